# Optimizing an MI355X kernel written in HIP

```python
import math
import jax, jax.numpy as jnp
from jax import lax
import numpy as np

D_MODEL = 1024
BATCH = 2
SEQ = 8192
DEPTH = 2

N_MEM = 256
EPS = 1e-6
MOBA_HEADS = 8
MOBA_HEAD_DIM = 64
MOBA_BLOCK = 256
MOBA_TOPK = 3
MOBA_Q_CHUNK = 64
A_WIDTH = MOBA_HEADS * MOBA_HEAD_DIM
POOL_WINDOWS = (2, 4, 8, 16)
POOL_GROUP = 128
POOL_WIDTH = POOL_GROUP * len(POOL_WINDOWS)
EV_IN = 3 * A_WIDTH + POOL_WIDTH
EV_MIX = A_WIDTH + POOL_WIDTH
SGU_GROUPS = 4
SGU_GROUP = 128
SGU_CHUNK = 128
SGU_WIDTH = SGU_GROUPS * SGU_GROUP
DN_HEADS = 4
DN_HEAD_DIM = 128
DN_WIDTH = DN_HEADS * DN_HEAD_DIM
DN_CONV = 4
DN_CHUNK = 64
OD_SPLITS = [2 * SGU_WIDTH, 2 * SGU_WIDTH + 3 * DN_WIDTH,
             2 * SGU_WIDTH + 4 * DN_WIDTH, 2 * SGU_WIDTH + 4 * DN_WIDTH + DN_HEADS]
OD_IN = 2 * SGU_WIDTH + 4 * DN_WIDTH + 2 * DN_HEADS
OD_MIX = SGU_WIDTH + DN_WIDTH
XATTN_HEADS = 4
XATTN_HEAD_DIM = D_MODEL // XATTN_HEADS
D_FF = 256 * ((8 * D_MODEL // 3 + 255) // 256)
FFN_CONV = 3
N_EVEN = (DEPTH + 1) // 2
N_ODD = DEPTH // 2

kernel_name = 'hybrid_moba_pool_sgu_gdeltanet'


def rmsnorm(x, g):
    xf = x.astype(jnp.float32)
    y = xf * lax.rsqrt(jnp.mean(xf * xf, axis=-1, keepdims=True) + EPS)
    return (y * g.astype(jnp.float32)).astype(x.dtype)


def causal_dwconv(x, w):
    K = w.shape[0]
    S = x.shape[1]
    xp = jnp.pad(x, ((0, 0), (K - 1, 0), (0, 0)))
    y = xp[:, 0:S] * w[0]
    for j in range(1, K):
        y = y + xp[:, j:j + S] * w[j]
    return y


def split_heads(t, n_heads, head_dim):
    B, S, _ = t.shape
    return t.reshape(B, S, n_heads, head_dim).transpose(0, 2, 1, 3)


def moba_attention(q, k, v):
    B, H, S, Dh = q.shape
    BS, QC = MOBA_BLOCK, MOBA_Q_CHUNK
    nb = -(-S // BS)
    pad = nb * BS - S
    k_blk = jnp.pad(k, ((0, 0), (0, 0), (0, pad), (0, 0))).reshape(B, H, nb, BS, Dh)
    v_blk = jnp.pad(v, ((0, 0), (0, 0), (0, pad), (0, 0))).reshape(B, H, nb, BS, Dh)
    k_mean = jnp.mean(k_blk.astype(jnp.float32), axis=3)
    q_blk_id = jnp.arange(S) // BS
    gate = jnp.einsum('bhsd,bhnd->bhsn', q.astype(jnp.float32), k_mean)
    fully_past = jnp.arange(nb)[None, :] < q_blk_id[:, None]
    gate = jnp.where(fully_past, gate, -jnp.inf)
    n_sel = min(MOBA_TOPK, nb)
    _, sel = lax.top_k(gate, n_sel)
    sel_valid = sel < q_blk_id[:, None]
    scale = Dh ** -0.5
    gather = jax.vmap(jax.vmap(lambda blk, ix: blk[ix]))

    def chunk(c):
        t0 = c * QC
        qc = lax.dynamic_slice_in_dim(q, t0, QC, axis=2)
        sc = lax.dynamic_slice_in_dim(sel, t0, QC, axis=2)
        vc = lax.dynamic_slice_in_dim(sel_valid, t0, QC, axis=2)
        own = t0 // BS
        k_own = lax.dynamic_index_in_dim(k_blk, own, axis=2, keepdims=False)
        v_own = lax.dynamic_index_in_dim(v_blk, own, axis=2, keepdims=False)
        k_sel = gather(k_blk, sc)
        v_sel = gather(v_blk, sc)
        s_sel = jnp.einsum('bhqd,bhqnkd->bhqnk', qc, k_sel).astype(jnp.float32) * scale
        s_sel = jnp.where(vc[..., None], s_sel, -jnp.inf).reshape(B, H, QC, n_sel * BS)
        tq = t0 + jnp.arange(QC)
        tk = own * BS + jnp.arange(BS)
        s_own = jnp.einsum('bhqd,bhkd->bhqk', qc, k_own).astype(jnp.float32) * scale
        s_own = jnp.where(tk[None, :] <= tq[:, None], s_own, -jnp.inf)
        p = jax.nn.softmax(jnp.concatenate([s_sel, s_own], axis=-1), axis=-1).astype(v.dtype)
        p_sel = p[..., :n_sel * BS].reshape(B, H, QC, n_sel, BS)
        p_own = p[..., n_sel * BS:]
        return (jnp.einsum('bhqnk,bhqnkd->bhqd', p_sel, v_sel)
                + jnp.einsum('bhqk,bhkd->bhqd', p_own, v_own))

    out = lax.map(chunk, jnp.arange(S // QC))
    return out.transpose(1, 2, 0, 3, 4).reshape(B, H, S, Dh)


def multiscale_pool(p, pool_w, pool_scale):
    B, S, _ = p.shape
    G = len(POOL_WINDOWS)
    pf = p.astype(jnp.float32).reshape(B, S, G, POOL_GROUP)
    cs = jnp.cumsum(pf, axis=1)
    t1 = jnp.arange(1, S + 1, dtype=jnp.float32)
    outs = []
    for g, w in enumerate(POOL_WINDOWS):
        c = cs[:, :, g]
        c_prev = jnp.pad(c, ((0, 0), (w, 0), (0, 0)))[:, :S]
        cnt = jnp.minimum(t1, float(w))[None, :, None]
        outs.append((c - c_prev) / cnt - pf[:, :, g])
    pooled = jnp.stack(outs, axis=2).astype(p.dtype)
    y = jnp.einsum('bsgc,gcd->bsgd', pooled, pool_w).reshape(B, S, POOL_WIDTH)
    return y * pool_scale


def spatial_gating(z, ln_g, ln_b, w_s, b_s):
    B, S, _ = z.shape
    u, v = jnp.split(z, 2, axis=-1)
    vf = v.astype(jnp.float32)
    mu = jnp.mean(vf, axis=-1, keepdims=True)
    var = jnp.mean(jnp.square(vf - mu), axis=-1, keepdims=True)
    vn = ((vf - mu) * lax.rsqrt(var + EPS) * ln_g + ln_b).astype(z.dtype)
    vn = vn.reshape(B, S // SGU_CHUNK, SGU_CHUNK, SGU_GROUPS, SGU_GROUP)
    causal = jnp.tril(jnp.ones((SGU_CHUNK, SGU_CHUNK), dtype=bool))
    w = jnp.where(causal[None], w_s, 0)
    s = jnp.einsum('gts,bnsgc->bntgc', w, vn) + b_s.T[None, None, :, :, None]
    return u * s.reshape(B, S, SGU_WIDTH)


def l2norm(t):
    return t * lax.rsqrt(jnp.sum(t * t, axis=-1, keepdims=True) + EPS)


def chunked_gated_delta_rule(q, k, v, g, beta):
    B, H, S, DK = q.shape
    DV = v.shape[-1]
    C = DN_CHUNK
    N = S // C
    q = q.reshape(B, H, N, C, DK)
    k = k.reshape(B, H, N, C, DK)
    v = v.reshape(B, H, N, C, DV)
    beta = beta.reshape(B, H, N, C)
    gc = jnp.cumsum(g.reshape(B, H, N, C), axis=-1)
    idx = jnp.arange(C)
    causal = idx[:, None] >= idx[None, :]
    strict = idx[:, None] > idx[None, :]
    decay = jnp.exp(jnp.where(causal, gc[..., :, None] - gc[..., None, :], -jnp.inf))
    kb = k * beta[..., None]
    a = jnp.where(strict, jnp.einsum('bhnid,bhnjd->bhnij', kb, k) * decay, 0.0)
    m = a + jnp.eye(C, dtype=a.dtype)
    rhs = jnp.concatenate([v * beta[..., None], kb * jnp.exp(gc)[..., None]], axis=-1)
    sol = lax.linalg.triangular_solve(m, rhs, left_side=True, lower=True, unit_diagonal=True)
    u, w = sol[..., :DV], sol[..., DV:]
    qk = jnp.einsum('bhnid,bhnjd->bhnij', q, k) * decay
    q_dec = q * jnp.exp(gc)[..., None]
    k_dec = k * jnp.exp(gc[..., -1:] - gc)[..., None]
    g_last = jnp.exp(gc[..., -1])

    def step(state, inp):
        qk_n, qd_n, kd_n, u_n, w_n, gl_n = inp
        v_new = u_n - jnp.einsum('bhck,bhkv->bhcv', w_n, state)
        o = (jnp.einsum('bhck,bhkv->bhcv', qd_n, state)
             + jnp.einsum('bhij,bhjv->bhiv', qk_n, v_new))
        state = state * gl_n[..., None, None] + jnp.einsum('bhck,bhcv->bhkv', kd_n, v_new)
        return state, o

    xs = (jnp.moveaxis(qk, 2, 0), jnp.moveaxis(q_dec, 2, 0), jnp.moveaxis(k_dec, 2, 0),
          jnp.moveaxis(u, 2, 0), jnp.moveaxis(w, 2, 0), jnp.moveaxis(g_last, 2, 0))
    state0 = jnp.zeros((B, H, DK, DV), q.dtype)
    _, o = lax.scan(step, state0, xs)
    return jnp.moveaxis(o, 0, 2).reshape(B, H, S, DV)


def gated_deltanet(qkv, gate, b_raw, a_raw, conv_w, a_log, dt_bias, norm_g):
    B, S, _ = qkv.shape
    dt = qkv.dtype
    qkv = jax.nn.silu(causal_dwconv(qkv, conv_w))
    q, k, v = jnp.split(qkv, 3, axis=-1)
    q = l2norm(split_heads(q, DN_HEADS, DN_HEAD_DIM).astype(jnp.float32)) * DN_HEAD_DIM ** -0.5
    k = l2norm(split_heads(k, DN_HEADS, DN_HEAD_DIM).astype(jnp.float32))
    v = split_heads(v, DN_HEADS, DN_HEAD_DIM).astype(jnp.float32)
    beta = jax.nn.sigmoid(b_raw.astype(jnp.float32)).transpose(0, 2, 1)
    g = (-jnp.exp(a_log.astype(jnp.float32))
         * jax.nn.softplus(a_raw.astype(jnp.float32) + dt_bias.astype(jnp.float32))).transpose(0, 2, 1)
    o = chunked_gated_delta_rule(q, k, v, g, beta)
    o = o * lax.rsqrt(jnp.mean(o * o, axis=-1, keepdims=True) + EPS) * norm_g.astype(jnp.float32)
    o = o.transpose(0, 2, 1, 3) * jax.nn.silu(gate.astype(jnp.float32).reshape(B, S, DN_HEADS, DN_HEAD_DIM))
    return o.reshape(B, S, DN_WIDTH).astype(dt)


def memory_cross_attention(xn, mem_n, wq, wkv, wo):
    B, S, D = xn.shape
    M = mem_n.shape[1]
    q = (xn @ wq).reshape(B, S, XATTN_HEADS, XATTN_HEAD_DIM)
    k, v = jnp.split(mem_n @ wkv, 2, axis=-1)
    k = k.reshape(B, M, XATTN_HEADS, XATTN_HEAD_DIM)
    v = v.reshape(B, M, XATTN_HEADS, XATTN_HEAD_DIM)
    s = jnp.einsum('bshd,bmhd->bhsm', q, k).astype(jnp.float32) * XATTN_HEAD_DIM ** -0.5
    p = jax.nn.softmax(s, axis=-1).astype(v.dtype)
    o = jnp.einsum('bhsm,bmhd->bshd', p, v).reshape(B, S, D)
    return o @ wo


def conv_ffn(xn, w_up, conv_w, w_down):
    h = causal_dwconv(xn @ w_up, conv_w)
    g, u = jnp.split(h, 2, axis=-1)
    return (jax.nn.silu(g) * u) @ w_down


def setup_inputs(seed: int = 0) -> dict:
    key = jax.random.key(seed)
    ks = iter(jax.random.split(key, 32))
    D = D_MODEL

    def nrm(shape, scale):
        return jax.random.normal(next(ks), shape, jnp.float32) * scale

    def gain(shape):
        return 1.0 + nrm(shape, 0.02)

    x = nrm((BATCH, SEQ, D), 1.0)
    mem = nrm((BATCH, N_MEM, D), 1.0)
    mem_norm = gain((D,))
    norm_mix = gain((DEPTH, D))
    norm_xattn = gain((DEPTH, D))
    norm_ffn = gain((DEPTH, D))
    ev_w_in = nrm((N_EVEN, D, EV_IN), D ** -0.5)
    pool_w = nrm((N_EVEN, len(POOL_WINDOWS), POOL_GROUP, POOL_GROUP), POOL_GROUP ** -0.5)
    pool_scale = 1.0 + nrm((N_EVEN, POOL_WIDTH), 0.1)
    ev_w_out = nrm((N_EVEN, EV_MIX, D), EV_MIX ** -0.5)
    od_w_in = nrm((N_ODD, D, OD_IN), D ** -0.5)
    sgu_ln_g = gain((N_ODD, SGU_WIDTH))
    sgu_ln_b = nrm((N_ODD, SGU_WIDTH), 0.02)
    sgu_w = nrm((N_ODD, SGU_GROUPS, SGU_CHUNK, SGU_CHUNK), SGU_CHUNK ** -0.5)
    sgu_b = 1.0 + nrm((N_ODD, SGU_GROUPS, SGU_CHUNK), 0.02)
    dn_conv = nrm((N_ODD, DN_CONV, 3 * DN_WIDTH), DN_CONV ** -0.5)
    dn_a_log = jnp.log(jax.random.uniform(next(ks), (N_ODD, DN_HEADS), jnp.float32, 1.0, 16.0))
    dt = jnp.exp(jax.random.uniform(next(ks), (N_ODD, DN_HEADS), jnp.float32,
                                    math.log(1e-3), math.log(1e-1)))
    dn_dt_bias = dt + jnp.log(-jnp.expm1(-dt))
    dn_norm_g = gain((N_ODD, DN_HEAD_DIM))
    od_w_out = nrm((N_ODD, OD_MIX, D), OD_MIX ** -0.5)
    xattn_wq = nrm((DEPTH, D, D), D ** -0.5)
    xattn_wkv = nrm((DEPTH, D, 2 * D), D ** -0.5)
    xattn_wo = nrm((DEPTH, D, D), D ** -0.5)
    ffn_w_up = nrm((DEPTH, D, 2 * D_FF), D ** -0.5)
    ffn_conv = nrm((DEPTH, FFN_CONV, 2 * D_FF), FFN_CONV ** -0.5)
    ffn_w_down = nrm((DEPTH, D_FF, D), D_FF ** -0.5)
    final_norm = gain((D,))
    return {'x': x, 'mem': mem, 'mem_norm': mem_norm, 'norm_mix': norm_mix,
            'norm_xattn': norm_xattn, 'norm_ffn': norm_ffn,
            'ev_w_in': ev_w_in, 'pool_w': pool_w, 'pool_scale': pool_scale, 'ev_w_out': ev_w_out,
            'od_w_in': od_w_in, 'sgu_ln_g': sgu_ln_g, 'sgu_ln_b': sgu_ln_b, 'sgu_w': sgu_w,
            'sgu_b': sgu_b, 'dn_conv': dn_conv, 'dn_a_log': dn_a_log, 'dn_dt_bias': dn_dt_bias,
            'dn_norm_g': dn_norm_g, 'od_w_out': od_w_out,
            'xattn_wq': xattn_wq, 'xattn_wkv': xattn_wkv, 'xattn_wo': xattn_wo,
            'ffn_w_up': ffn_w_up, 'ffn_conv': ffn_conv, 'ffn_w_down': ffn_w_down,
            'final_norm': final_norm}


def reference(x, mem, mem_norm, norm_mix, norm_xattn, norm_ffn,
              ev_w_in, pool_w, pool_scale, ev_w_out,
              od_w_in, sgu_ln_g, sgu_ln_b, sgu_w, sgu_b,
              dn_conv, dn_a_log, dn_dt_bias, dn_norm_g, od_w_out,
              xattn_wq, xattn_wkv, xattn_wo,
              ffn_w_up, ffn_conv, ffn_w_down, final_norm):
    B, S, _ = x.shape
    mem_n = rmsnorm(mem, mem_norm)
    h = x
    for layer in range(DEPTH):
        xn = rmsnorm(h, norm_mix[layer])
        i = layer // 2
        if layer % 2 == 0:
            proj = xn @ ev_w_in[i]
            q, k, v, p = jnp.split(proj, [A_WIDTH, 2 * A_WIDTH, 3 * A_WIDTH], axis=-1)
            a_out = moba_attention(split_heads(q, MOBA_HEADS, MOBA_HEAD_DIM),
                                   split_heads(k, MOBA_HEADS, MOBA_HEAD_DIM),
                                   split_heads(v, MOBA_HEADS, MOBA_HEAD_DIM))
            a_out = a_out.transpose(0, 2, 1, 3).reshape(B, S, A_WIDTH)
            b_out = multiscale_pool(p, pool_w[i], pool_scale[i])
            mix = jnp.concatenate([a_out, b_out], axis=-1) @ ev_w_out[i]
        else:
            proj = xn @ od_w_in[i]
            z, qkv, gate, b_raw, a_raw = jnp.split(proj, OD_SPLITS, axis=-1)
            c_out = spatial_gating(jax.nn.gelu(z), sgu_ln_g[i], sgu_ln_b[i], sgu_w[i], sgu_b[i])
            d_out = gated_deltanet(qkv, gate, b_raw, a_raw, dn_conv[i], dn_a_log[i],
                                   dn_dt_bias[i], dn_norm_g[i])
            mix = jnp.concatenate([c_out, d_out], axis=-1) @ od_w_out[i]
        h = h + mix
        h = h + memory_cross_attention(rmsnorm(h, norm_xattn[layer]), mem_n,
                                       xattn_wq[layer], xattn_wkv[layer], xattn_wo[layer])
        h = h + conv_ffn(rmsnorm(h, norm_ffn[layer]), ffn_w_up[layer], ffn_conv[layer], ffn_w_down[layer])
    return rmsnorm(h, final_norm)
```

```cpp
#include <hip/hip_runtime.h>
#include <hip/hip_cooperative_groups.h>
#include <cstdio>
#include <cstdint>
namespace cg = cooperative_groups;
namespace pg8 {
#define PG8_LAS __attribute__((address_space(3)))
typedef unsigned short bf16_t;
typedef short bf16x8 __attribute__((ext_vector_type(8)));
typedef float f32x4 __attribute__((ext_vector_type(4)));
typedef unsigned u32x4 __attribute__((ext_vector_type(4)));
constexpr int BM = 256, BK = 64, HALF = 128, HTB = HALF * BK * 2  , STAGE_BYTES = 8 * HTB, NXCD = 8, WGM = 8;

__host__ __device__ __forceinline__ int lds_byte(int r, int c) { const int st = (r >> 4) * 2 + (c >> 5), rr = r & 15, cc = c & 31, ob = rr * 64 + cc * 2; return st * 1024 + (ob ^ (((ob >> 9) & 1) << 5)); }
__host__ __device__ __forceinline__ void stage_rc(int b, int& R, int& C) { const int st = b / 1024, sb = b % 1024, swz = sb ^ (((sb >> 9) & 1) << 5); R = (st >> 1) * 16 + swz / 64; C = (st & 1) * 32 + (swz % 64) / 2; }
__host__ __device__ __forceinline__ int perm32(int rho) { const int n = rho >> 4, i = rho & 15; return 8 * (i >> 2) + 4 * n + (i & 3); }

struct Unit { int pm, pn; };
struct Gemm { const bf16_t* A; const bf16_t* Bt; int M, N, K; int ov, tpb, seq; };

struct StaticOrder {
    int nM, nN, nwg, G, c;
    __host__ __device__ void init(int M, int N, int G_, int c_) { nM = M / BM; nN = N / BM; nwg = nM * nN; G = G_; c = c_; }
    __host__ __device__ bool next(int i, Unit& u) const {
        const long L = (long)i * G + c; if (L >= nwg) return false;
        int wgid = (int)L; { const int q = nwg / NXCD, r = nwg % NXCD, xcd = wgid % NXCD, off = wgid / NXCD; wgid = (xcd < r ? xcd * (q + 1) : r * (q + 1) + (xcd - r) * q) + off; }
        const int nig = WGM * nN, gid = wgid / nig, fm = gid * WGM, gsz = (nM - fm) < WGM ? (nM - fm) : WGM;
        u.pm = fm + ((wgid % nig) % gsz); u.pn = (wgid % nig) / gsz; return true;
    }
    __device__ __forceinline__ void a_ready(const Unit&) const {}
    __device__ __forceinline__ void done(const Unit&) const {}
};

__device__ __forceinline__ unsigned cvt_pk_bf16(float lo, float hi) { unsigned r; asm volatile("v_cvt_pk_bf16_f32 %0, %1, %2" : "=v"(r) : "v"(lo), "v"(hi)); return r; }
__device__ __forceinline__ float gelu_tanh(float x) { const float u2 = 1.5957691216057308f * (x + 0.044715f * x * x * x); return x * __builtin_amdgcn_rcpf(1.0f + __expf(-u2)); }

struct EpiSeg {
    static constexpr bool PERM = true, AFTER_DRAIN = false;
    bf16_t* p0; bf16_t* p1; bf16_t* p2; int ld0, ld1, ld2, t1, t2, gelu0; const float* ss;
    __device__ __forceinline__ void operator()(const f32x4 (&acc)[2][2][4][2], const Unit& u, int wr, int wc, int fr, int fq) const {
        bf16_t* base; int ld, colt; bool act = false;
        if (u.pn < t1) { base = p0; ld = ld0; colt = u.pn * BM; act = gelu0 != 0; }
        else if (u.pn < t2) { base = p1; ld = ld1; colt = (u.pn - t1) * BM; }
        else { base = p2; ld = ld2; colt = (u.pn - t2) * BM; }
        const int row0 = u.pm * BM + wr * 64 + fr, col0 = colt + wc * 32 + 8 * fq;
#pragma unroll
        for (int ai = 0; ai < 2; ++ai)
#pragma unroll
            for (int m = 0; m < 4; ++m) { bf16_t* rowp = base + (size_t)(row0 + ai * HALF + m * 16) * ld + col0;
                float rs = 1.0f;
                if (ss) { const f32x4* sp = (const f32x4*)(ss + (size_t)(row0 + ai * HALF + m * 16) * 16); const f32x4 s0 = sp[0], s1 = sp[1], s2 = sp[2], s3 = sp[3];
                    const float tot = ((s0[0] + s0[1]) + (s0[2] + s0[3])) + ((s1[0] + s1[1]) + (s1[2] + s1[3])) + ((s2[0] + s2[1]) + (s2[2] + s2[3])) + ((s3[0] + s3[1]) + (s3[2] + s3[3]));
                    rs = 1.0f / sqrtf(tot * (1.0f / 1024.0f) + 1e-6f); }
#pragma unroll
                for (int bj = 0; bj < 2; ++bj) { f32x4 v0 = acc[ai][bj][m][0] * rs, v1 = acc[ai][bj][m][1] * rs;
                    if (act) { v0 = (f32x4){gelu_tanh(v0[0]), gelu_tanh(v0[1]), gelu_tanh(v0[2]), gelu_tanh(v0[3])}; v1 = (f32x4){gelu_tanh(v1[0]), gelu_tanh(v1[1]), gelu_tanh(v1[2]), gelu_tanh(v1[3])}; }
                    u32x4 w; w.x = cvt_pk_bf16(v0[0], v0[1]); w.y = cvt_pk_bf16(v0[2], v0[3]); w.z = cvt_pk_bf16(v1[0], v1[1]); w.w = cvt_pk_bf16(v1[2], v1[3]);
                    *(u32x4*)(rowp + bj * HALF) = w; } }
    }
};
struct EpiResid {
    static constexpr bool PERM = true, AFTER_DRAIN = false;
    const float* basef; const bf16_t* baseh; bf16_t* hb; float* ss; int ld;
    __device__ __forceinline__ void operator()(const f32x4 (&acc)[2][2][4][2], const Unit& u, int wr, int wc, int fr, int fq) const {
        const int col0 = u.pn * BM + wc * 32 + 8 * fq;
#pragma unroll
        for (int ai = 0; ai < 2; ++ai)
#pragma unroll
            for (int m = 0; m < 4; ++m) { const size_t off = (size_t)(u.pm * BM + ai * HALF + wr * 64 + m * 16 + fr) * ld + col0; float sq = 0.f;
#pragma unroll
                for (int bj = 0; bj < 2; ++bj) { f32x4 b0, b1;
                    if (basef) { b0 = *(const f32x4*)(basef + off + bj * HALF); b1 = *(const f32x4*)(basef + off + bj * HALF + 4); }
                    else { const u32x4 w = *(const u32x4*)(baseh + off + bj * HALF);
                        b0[0] = __uint_as_float(w.x << 16); b0[1] = __uint_as_float(w.x & 0xffff0000u); b0[2] = __uint_as_float(w.y << 16); b0[3] = __uint_as_float(w.y & 0xffff0000u);
                        b1[0] = __uint_as_float(w.z << 16); b1[1] = __uint_as_float(w.z & 0xffff0000u); b1[2] = __uint_as_float(w.w << 16); b1[3] = __uint_as_float(w.w & 0xffff0000u); }
                    const f32x4 o0 = b0 + acc[ai][bj][m][0], o1 = b1 + acc[ai][bj][m][1];
                    sq += ((o0[0] * o0[0] + o0[1] * o0[1]) + (o0[2] * o0[2] + o0[3] * o0[3])) + ((o1[0] * o1[0] + o1[1] * o1[1]) + (o1[2] * o1[2] + o1[3] * o1[3]));
                    u32x4 w2; w2.x = cvt_pk_bf16(o0[0], o0[1]); w2.y = cvt_pk_bf16(o0[2], o0[3]); w2.z = cvt_pk_bf16(o1[0], o1[1]); w2.w = cvt_pk_bf16(o1[2], o1[3]); *(u32x4*)(hb + off + bj * HALF) = w2; }
                if (ss) { sq += __shfl_xor(sq, 16); sq += __shfl_xor(sq, 32); if (fq == 0) ss[(size_t)(u.pm * BM + ai * HALF + wr * 64 + m * 16 + fr) * 16 + u.pn * 4 + wc] = sq; } }
    }
};
struct EpiConv {
    static constexpr bool PERM = true, AFTER_DRAIN = false;
    static __device__ __forceinline__ float shr16(float oldv, float v, int d) { const int o = __builtin_bit_cast(int, oldv), x = __builtin_bit_cast(int, v); const int y = d == 1 ? __builtin_amdgcn_update_dpp(o, x, 0x111, 0xf, 0xf, false) : __builtin_amdgcn_update_dpp(o, x, 0x112, 0xf, 0xf, false); return __builtin_bit_cast(float, y); }
    static __device__ __forceinline__ float ror16(float v, int d) { const int x = __builtin_bit_cast(int, v); const int y = d == 1 ? __builtin_amdgcn_mov_dpp(x, 0x121, 0xf, 0xf, false) : __builtin_amdgcn_mov_dpp(x, 0x122, 0xf, 0xf, false); return __builtin_bit_cast(float, y); }
    bf16_t* O; const float* ss; const float* cw; int tpb, seq, dff;
    __device__ __forceinline__ void operator()(const f32x4 (&acc)[2][2][4][2], const Unit& u, int wr, int wc, int fr, int fq) const {
        const int lane = fq * 16 + fr, b = u.pm / tpb, pmm = u.pm % tpb, ch0 = u.pn * 128 + wc * 32 + 8 * fq;
#pragma unroll
        for (int ai = 0; ai < 2; ++ai) {
            const int tl0 = pmm * 248 + (2 * ai + wr) * 62 - 2;
            float rs[4];
#pragma unroll
            for (int m = 0; m < 4; ++m) { const int tl = tl0 + 16 * m + fr; float r_ = 0.f;
                if (tl >= 0 && tl < seq) { const f32x4* sp = (const f32x4*)(ss + ((size_t)b * seq + tl) * 16); const f32x4 s0 = sp[0], s1 = sp[1], s2 = sp[2], s3 = sp[3];
                    const float tot = ((s0[0] + s0[1]) + (s0[2] + s0[3])) + ((s1[0] + s1[1]) + (s1[2] + s1[3])) + ((s2[0] + s2[1]) + (s2[2] + s2[3])) + ((s3[0] + s3[1]) + (s3[2] + s3[3]));
                    r_ = 1.0f / sqrtf(tot * (1.0f / 1024.0f) + 1e-6f); }
                rs[m] = r_; }
#pragma unroll
            for (int n = 0; n < 2; ++n) {
                f32x4 wg[3], wu[3];
#pragma unroll
                for (int k = 0; k < 3; ++k) { wg[k] = *(const f32x4*)(cw + (size_t)k * 2 * dff + ch0 + 4 * n); wu[k] = *(const f32x4*)(cw + (size_t)k * 2 * dff + dff + ch0 + 4 * n); }
                float pv[2][4];
#pragma unroll
                for (int bj = 0; bj < 2; ++bj)
#pragma unroll
                    for (int i = 0; i < 4; ++i) pv[bj][i] = 0.f;
#pragma unroll
                for (int m = 0; m < 4; ++m) {
                    const int tl = tl0 + 16 * m + fr; const bool ok = (16 * m + fr >= 2) && tl < seq;
                    float o[4];
#pragma unroll
                    for (int i = 0; i < 4; ++i) { float cv[2];
#pragma unroll
                        for (int bj = 0; bj < 2; ++bj) {
                            const float cur = rs[m] > 0.f ? acc[ai][bj][m][n][i] * rs[m] : 0.f;
                            const float p1 = shr16(ror16(pv[bj][i], 1), cur, 1), p2 = shr16(ror16(pv[bj][i], 2), cur, 2);
                            pv[bj][i] = cur;
                            cv[bj] = bj == 0 ? (wg[0][i] * p2 + wg[1][i] * p1 + wg[2][i] * cur) : (wu[0][i] * p2 + wu[1][i] * p1 + wu[2][i] * cur); }
                        o[i] = cv[0] * __builtin_amdgcn_rcpf(1.0f + __expf(-cv[0])) * cv[1]; }
                    if (ok) { typedef unsigned u32x2e __attribute__((ext_vector_type(2))); u32x2e w; w.x = cvt_pk_bf16(o[0], o[1]); w.y = cvt_pk_bf16(o[2], o[3]);
                        *(u32x2e*)(O + ((size_t)b * seq + tl) * dff + ch0 + 4 * n) = w; }
                }
            }
        }
    }
};
template <class Epi, class Sched, bool ALIGN_EPI = false, bool SP2 = false>
__device__ __forceinline__ void gemm_phase(PG8_LAS unsigned char* lds, const Gemm g, const Sched& S, const Epi& E, const int tid_in) {
    const int tid = tid_in, wid = __builtin_amdgcn_readfirstlane(tid >> 6), lane = tid & 63, wr = wid >> 2, wc = wid & 3, fr = lane & 15, fq = lane >> 4;
    const int K = g.K, nt = K / BK;
    unsigned voffA[2], voffB[2];
#pragma unroll
    for (int i = 0; i < 2; ++i) { int R, C; stage_rc(tid * 16 + i * 8192, R, C); const int Rb = Epi::PERM ? ((R & ~31) + perm32(R & 31)) : R;
        voffA[i] = (unsigned)((R - (R >> 6) * g.ov) * K + C) * 2u; voffB[i] = (unsigned)(Rb * K + C) * 2u; }
    const size_t kstep = (size_t)(BK * 2);
    const size_t hstep = (size_t)HALF * K * 2;
    const size_t tstep = 2 * hstep;
    const size_t hstepA = (size_t)(HALF - 2 * g.ov) * K * 2;
#define PG8_ABASE(pm_) ((const char*)g.A + (g.ov ? ((size_t)((pm_) / g.tpb) * g.seq + (size_t)((pm_) % g.tpb) * (BM - 4 * g.ov)) * K * 2 - (size_t)g.ov * K * 2 : (size_t)(pm_) * tstep))
    const unsigned ldsw = (unsigned)wid * 1024u;
    const int aoff = lds_byte(wr * 64 + fr, fq * 8), boff = lds_byte(wc * 32 + fr, fq * 8);
#define PG8_SA(b, h) (((b) * 2 + (h)) * HTB)
#define PG8_SB(b, h) ((4 + (b) * 2 + (h)) * HTB)
#define PG8_STAGE(bufoff, gbase, voff) do { _Pragma("unroll") for (int _i = 0; _i < 2; ++_i) \
        __builtin_amdgcn_global_load_lds((const unsigned*)((const char*)(gbase) + (voff)[_i]), (PG8_LAS unsigned*)(lds + (bufoff) + ldsw + _i * 8192), 16, 0, 0); } while (0)
#define PG8_LDA(dst, b, h) do { _Pragma("unroll") for (int m = 0; m < 4; ++m) _Pragma("unroll") for (int k = 0; k < 2; ++k) dst[m][k] = *(const PG8_LAS bf16x8*)(lds + PG8_SA(b, h) + aoff + m * 2048 + k * 1024); } while (0)
#define PG8_LDB(dst, b, h) do { _Pragma("unroll") for (int n = 0; n < 2; ++n) _Pragma("unroll") for (int k = 0; k < 2; ++k) dst[n][k] = *(const PG8_LAS bf16x8*)(lds + PG8_SB(b, h) + boff + n * 2048 + k * 1024); } while (0)
#define PG8_MMA(ai, bj, At, Bt) do { __builtin_amdgcn_s_setprio(1); _Pragma("unroll") for (int m = 0; m < 4; ++m) _Pragma("unroll") for (int n = 0; n < 2; ++n) _Pragma("unroll") for (int k = 0; k < 2; ++k) \
        acc[ai][bj][m][n] = __builtin_amdgcn_mfma_f32_16x16x32_bf16(Bt[n][k], At[m][k], acc[ai][bj][m][n], 0, 0, 0); __builtin_amdgcn_s_setprio(0); } while (0)
#define PG8_WAIT_V(n) asm volatile("s_waitcnt vmcnt(" #n ")" ::: "memory")
#define PG8_WAIT_L(n) asm volatile("s_waitcnt lgkmcnt(" #n ")" ::: "memory")
#define PG8_BAR __builtin_amdgcn_s_barrier()
#define PG8_SCHED __builtin_amdgcn_sched_barrier(0)
    Unit cur, nxt; int ui = 0;
    if (!S.next(0, cur)) return;
    f32x4 acc[2][2][4][2];
#pragma unroll
    for (int a = 0; a < 2; ++a)
#pragma unroll
        for (int b = 0; b < 2; ++b)
#pragma unroll
            for (int m = 0; m < 4; ++m)
#pragma unroll
                for (int n = 0; n < 2; ++n) acc[a][b][m][n] = (f32x4){0.f, 0.f, 0.f, 0.f};
    bf16x8 At[4][2], B0[2][2], B1[2][2];
    const char* cA = PG8_ABASE(cur.pm); const char* cB = (const char*)g.Bt + (size_t)cur.pn * tstep;
    S.a_ready(cur);
    if constexpr (SP2) {
        PG8_STAGE(PG8_SB(0, 0), cB, voffB); PG8_STAGE(PG8_SB(0, 1), cB + hstep, voffB); PG8_STAGE(PG8_SA(0, 0), cA, voffA); PG8_STAGE(PG8_SA(0, 1), cA + hstepA, voffA);
        if (wr == 1) PG8_BAR;
        PG8_WAIT_V(2); PG8_BAR;
        PG8_STAGE(PG8_SB(1, 0), cB + kstep, voffB); PG8_STAGE(PG8_SA(1, 0), cA + kstep, voffA); PG8_STAGE(PG8_SB(1, 1), cB + hstep + kstep, voffB);
        PG8_WAIT_V(6); PG8_BAR;
    } else {
        PG8_STAGE(PG8_SB(0, 0), cB, voffB); PG8_STAGE(PG8_SA(0, 0), cA, voffA); PG8_STAGE(PG8_SB(0, 1), cB + hstep, voffB); PG8_STAGE(PG8_SA(0, 1), cA + hstepA, voffA);
        if (wr == 1) PG8_BAR;
        PG8_WAIT_V(4); PG8_BAR;
        PG8_STAGE(PG8_SB(1, 0), cB + kstep, voffB); PG8_STAGE(PG8_SA(1, 0), cA + kstep, voffA); PG8_STAGE(PG8_SB(1, 1), cB + hstep + kstep, voffB);
        PG8_WAIT_V(6); PG8_BAR;
    }
    for (;;) {
        const bool has_next = S.next(ui + 1, nxt);
        const char* nA = has_next ? PG8_ABASE(nxt.pm) : cA; const char* nB = has_next ? (const char*)g.Bt + (size_t)nxt.pn * tstep : cB;
        for (int t = 0; t < nt; t += 2) {
            const bool last = (t == nt - 2);
            const char* a1 = cA + (size_t)(t + 1) * kstep;
            const char* a2 = last ? nA : cA + (size_t)(t + 2) * kstep; const char* b2 = last ? nB : cB + (size_t)(t + 2) * kstep;
            const char* a3 = a2 + kstep; const char* b3 = b2 + kstep;
            if (last && has_next) S.a_ready(nxt);
            if constexpr (SP2) {
            PG8_LDB(B0, 0, 0); PG8_LDB(B1, 0, 1); PG8_SCHED; PG8_LDA(At, 0, 0); PG8_STAGE(PG8_SA(1, 1), a1 + hstepA, voffA);
            PG8_WAIT_V(8); PG8_WAIT_L(0); PG8_BAR; PG8_MMA(0, 0, At, B0); PG8_MMA(0, 1, At, B1); PG8_BAR; PG8_SCHED;
            PG8_LDA(At, 0, 1); PG8_STAGE(PG8_SB(0, 0), b2, voffB); PG8_STAGE(PG8_SB(0, 1), b2 + hstep, voffB); PG8_STAGE(PG8_SA(0, 0), a2, voffA);
            PG8_WAIT_V(8); PG8_WAIT_L(0); PG8_BAR; PG8_MMA(1, 0, At, B0); PG8_MMA(1, 1, At, B1); PG8_BAR; PG8_SCHED;
            PG8_LDB(B0, 1, 0); PG8_LDB(B1, 1, 1); PG8_SCHED; PG8_LDA(At, 1, 0); PG8_STAGE(PG8_SA(0, 1), a2 + hstepA, voffA);
            PG8_WAIT_V(8); PG8_WAIT_L(0); PG8_BAR; PG8_MMA(0, 0, At, B0); PG8_MMA(0, 1, At, B1); PG8_BAR; PG8_SCHED;
            PG8_LDA(At, 1, 1); PG8_STAGE(PG8_SB(1, 0), b3, voffB); PG8_STAGE(PG8_SB(1, 1), b3 + hstep, voffB); PG8_STAGE(PG8_SA(1, 0), a3, voffA);
            PG8_WAIT_V(8); PG8_WAIT_L(0); PG8_BAR; PG8_MMA(1, 0, At, B0); PG8_MMA(1, 1, At, B1); PG8_BAR; PG8_SCHED;
            } else {
            PG8_LDB(B0, 0, 0); PG8_SCHED; PG8_LDA(At, 0, 0); PG8_STAGE(PG8_SA(1, 1), a1 + hstepA, voffA);
            PG8_WAIT_L(8); PG8_BAR; PG8_WAIT_L(0); PG8_MMA(0, 0, At, B0); PG8_BAR; PG8_SCHED;
            PG8_LDB(B1, 0, 1); PG8_STAGE(PG8_SB(0, 0), b2, voffB);
            PG8_BAR; PG8_WAIT_L(0); PG8_MMA(0, 1, At, B1); PG8_BAR;
            PG8_LDA(At, 0, 1); PG8_STAGE(PG8_SA(0, 0), a2, voffA);
            PG8_BAR; PG8_WAIT_L(0); PG8_MMA(1, 0, At, B0); PG8_BAR; PG8_SCHED;
            PG8_STAGE(PG8_SB(0, 1), b2 + hstep, voffB);
            PG8_WAIT_V(6); PG8_BAR; PG8_MMA(1, 1, At, B1); PG8_BAR;
            PG8_LDB(B0, 1, 0); PG8_SCHED; PG8_LDA(At, 1, 0); PG8_STAGE(PG8_SA(0, 1), a2 + hstepA, voffA);
            PG8_WAIT_L(8); PG8_BAR; PG8_WAIT_L(0); PG8_MMA(0, 0, At, B0); PG8_BAR; PG8_SCHED;
            PG8_LDB(B1, 1, 1); PG8_STAGE(PG8_SB(1, 0), b3, voffB);
            PG8_BAR; PG8_WAIT_L(0); PG8_MMA(0, 1, At, B1); PG8_BAR;
            PG8_LDA(At, 1, 1); PG8_STAGE(PG8_SA(1, 0), a3, voffA);
            PG8_BAR; PG8_WAIT_L(0); PG8_MMA(1, 0, At, B0); PG8_BAR; PG8_SCHED;
            PG8_STAGE(PG8_SB(1, 1), b3 + hstep, voffB);
            PG8_WAIT_V(6); PG8_BAR; PG8_MMA(1, 1, At, B1); PG8_BAR;
            }
        }
        if constexpr (ALIGN_EPI) { if (wr == 0) PG8_BAR; }
        if constexpr (!Epi::AFTER_DRAIN) { E(acc, cur, wr, wc, fr, fq); S.done(cur); }
        if (!has_next) break;
#pragma unroll
        for (int a = 0; a < 2; ++a)
#pragma unroll
            for (int b = 0; b < 2; ++b)
#pragma unroll
                for (int m = 0; m < 4; ++m)
#pragma unroll
                    for (int n = 0; n < 2; ++n) acc[a][b][m][n] = (f32x4){0.f, 0.f, 0.f, 0.f};
        cur = nxt; cA = nA; cB = nB; ++ui;
        if constexpr (ALIGN_EPI) { if (wr == 1) PG8_BAR; }
    }
    PG8_WAIT_V(0);
    if constexpr (!ALIGN_EPI) { if (wr == 0) PG8_BAR; }
    PG8_BAR;
    if constexpr (Epi::AFTER_DRAIN) { E.fused(acc, cur, wr, wc, fr, fq, lds, wid, lane); S.done(cur); }
#undef PG8_ABASE
#undef PG8_SA
#undef PG8_SB
#undef PG8_STAGE
#undef PG8_LDA
#undef PG8_LDB
#undef PG8_MMA
#undef PG8_WAIT_V
#undef PG8_WAIT_L
#undef PG8_BAR
#undef PG8_SCHED
}
}

constexpr int NT = 16384, SEQ = 8192, DM = 1024, NMEM = 256, DFF = 2816, DFF2 = 5632;
constexpr float EPS = 1e-6f;
#define LAS __attribute__((address_space(3)))
typedef unsigned short bf16;
typedef float f32x4 __attribute__((ext_vector_type(4)));
typedef unsigned u32x4 __attribute__((ext_vector_type(4)));
typedef unsigned u32x2 __attribute__((ext_vector_type(2)));
constexpr size_t MiB = 1u << 20;
constexpr size_t WS_MEMN = 0, WS_BG = 1 * MiB, WS_KMEAN = 1 * MiB + 512 * 1024;
constexpr size_t WS_WTS = 4 * MiB;
constexpr size_t W_IN = WS_WTS, W_OUT = WS_WTS + 6 * MiB, W_Q = WS_WTS + 8 * MiB, W_KV = WS_WTS + 10 * MiB, W_O = WS_WTS + 14 * MiB, W_UP = WS_WTS + 16 * MiB, W_DN = WS_WTS + 27 * MiB;
constexpr size_t WS_XN = 37 * MiB, WS_KVX = 69 * MiB, WS_MIX = 71 * MiB, WS_QX = 103 * MiB, WS_F = 135 * MiB;
constexpr size_t WS_PROJ0 = WS_F, WS_Z = WS_F, WS_QKV = WS_F + 32 * MiB, WS_GATE = WS_F + 80 * MiB, WS_O = WS_QX;
constexpr size_t WS_U = WS_F + 32 * MiB, WS_W = WS_F + 48 * MiB, WS_KDT = WS_F + 64 * MiB, WS_QD = WS_F + 96 * MiB, WS_QKM = WS_F + 112 * MiB, WS_GL = 1 * MiB + 768 * 1024;
constexpr size_t WS_VT = WS_F + 48 * MiB, WS_XNP = WS_F + 64 * MiB, WS_MEMNP = 2 * MiB, WS_VXT = WS_KVX + 1 * MiB;
constexpr size_t WS_PWT = 3 * MiB + 64 * 1024, WS_WB = 3 * MiB + 256 * 1024;
constexpr size_t WS_VNT = WS_XN, WS_HB = WS_XN, WS_SS = 248 * MiB;
constexpr size_t WS_POOLED = WS_QX, WS_VN = WS_XN, WS_VV = WS_XN + 16 * MiB, WS_QN = WS_QX, WS_KN = WS_QX + 16 * MiB;
constexpr size_t WS_ACT = WS_MIX, WS_HUP = WS_MIX + 88 * MiB, WS_END = 256 * MiB;
static_assert(WS_HUP + 88 * MiB <= WS_END && WS_GATE + 16 * MiB <= WS_QD && WS_QKM + 8 * MiB <= WS_END, "ws map");
constexpr int LDS_BYTES = 147456;

__device__ __forceinline__ float bf2f(unsigned v) { return __uint_as_float(v << 16); }
__device__ __forceinline__ unsigned f2bf(float f) { unsigned u = __float_as_uint(f); return (u + 0x7fffu + ((u >> 16) & 1u)) >> 16; }
__device__ __forceinline__ unsigned pk2(float lo, float hi) { return f2bf(lo) | (f2bf(hi) << 16); }
__device__ __forceinline__ float lo16(unsigned w) { return __uint_as_float(w << 16); }
__device__ __forceinline__ float hi16(unsigned w) { return __uint_as_float(w & 0xffff0000u); }
__device__ __forceinline__ float wave_sum(float v) {
#pragma unroll
    for (int o = 1; o < 64; o <<= 1) v += __shfl_xor(v, o);
    return v;
}
__device__ __forceinline__ float wave_max(float v) {
#pragma unroll
    for (int o = 1; o < 64; o <<= 1) v = fmaxf(v, __shfl_xor(v, o));
    return v;
}
__device__ __forceinline__ float silu_f(float x) { return x * __builtin_amdgcn_rcpf(1.0f + __expf(-x)); }
#define LDS_WAIT() asm volatile("s_waitcnt lgkmcnt(0)" ::: "memory")

struct Args { const float* in[27]; float* out; unsigned char* ws; int ph_lo, ph_hi; };
typedef const __attribute__((address_space(4))) Args* ArgsP;
#define GAS1 __attribute__((address_space(1)))
__device__ __forceinline__ const float* inp_ptr(ArgsP ap, int i) { GAS1 const float* g = (GAS1 const float*)ap->in[i]; asm volatile("" : "+s"(g)); return (const float*)g; }
__device__ __forceinline__ unsigned char* ws_ptr(ArgsP ap) { GAS1 unsigned char* g = (GAS1 unsigned char*)ap->ws; asm volatile("" : "+s"(g)); return (unsigned char*)g; }
#define INP(ap, i) inp_ptr((ap), (i))
enum { I_X = 0, I_MEM, I_MEMNORM, I_NMIX, I_NXATTN, I_NFFN, I_EVIN, I_POOLW, I_POOLS, I_EVOUT, I_ODIN, I_SGUG, I_SGUB, I_SGUW, I_SGUBS, I_DNCONV, I_DNALOG, I_DNDT, I_DNNG, I_ODOUT,
       I_WQ, I_WKV, I_WO, I_FUP, I_FCONV, I_FDN, I_FNORM };

struct Ctx { LAS unsigned char* lds; int tid, lane, wave, G, gw, ngw, gtid, nthr; };

__device__ __forceinline__ void transpose_item(const float* W, int ldw, int K, int ncols, bf16* WT, LAS float* scr, int item, int lane, const float* gain = nullptr, int guperm = 0) {
    const int nblk = ncols / 32, kb = item / nblk, nb = item % nblk, k0 = 64 * kb, n0 = 32 * nb;
#pragma unroll
    for (int i = 0; i < 8; ++i) { const int kk = 8 * i + (lane >> 3), c4 = lane & 7;
        const f32x4 v = *(const f32x4*)(W + (size_t)(k0 + kk) * ldw + n0 + 4 * c4); const float gk = gain ? gain[k0 + kk] : 1.0f;
        LAS float* d = scr + kk * 33 + 4 * c4; d[0] = v.x * gk; d[1] = v.y * gk; d[2] = v.z * gk; d[3] = v.w * gk; }
    LDS_WAIT();
    const int c = lane & 7;
    int drow = n0; if (guperm) { const int isu = n0 >= guperm ? 1 : 0, nn = n0 - isu * guperm; drow = 256 * (nn >> 7) + 128 * isu + (nn & 127); }
#pragma unroll
    for (int j = 0; j < 4; ++j) { const int n = (lane >> 3) + 8 * j; const LAS float* s = scr + (8 * c) * 33 + n;
        u32x4 o; o.x = pk2(s[0 * 33], s[1 * 33]); o.y = pk2(s[2 * 33], s[3 * 33]); o.z = pk2(s[4 * 33], s[5 * 33]); o.w = pk2(s[6 * 33], s[7 * 33]);
        *(u32x4*)(WT + (size_t)(drow + n) * K + k0 + 8 * c) = o; }
    LDS_WAIT();
}
__device__ __forceinline__ void convert_weights(const Ctx& C, ArgsP a, int L, int part, int gw0, int ngw0) {
    LAS float* scr = (LAS float*)(C.lds + C.wave * 16384);
    unsigned char* ws = ws_ptr(a);
    const float* w_in = L == 0 ? INP(a, I_EVIN) : INP(a, I_ODIN); const int n_in = L == 0 ? 2048 : 3072, ld_in = L == 0 ? 2048 : 3080;
    const float* w_out = L == 0 ? INP(a, I_EVOUT) : INP(a, I_ODOUT);
    const float* wq = INP(a, I_WQ) + (size_t)L * DM * DM; const float* wkv = INP(a, I_WKV) + (size_t)L * DM * 2 * DM; const float* wo = INP(a, I_WO) + (size_t)L * DM * DM;
    const float* wup = INP(a, I_FUP) + (size_t)L * DM * DFF2; const float* wdn = INP(a, I_FDN) + (size_t)L * DFF * DM;
    const int i0 = (DM / 64) * (n_in / 32), i1 = (DM / 64) * (DM / 32), i2 = i1, i3 = (DM / 64) * (2 * DM / 32), i4 = i1, i5 = (DM / 64) * (DFF2 / 32), i6 = (DFF / 64) * (DM / 32);
    const int total = i0 + i1 + i2 + i3 + i4 + i5 + i6;
    for (int it = gw0; it < total; it += ngw0) {
        int r = it;
        { const bool first = (r < i0 + i1) || (r >= i0 + i1 + i2 && r < i0 + i1 + i2 + i3); if ((part == 0 && !first) || (part == 1 && first)) continue; }
        if (r < i0) {
            if (L == 0) {
                const int ia = (DM / 64) * (1024 / 32), ib = (DM / 64) * (512 / 32);
                if (r < ia) transpose_item(w_in, ld_in, DM, 1024, (bf16*)(ws + W_IN), scr, r, C.lane);
                else if (r < ia + ib) transpose_item(w_in + 1536, ld_in, DM, 512, (bf16*)(ws + W_IN) + (size_t)1024 * DM, scr, r - ia, C.lane);
                else transpose_item(w_in + 1024, ld_in, DM, 512, (bf16*)(ws + W_IN) + (size_t)1536 * DM, scr, r - ia - ib, C.lane);
            } else transpose_item(w_in, ld_in, DM, n_in, (bf16*)(ws + W_IN), scr, r, C.lane);
            continue; } r -= i0;
        if (r < i1) { transpose_item(w_out, DM, DM, DM, (bf16*)(ws + W_OUT), scr, r, C.lane); continue; } r -= i1;
        if (r < i2) { transpose_item(wq, DM, DM, DM, (bf16*)(ws + W_Q), scr, r, C.lane, INP(a, I_NXATTN) + L * DM); continue; } r -= i2;
        if (r < i3) { transpose_item(wkv, 2 * DM, DM, 2 * DM, (bf16*)(ws + W_KV), scr, r, C.lane); continue; } r -= i3;
        if (r < i4) { transpose_item(wo, DM, DM, DM, (bf16*)(ws + W_O), scr, r, C.lane); continue; } r -= i4;
        if (r < i5) { transpose_item(wup, DFF2, DM, DFF2, (bf16*)(ws + W_UP), scr, r, C.lane, INP(a, I_NFFN) + L * DM, DFF); continue; } r -= i5;
        transpose_item(wdn, DM, DFF, DM, (bf16*)(ws + W_DN), scr, r, C.lane);
    }
    if (L == 0) for (int it = gw0; it < 32; it += ngw0) { const int g = it >> 3; transpose_item(INP(a, I_POOLW) + (size_t)g * 128 * 128, 128, 128, 128, (bf16*)(ws + WS_PWT) + (size_t)g * 128 * 128, scr, it & 7, C.lane); }
}
__device__ __forceinline__ void rms_row_bf16(const float* xrow, const float* gain, bf16* orow, int lane, bf16* orow2 = nullptr) {
    const f32x4* xr = (const f32x4*)xrow + lane; const f32x4* gr = (const f32x4*)gain + lane;
    f32x4 v[4]; float s = 0.f;
#pragma unroll
    for (int j = 0; j < 4; ++j) { v[j] = xr[64 * j]; s += (v[j].x * v[j].x + v[j].y * v[j].y) + (v[j].z * v[j].z + v[j].w * v[j].w); }
    const float r = 1.0f / sqrtf(wave_sum(s) * (1.0f / DM) + EPS);
    u32x2* o8 = (u32x2*)orow + lane;
#pragma unroll
    for (int j = 0; j < 4; ++j) { const f32x4 g = gr[64 * j]; u32x2 w; w.x = pk2(v[j].x * r * g.x, v[j].y * r * g.y); w.y = pk2(v[j].z * r * g.z, v[j].w * r * g.w); o8[64 * j] = w; if (orow2) ((u32x2*)orow2 + lane)[64 * j] = w; }
}
__device__ __forceinline__ int perm32k_pos(int s) { return (s < 16) ? (8 * (s >> 2) + (s & 3)) : (8 * ((s - 16) >> 2) + 4 + (s & 3)); }
__device__ __forceinline__ void rms_all_rows(const Ctx& C, const float* src, const float* gain, bf16* dst, int nrows, bf16* dstp = nullptr) {
    for (int m = C.gw; m < nrows; m += C.ngw) rms_row_bf16(src + (size_t)m * DM, gain, dst + (size_t)m * DM, C.lane, dstp ? dstp + (size_t)((m & ~31) + perm32k_pos(m & 31)) * DM : nullptr);
}
__device__ __forceinline__ void rms_rows_bg(const Ctx& C, ArgsP a, const bf16* HBin, bf16* XN, float* BG) {
    const float* gain = INP(a, I_NMIX) + DM; const float* W = INP(a, I_ODIN);
    const int lane = C.lane;
    for (int m = C.gw; m < NT; m += C.ngw) {
        const u32x2* xr = (const u32x2*)(HBin + (size_t)m * DM) + lane; const f32x4* gr = (const f32x4*)gain + lane;
        f32x4 v[4]; float s = 0.f;
#pragma unroll
        for (int j = 0; j < 4; ++j) { const u32x2 w_ = xr[64 * j]; v[j].x = lo16(w_.x); v[j].y = hi16(w_.x); v[j].z = lo16(w_.y); v[j].w = hi16(w_.y); s += (v[j].x * v[j].x + v[j].y * v[j].y) + (v[j].z * v[j].z + v[j].w * v[j].w); }
        const float r = 1.0f / sqrtf(wave_sum(s) * (1.0f / DM) + EPS);
        u32x2* o8 = (u32x2*)(XN + (size_t)m * DM) + lane;
        float d[8];
#pragma unroll
        for (int c = 0; c < 8; ++c) d[c] = 0.f;
#pragma unroll
        for (int j = 0; j < 4; ++j) { const f32x4 g = gr[64 * j]; f32x4 y; y.x = v[j].x * r * g.x; y.y = v[j].y * r * g.y; y.z = v[j].z * r * g.z; y.w = v[j].w * r * g.w;
            u32x2 w; w.x = pk2(y.x, y.y); w.y = pk2(y.z, y.w); o8[64 * j] = w;
#pragma unroll
            for (int e = 0; e < 4; ++e) { const int k = 4 * lane + 256 * j + e; const f32x4 w0 = *(const f32x4*)(W + (size_t)k * 3080 + 3072), w1 = *(const f32x4*)(W + (size_t)k * 3080 + 3076);
                const float ye = y[e]; d[0] += ye * w0.x; d[1] += ye * w0.y; d[2] += ye * w0.z; d[3] += ye * w0.w; d[4] += ye * w1.x; d[5] += ye * w1.y; d[6] += ye * w1.z; d[7] += ye * w1.w; } }
#pragma unroll
        for (int c = 0; c < 8; ++c) d[c] = wave_sum(d[c]);
        if (lane < 4) {
            const float braw = lane == 0 ? d[0] : lane == 1 ? d[1] : lane == 2 ? d[2] : d[3];
            const float araw = lane == 0 ? d[4] : lane == 1 ? d[5] : lane == 2 ? d[6] : d[7];
            const float beta = 1.0f / (1.0f + expf(-braw));
            const float xx = araw + INP(a, I_DNDT)[lane];
            const float sp = xx > 20.f ? xx : log1pf(expf(xx));
            BG[(size_t)m * 8 + lane] = beta; BG[(size_t)m * 8 + 4 + lane] = -expf(INP(a, I_DNALOG)[lane]) * sp;
        }
    }
}
__device__ __forceinline__ void final_norm(const Ctx& C, const bf16* HBin, float* out, const float* gain) {
    for (int m = C.gw; m < NT; m += C.ngw) {
        const u32x2* xr = (const u32x2*)(HBin + (size_t)m * DM) + C.lane; const f32x4* gr = (const f32x4*)gain + C.lane; f32x4* orow = (f32x4*)(out + (size_t)m * DM) + C.lane;
        f32x4 v[4]; float s = 0.f;
#pragma unroll
        for (int j = 0; j < 4; ++j) { const u32x2 w_ = xr[64 * j]; v[j].x = lo16(w_.x); v[j].y = hi16(w_.x); v[j].z = lo16(w_.y); v[j].w = hi16(w_.y); s += (v[j].x * v[j].x + v[j].y * v[j].y) + (v[j].z * v[j].z + v[j].w * v[j].w); }
        const float r = 1.0f / sqrtf(wave_sum(s) * (1.0f / DM) + EPS);
#pragma unroll
        for (int j = 0; j < 4; ++j) { const f32x4 g = gr[64 * j]; f32x4 y; y.x = v[j].x * r * g.x; y.y = v[j].y * r * g.y; y.z = v[j].z * r * g.z; y.w = v[j].w * r * g.w; orow[64 * j] = y; }
    }
}
__device__ __forceinline__ void kmean_pooled(const Ctx& C, const bf16* PROJ, float* KMEAN) {
    const int lane = C.lane, d4 = lane & 15, rq = lane >> 4;
    for (int it = C.gw; it < 2 * 8 * 32; it += C.ngw) {
        const int blk = it & 31, h = (it >> 5) & 7, b = it >> 8;
        const bf16* p = PROJ + (size_t)(b * SEQ + blk * 256 + rq * 64) * 1536 + 512 + h * 64 + 4 * d4; float s0 = 0.f, s1 = 0.f, s2 = 0.f, s3 = 0.f;
#pragma unroll 8
        for (int r = 0; r < 64; ++r) { const u32x2 w = *(const u32x2*)(p + (size_t)r * 1536); s0 += lo16(w.x); s1 += hi16(w.x); s2 += lo16(w.y); s3 += hi16(w.y); }
        s0 += __shfl_xor(s0, 16); s1 += __shfl_xor(s1, 16); s2 += __shfl_xor(s2, 16); s3 += __shfl_xor(s3, 16);
        s0 += __shfl_xor(s0, 32); s1 += __shfl_xor(s1, 32); s2 += __shfl_xor(s2, 32); s3 += __shfl_xor(s3, 32);
        if (rq == 0) { f32x4 o; o.x = s0 * (1.0f / 256.0f); o.y = s1 * (1.0f / 256.0f); o.z = s2 * (1.0f / 256.0f); o.w = s3 * (1.0f / 256.0f); *(f32x4*)(KMEAN + (size_t)it * 64 + 4 * d4) = o; }
    }
}
__device__ __forceinline__ void unpack8(const u32x4 w, float* f) { f[0] = lo16(w.x); f[1] = hi16(w.x); f[2] = lo16(w.y); f[3] = hi16(w.y); f[4] = lo16(w.z); f[5] = hi16(w.z); f[6] = lo16(w.w); f[7] = hi16(w.w); }
__device__ __forceinline__ void moba_naive(const Ctx& C, const bf16* PROJ, const float* KMEAN, bf16* MIX) {
    for (int idx = C.gtid; idx < 2 * 8 * SEQ; idx += C.nthr) {
        const int t = idx & (SEQ - 1), bh = idx >> 13, h = bh & 7, b = bh >> 3, row = b * SEQ + t, qb = t >> 8;
        float q[64];
        { const u32x4* qp = (const u32x4*)(PROJ + (size_t)row * 2048 + h * 64);
#pragma unroll
          for (int i = 0; i < 8; ++i) unpack8(qp[i], q + 8 * i); }
        float b0 = -INFINITY, b1 = -INFINITY, b2 = -INFINITY; int i0 = -1, i1 = -1, i2 = -1;
        const float* km = KMEAN + (size_t)bh * 32 * 64;
        for (int j = 0; j < qb; ++j) { float s = 0.f;
#pragma unroll
            for (int d = 0; d < 64; ++d) s += q[d] * km[j * 64 + d];
            if (s > b0) { b2 = b1; i2 = i1; b1 = b0; i1 = i0; b0 = s; i0 = j; } else if (s > b1) { b2 = b1; i2 = i1; b1 = s; i1 = j; } else if (s > b2) { b2 = s; i2 = j; } }
        float m = -INFINITY, l = 0.f, o[64];
#pragma unroll
        for (int d = 0; d < 64; ++d) o[d] = 0.f;
        for (int si = 0; si < 4; ++si) {
            const int blk = si == 0 ? i0 : si == 1 ? i1 : si == 2 ? i2 : qb;
            if (blk < 0) continue;
            const int nk = (si == 3) ? (t - qb * 256 + 1) : 256;
            const bf16* kp = PROJ + (size_t)(b * SEQ + blk * 256) * 2048 + 512 + h * 64;
            for (int kk = 0; kk < nk; ++kk) {
                const u32x4* kr = (const u32x4*)(kp + (size_t)kk * 2048); const u32x4* vr = (const u32x4*)(kp + (size_t)kk * 2048 + 512);
                float s = 0.f;
#pragma unroll
                for (int i = 0; i < 8; ++i) { float f[8]; unpack8(kr[i], f);
#pragma unroll
                    for (int e = 0; e < 8; ++e) s += q[8 * i + e] * f[e]; }
                s *= 0.125f;
                const float mn = fmaxf(m, s), corr = __expf(m - mn), p = __expf(s - mn);
                l = l * corr + p; m = mn;
#pragma unroll
                for (int i = 0; i < 8; ++i) { float f[8]; unpack8(vr[i], f);
#pragma unroll
                    for (int e = 0; e < 8; ++e) o[8 * i + e] = o[8 * i + e] * corr + p * f[e]; }
            }
        }
        const float il = 1.0f / l; u32x4* op = (u32x4*)(MIX + (size_t)row * 1024 + h * 64);
#pragma unroll
        for (int i = 0; i < 8; ++i) { u32x4 w; w.x = pk2(o[8 * i] * il, o[8 * i + 1] * il); w.y = pk2(o[8 * i + 2] * il, o[8 * i + 3] * il); w.z = pk2(o[8 * i + 4] * il, o[8 * i + 5] * il); w.w = pk2(o[8 * i + 6] * il, o[8 * i + 7] * il); op[i] = w; }
    }
}
__device__ __forceinline__ void pool_linear_naive(const Ctx& C, const bf16* POOLED, const float* pool_w, const float* pool_scale, bf16* MIX) {
    for (size_t idx = C.gtid; idx < (size_t)NT * 512; idx += C.nthr) {
        const int co = (int)(idx & 511), row = (int)(idx >> 9), g = co >> 7, d = co & 127;
        const bf16* pp = POOLED + (size_t)row * 512 + g * 128; const float* w = pool_w + (size_t)g * 128 * 128 + d; float s = 0.f;
        for (int c = 0; c < 128; ++c) s += bf2f(pp[c]) * w[(size_t)c * 128];
        MIX[(size_t)row * 1024 + 512 + co] = (bf16)f2bf(s * pool_scale[co]);
    }
}
__device__ __forceinline__ void xattn_naive(const Ctx& C, const bf16* QX, const bf16* KVX, bf16* OX) {
    LAS float* qs = (LAS float*)(C.lds + C.wave * 2048); LAS float* ps = qs + 256; const int lane = C.lane;
    for (int it = C.gw; it < NT * 4; it += C.ngw) {
        const int row = it >> 2, hd = it & 3, b = row >> 13;
        { const u32x2 w = *((const u32x2*)(QX + (size_t)row * 1024 + hd * 256) + lane); qs[4 * lane] = lo16(w.x); qs[4 * lane + 1] = hi16(w.x); qs[4 * lane + 2] = lo16(w.y); qs[4 * lane + 3] = hi16(w.y); }
        LDS_WAIT();
        float s[4];
#pragma unroll
        for (int i = 0; i < 4; ++i) { const int j = lane + 64 * i; const u32x4* kr = (const u32x4*)(KVX + (size_t)(b * NMEM + j) * 2048 + hd * 256); float acc = 0.f;
            for (int d8 = 0; d8 < 32; ++d8) { float f[8]; unpack8(kr[d8], f); const f32x4 qa = *(const LAS f32x4*)(qs + 8 * d8), qb = *(const LAS f32x4*)(qs + 8 * d8 + 4);
                acc += f[0] * qa.x + f[1] * qa.y + f[2] * qa.z + f[3] * qa.w + f[4] * qb.x + f[5] * qb.y + f[6] * qb.z + f[7] * qb.w; }
            s[i] = acc * 0.0625f; }
        const float mx = wave_max(fmaxf(fmaxf(s[0], s[1]), fmaxf(s[2], s[3])));
        float p[4], sum = 0.f;
#pragma unroll
        for (int i = 0; i < 4; ++i) { p[i] = __expf(s[i] - mx); sum += p[i]; }
        sum = wave_sum(sum); const float inv = 1.0f / sum;
#pragma unroll
        for (int i = 0; i < 4; ++i) ps[lane + 64 * i] = p[i] * inv;
        LDS_WAIT();
        float o0 = 0.f, o1 = 0.f, o2 = 0.f, o3 = 0.f; const bf16* vb = KVX + (size_t)(b * NMEM) * 2048 + 1024 + hd * 256 + 4 * lane;
        for (int j = 0; j < 256; ++j) { const float pj = ps[j]; const u32x2 w = *(const u32x2*)(vb + (size_t)j * 2048); o0 += pj * lo16(w.x); o1 += pj * hi16(w.x); o2 += pj * lo16(w.y); o3 += pj * hi16(w.y); }
        u32x2 w; w.x = pk2(o0, o1); w.y = pk2(o2, o3); *((u32x2*)(OX + (size_t)row * 1024 + hd * 256) + lane) = w;
        LDS_WAIT();
    }
}
__device__ __forceinline__ void ffn_act(const Ctx& C, const bf16* HUP, const float* cw, bf16* ACT, int hb) {
    for (int idx = C.gtid; idx < (SEQ / 8) * 352; idx += C.nthr) {
        const int c8 = idx % 352, rb = idx / 352, c = c8 * 8, t0 = rb * 8;
        float wg[3][8], wu[3][8];
#pragma unroll
        for (int k = 0; k < 3; ++k) { const f32x4 a0 = *(const f32x4*)(cw + (size_t)k * DFF2 + c), a1 = *(const f32x4*)(cw + (size_t)k * DFF2 + c + 4), b0 = *(const f32x4*)(cw + (size_t)k * DFF2 + DFF + c), b1 = *(const f32x4*)(cw + (size_t)k * DFF2 + DFF + c + 4);
            wg[k][0] = a0.x; wg[k][1] = a0.y; wg[k][2] = a0.z; wg[k][3] = a0.w; wg[k][4] = a1.x; wg[k][5] = a1.y; wg[k][6] = a1.z; wg[k][7] = a1.w;
            wu[k][0] = b0.x; wu[k][1] = b0.y; wu[k][2] = b0.z; wu[k][3] = b0.w; wu[k][4] = b1.x; wu[k][5] = b1.y; wu[k][6] = b1.z; wu[k][7] = b1.w; }
        float g0[8], g1[8], u0[8], u1[8];
        if (t0 >= 2) { unpack8(*(const u32x4*)(HUP + (size_t)(t0 - 2) * DFF2 + c), g0); unpack8(*(const u32x4*)(HUP + (size_t)(t0 - 2) * DFF2 + DFF + c), u0);
                       unpack8(*(const u32x4*)(HUP + (size_t)(t0 - 1) * DFF2 + c), g1); unpack8(*(const u32x4*)(HUP + (size_t)(t0 - 1) * DFF2 + DFF + c), u1); }
        else {
#pragma unroll
            for (int e = 0; e < 8; ++e) { g0[e] = 0.f; g1[e] = 0.f; u0[e] = 0.f; u1[e] = 0.f; } }
#pragma unroll
        for (int r = 0; r < 8; ++r) {
            float g2[8], u2[8]; unpack8(*(const u32x4*)(HUP + (size_t)(t0 + r) * DFF2 + c), g2); unpack8(*(const u32x4*)(HUP + (size_t)(t0 + r) * DFF2 + DFF + c), u2);
            float o[8];
#pragma unroll
            for (int e = 0; e < 8; ++e) { const float gv = wg[0][e] * g0[e] + wg[1][e] * g1[e] + wg[2][e] * g2[e], uv = wu[0][e] * u0[e] + wu[1][e] * u1[e] + wu[2][e] * u2[e]; o[e] = silu_f(gv) * uv; }
            u32x4 w; w.x = pk2(o[0], o[1]); w.y = pk2(o[2], o[3]); w.z = pk2(o[4], o[5]); w.w = pk2(o[6], o[7]);
            *(u32x4*)(ACT + (size_t)(hb * SEQ + t0 + r) * DFF + c) = w;
#pragma unroll
            for (int e = 0; e < 8; ++e) { g0[e] = g1[e]; g1[e] = g2[e]; u0[e] = u1[e]; u1[e] = u2[e]; }
        }
    }
}
__device__ __forceinline__ void l1_prep_naive(const Ctx& C, ArgsP a, const bf16* Z, const bf16* QKV, bf16* VN, bf16* QN, bf16* KN, bf16* VV) {
    const int lane = C.lane;
    const float* lng = INP(a, I_SGUG); const float* lnb = INP(a, I_SGUB); const float* cw = INP(a, I_DNCONV);
    for (int row = C.gw; row < NT; row += C.ngw) {
        float f[8]; unpack8(*((const u32x4*)(Z + (size_t)row * 1024 + 512) + lane), f);
        float s = 0.f;
#pragma unroll
        for (int e = 0; e < 8; ++e) s += f[e];
        const float mu = wave_sum(s) * (1.0f / 512.0f); float q = 0.f;
#pragma unroll
        for (int e = 0; e < 8; ++e) { f[e] -= mu; q += f[e] * f[e]; }
        const float rstd = 1.0f / sqrtf(wave_sum(q) * (1.0f / 512.0f) + EPS);
        const f32x4 g0 = *((const f32x4*)lng + 2 * lane), g1 = *((const f32x4*)lng + 2 * lane + 1), c0 = *((const f32x4*)lnb + 2 * lane), c1 = *((const f32x4*)lnb + 2 * lane + 1);
        u32x4 w; w.x = pk2(f[0] * rstd * g0.x + c0.x, f[1] * rstd * g0.y + c0.y); w.y = pk2(f[2] * rstd * g0.z + c0.z, f[3] * rstd * g0.w + c0.w);
        w.z = pk2(f[4] * rstd * g1.x + c1.x, f[5] * rstd * g1.y + c1.y); w.w = pk2(f[6] * rstd * g1.z + c1.z, f[7] * rstd * g1.w + c1.w);
        { bf16* vt = VN + ((size_t)(row >> 7) * 512 + 8 * lane) * 128 + (row & 127);
          vt[0] = (bf16)(w.x & 0xffffu); vt[128] = (bf16)(w.x >> 16); vt[256] = (bf16)(w.y & 0xffffu); vt[384] = (bf16)(w.y >> 16);
          vt[512] = (bf16)(w.z & 0xffffu); vt[640] = (bf16)(w.z >> 16); vt[768] = (bf16)(w.w & 0xffffu); vt[896] = (bf16)(w.w >> 16); }
    }
    for (int it = C.gw; it < NT * 4; it += C.ngw) {
        const int row = it >> 2, hh = it & 3, tl = row & (SEQ - 1), c = hh * 128 + 2 * lane;
        float y[3][2];
#pragma unroll
        for (int s3 = 0; s3 < 3; ++s3) { const int cs = s3 * 512 + c; float a0 = 0.f, a1 = 0.f;
#pragma unroll
            for (int j = 0; j < 4; ++j) { const int ts = tl - 3 + j; if (ts < 0) continue;
                const unsigned w = *(const unsigned*)(QKV + (size_t)(row - 3 + j) * 1536 + cs); a0 += cw[j * 1536 + cs] * lo16(w); a1 += cw[j * 1536 + cs + 1] * hi16(w); }
            y[s3][0] = silu_f(a0); y[s3][1] = silu_f(a1); }
        const float rq = 1.0f / sqrtf(wave_sum(y[0][0] * y[0][0] + y[0][1] * y[0][1]) + EPS) * 0.08838834764831845f;
        const float rk = 1.0f / sqrtf(wave_sum(y[1][0] * y[1][0] + y[1][1] * y[1][1]) + EPS);
        *(unsigned*)(QN + (size_t)row * 512 + c) = pk2(y[0][0] * rq, y[0][1] * rq);
        *(unsigned*)(KN + (size_t)row * 512 + c) = pk2(y[1][0] * rk, y[1][1] * rk);
        *(unsigned*)(VV + (size_t)row * 512 + c) = pk2(y[2][0], y[2][1]);
    }
}
__device__ __forceinline__ void sgu_naive(const Ctx& C, ArgsP a, const bf16* Z, const bf16* VN, bf16* MIX, int blk0, int nblk) {
    const float* sw = INP(a, I_SGUW); const float* sb = INP(a, I_SGUBS);
    const size_t start = (size_t)(blockIdx.x - blk0) * 512 + C.tid, stride = (size_t)nblk * 512;
    for (size_t idx = start; idx < (size_t)NT * 512; idx += stride) {
        const int ch = (int)(idx & 511), row = (int)(idx >> 9), g = ch >> 7, tl = row & 127, r0 = row & ~127;
        const float* w = sw + (size_t)(g * 128 + tl) * 128; const bf16* vp = VN + (size_t)r0 * 512 + ch; float s = 0.f;
        for (int k = 0; k <= tl; ++k) s += w[k] * bf2f(vp[(size_t)k * 512]);
        s += sb[g * 128 + tl];
        MIX[(size_t)row * 1024 + ch] = (bf16)f2bf(bf2f(Z[(size_t)row * 1024 + ch]) * s);
    }
}
__device__ __forceinline__ void dn_recurrent(const Ctx& C, const bf16* QN, const bf16* KN, const bf16* VV, const float* BG, float* O, int bh) {
    const int b = bh >> 2, hh = bh & 3, dv = C.tid & 127, g4 = C.tid >> 7;
    LAS float* red1 = (LAS float*)C.lds; LAS float* red2 = red1 + 512;
    float S[32];
#pragma unroll
    for (int i = 0; i < 32; ++i) S[i] = 0.f;
    for (int t = 0; t < SEQ; ++t) {
        const size_t row = (size_t)b * SEQ + t;
        const u32x4* kp = (const u32x4*)(KN + row * 512 + hh * 128 + 32 * g4); const u32x4* qp = (const u32x4*)(QN + row * 512 + hh * 128 + 32 * g4);
        float kk[32], qq[32];
#pragma unroll
        for (int i = 0; i < 4; ++i) { unpack8(kp[i], kk + 8 * i); unpack8(qp[i], qq + 8 * i); }
        const float vv = bf2f(VV[row * 512 + hh * 128 + dv]), beta = BG[row * 8 + hh], av = __expf(BG[row * 8 + 4 + hh]);
        float part = 0.f;
#pragma unroll
        for (int i = 0; i < 32; ++i) part += kk[i] * S[i];
        red1[g4 * 128 + dv] = part; __syncthreads();
        const float kS = (red1[dv] + red1[128 + dv]) + (red1[256 + dv] + red1[384 + dv]);
        const float vnew = beta * (vv - av * kS);
        float op = 0.f;
#pragma unroll
        for (int i = 0; i < 32; ++i) { S[i] = av * S[i] + kk[i] * vnew; op += qq[i] * S[i]; }
        red2[g4 * 128 + dv] = op; __syncthreads();
        if (g4 == 0) O[row * 512 + hh * 128 + dv] = (red2[dv] + red2[128 + dv]) + (red2[256 + dv] + red2[384 + dv]);
    }
    __syncthreads();
}
__device__ __forceinline__ void dn_out_gate(const Ctx& C, ArgsP a, const float* O, const bf16* GATE, bf16* MIX) {
    const float* ng = INP(a, I_DNNG); const int lane = C.lane;
    const f32x4 n0 = *(const f32x4*)(ng + ((8 * lane) & 127)), n1 = *(const f32x4*)(ng + ((8 * lane) & 127) + 4);
    for (int row = C.gw; row < NT; row += C.ngw) {
        const f32x4 o0 = *((const f32x4*)(O + (size_t)row * 512) + 2 * lane), o1 = *((const f32x4*)(O + (size_t)row * 512) + 2 * lane + 1);
        float ss = ((o0.x * o0.x + o0.y * o0.y) + (o0.z * o0.z + o0.w * o0.w)) + ((o1.x * o1.x + o1.y * o1.y) + (o1.z * o1.z + o1.w * o1.w));
        ss += __shfl_xor(ss, 1); ss += __shfl_xor(ss, 2); ss += __shfl_xor(ss, 4); ss += __shfl_xor(ss, 8);
        const float r = 1.0f / sqrtf(ss * (1.0f / 128.0f) + EPS);
        float g[8]; unpack8(*((const u32x4*)(GATE + (size_t)row * 512) + lane), g);
        u32x4 w; w.x = pk2(o0.x * r * n0.x * silu_f(g[0]), o0.y * r * n0.y * silu_f(g[1])); w.y = pk2(o0.z * r * n0.z * silu_f(g[2]), o0.w * r * n0.w * silu_f(g[3]));
        w.z = pk2(o1.x * r * n1.x * silu_f(g[4]), o1.y * r * n1.y * silu_f(g[5])); w.w = pk2(o1.z * r * n1.z * silu_f(g[6]), o1.w * r * n1.w * silu_f(g[7]));
        *((u32x4*)(MIX + (size_t)row * 1024 + 512) + lane) = w;
    }
}
typedef short bf16x8 __attribute__((ext_vector_type(8)));
#define MFMA16(a, b, c) __builtin_amdgcn_mfma_f32_16x16x32_bf16((a), (b), (c), 0, 0, 0)
__device__ __forceinline__ float rdlane(float v, int i) { return __uint_as_float(__builtin_amdgcn_readlane(__float_as_uint(v), i)); }
#define WG_BAR() do { asm volatile("s_waitcnt vmcnt(0) lgkmcnt(0)" ::: "memory"); __builtin_amdgcn_s_barrier(); asm volatile("" ::: "memory"); } while (0)
#define LDS_BAR() do { asm volatile("s_waitcnt lgkmcnt(0)" ::: "memory"); __builtin_amdgcn_s_barrier(); asm volatile("" ::: "memory"); } while (0)

__device__ __forceinline__ void dn_chunk_prep(const Ctx& C, const bf16* QN, const bf16* KN, const bf16* VV, const float* BG, bf16* U, bf16* Wm, bf16* QD, bf16* KDT, bf16* QKm, float* GL) {
    LAS float* Am = (LAS float*)(C.lds + C.wave * 16384);
    const int lane = C.lane, fr = lane & 15, fq = lane >> 4;
    for (int it4 = C.gw; it4 < 4096; it4 += C.ngw) {
        const int it = it4 >> 2, ps = it4 & 3;
        const int n = it & 127, hh = (it >> 7) & 3, b = it >> 9;
        const size_t row0 = (size_t)b * SEQ + (size_t)n * 64;
        const float beta = BG[(row0 + lane) * 8 + hh], gg = BG[(row0 + lane) * 8 + 4 + hh];
        float gc = gg;
#pragma unroll
        for (int o = 1; o < 64; o <<= 1) { const float t = __shfl_up(gc, o); if (lane >= o) gc += t; }
        const float gcl = rdlane(gc, 63);
        const bf16* Kb = KN + row0 * 512 + hh * 128; const bf16* Qb = QN + row0 * 512 + hh * 128; const bf16* Vb = VV + row0 * 512 + hh * 128;
        bf16* qkm = QKm + (size_t)it * 4096;
#pragma unroll 1
        for (int mt = 0; mt < 4; ++mt) {
            bf16x8 ak[4], aq[4];
#pragma unroll
            for (int ks = 0; ks < 4; ++ks) { ak[ks] = *(const bf16x8*)(Kb + (size_t)(16 * mt + fr) * 512 + 32 * ks + 8 * fq); aq[ks] = *(const bf16x8*)(Qb + (size_t)(16 * mt + fr) * 512 + 32 * ks + 8 * fq); }
#pragma unroll 1
            for (int nt = 0; nt < 4; ++nt) {
                const int j = 16 * nt + fr;
                if (nt > mt) {
                    if (ps == 0) {
#pragma unroll
                        for (int r = 0; r < 4; ++r) qkm[(16 * mt + 4 * fq + r) * 64 + j] = 0; }
                    continue;
                }
                f32x4 ckk = {0.f, 0.f, 0.f, 0.f}, cqk = {0.f, 0.f, 0.f, 0.f};
#pragma unroll
                for (int ks = 0; ks < 4; ++ks) { const bf16x8 bk = *(const bf16x8*)(Kb + (size_t)(16 * nt + fr) * 512 + 32 * ks + 8 * fq); ckk = MFMA16(ak[ks], bk, ckk); cqk = MFMA16(aq[ks], bk, cqk); }
                const float gj = __shfl(gc, j);
#pragma unroll
                for (int r = 0; r < 4; ++r) { const int i = 16 * mt + 4 * fq + r; const float gi = __shfl(gc, i), bi = __shfl(beta, i);
                    const float dec = (i >= j) ? __expf(gi - gj) : 0.f;
                    Am[i * 64 + j] = (i > j) ? bi * ckk[r] * dec : 0.f;
                    if (ps == 0) qkm[i * 64 + j] = (bf16)f2bf((i >= j) ? cqk[r] * dec : 0.f); }
            }
        }
        LDS_WAIT();
        { const int p = ps;
            const int c = lane + 64 * (p & 1); const bf16* src = (p < 2 ? Vb : Kb) + c; bf16* dst = (p < 2 ? U : Wm) + (size_t)it * 8192 + c;
            float x[64];
#pragma unroll
            for (int i = 0; i < 64; ++i) { const float bi = rdlane(beta, i), gi = rdlane(gc, i); x[i] = bf2f(src[(size_t)i * 512]) * (p < 2 ? bi : bi * __expf(gi)); if ((i & 7) == 7) __builtin_amdgcn_sched_barrier(0); }
#pragma unroll
            for (int i = 1; i < 64; ++i) {
                float acc = x[i];
#pragma unroll
                for (int j4 = 0; j4 < (i + 3) / 4; ++j4) { const f32x4 av = *(const LAS f32x4*)(Am + i * 64 + 4 * j4);
                    if (4 * j4 + 0 < i) acc -= av.x * x[4 * j4 + 0];
                    if (4 * j4 + 1 < i) acc -= av.y * x[4 * j4 + 1];
                    if (4 * j4 + 2 < i) acc -= av.z * x[4 * j4 + 2];
                    if (4 * j4 + 3 < i) acc -= av.w * x[4 * j4 + 3]; }
                x[i] = acc;
                if ((i & 3) == 3) asm volatile("" ::: "memory");
            }
#pragma unroll
            for (int i = 0; i < 64; ++i) dst[(size_t)i * 128] = (bf16)f2bf(x[i]);
        }
        bf16* qd = QD + (size_t)it * 8192;
        if (ps == 1)
#pragma unroll 4
        for (int i = 0; i < 64; ++i) { const float e = __expf(__shfl(gc, i)); const unsigned w = *(const unsigned*)(Qb + (size_t)i * 512 + 2 * lane); *(unsigned*)(qd + i * 128 + 2 * lane) = pk2(lo16(w) * e, hi16(w) * e); }
        bf16* kdt = KDT + (size_t)it * 8192; const float ek = __expf(gcl - gc);
        if (ps == 2)
#pragma unroll 2
        for (int d8 = 0; d8 < 16; ++d8) { float f[8]; unpack8(*(const u32x4*)(Kb + (size_t)lane * 512 + 8 * d8), f);
#pragma unroll
            for (int e = 0; e < 8; ++e) kdt[(8 * d8 + e) * 64 + lane] = (bf16)f2bf(f[e] * ek); }
        if (ps == 3 && lane == 0) GL[it] = __expf(gcl);
        LDS_WAIT();
    }
}
constexpr int SB_LD = 136, VN_LD = 72;
__device__ __forceinline__ void dn_scan(const Ctx& C, const bf16* U, const bf16* Wm, const bf16* QD, const bf16* KDT, const bf16* QKm, const float* GL, float* O, int it) {
    const int bh = it & 7, sl = it >> 3, hh = bh & 3, b = bh >> 2, dv0 = sl * 16;
    LAS bf16* SbT = (LAS bf16*)C.lds;
    LAS bf16* VnT = (LAS bf16*)(C.lds + 16384);
    LAS float* glb = (LAS float*)(C.lds + 24576);
    for (int i = C.tid; i < 2 * 16 * SB_LD / 2; i += 512) ((LAS unsigned*)SbT)[i] = 0u;
    if (C.tid < 128) glb[C.tid] = GL[(size_t)(it & 7) * 128 + C.tid];
    __syncthreads();
    const int w = C.wave, lane = C.lane, fr = lane & 15, fq = lane >> 4;
    f32x4 S0 = {0.f, 0.f, 0.f, 0.f}, S1 = S0;
    const size_t item0 = (size_t)bh * 128;
    if (w < 4) {
        bf16x8 cw[4][4], ck[4][4]; float cu[4][4];
#define DN_LOAD_A(set, st) do { const size_t it_ = item0 + (st); \
            const bf16* wp_ = Wm + (it_ * 64 + 16 * w + fr) * 128 + 8 * fq; const bf16* up_ = U + (it_ * 64 + 16 * w + 4 * fq) * 128 + dv0 + fr; const bf16* kp_ = KDT + (it_ * 128 + 32 * w + fr) * 64 + 8 * fq; \
            _Pragma("unroll") for (int ks = 0; ks < 4; ++ks) cw[set][ks] = *(const bf16x8*)(wp_ + 32 * ks); \
            _Pragma("unroll") for (int r = 0; r < 4; ++r) cu[set][r] = bf2f(up_[r * 128]); \
            ck[set][0] = *(const bf16x8*)(kp_); ck[set][1] = *(const bf16x8*)(kp_ + 32); ck[set][2] = *(const bf16x8*)(kp_ + 16 * 64); ck[set][3] = *(const bf16x8*)(kp_ + 16 * 64 + 32); } while (0)
        DN_LOAD_A(0, 0); DN_LOAD_A(1, 1); DN_LOAD_A(2, 2);
        for (int n0 = 0; n0 < 128; n0 += 4) {
#pragma unroll
            for (int k = 0; k < 4; ++k) {
                const int n = n0 + k, ns = (n + 3 < 128) ? n + 3 : 127;
                DN_LOAD_A((k + 3) & 3, ns);
                LAS bf16* Sc = SbT + (k & 1) * 16 * SB_LD; LAS bf16* Sn = SbT + ((k & 1) ^ 1) * 16 * SB_LD;
                f32x4 t1 = {0.f, 0.f, 0.f, 0.f};
                { bf16x8 sb[4];
#pragma unroll
                  for (int ks = 0; ks < 4; ++ks) sb[ks] = *(const LAS bf16x8*)(Sc + fr * SB_LD + 32 * ks + 8 * fq);
                  __builtin_amdgcn_sched_barrier(0);
#pragma unroll
                  for (int ks = 0; ks < 4; ++ks) t1 = MFMA16(cw[k][ks], sb[ks], t1); }
                u32x2 pw; pw.x = pk2(cu[k][0] - t1[0], cu[k][1] - t1[1]); pw.y = pk2(cu[k][2] - t1[2], cu[k][3] - t1[3]);
                *(LAS u32x2*)(VnT + fr * VN_LD + 16 * w + 4 * fq) = pw;
                LDS_BAR();
                bf16x8 vb[2];
                { const float gl = glb[n]; S0 = S0 * gl; S1 = S1 * gl; }
#pragma unroll
                for (int ks = 0; ks < 2; ++ks) vb[ks] = *(const LAS bf16x8*)(VnT + fr * VN_LD + 32 * ks + 8 * fq);
                __builtin_amdgcn_sched_barrier(0);
#pragma unroll
                for (int ks = 0; ks < 2; ++ks) { S0 = MFMA16(ck[k][ks], vb[ks], S0); S1 = MFMA16(ck[k][2 + ks], vb[ks], S1); }
                u32x2 s0; s0.x = pk2(S0[0], S0[1]); s0.y = pk2(S0[2], S0[3]); u32x2 s1; s1.x = pk2(S1[0], S1[1]); s1.y = pk2(S1[2], S1[3]);
                *(LAS u32x2*)(Sn + fr * SB_LD + 32 * w + 4 * fq) = s0; *(LAS u32x2*)(Sn + fr * SB_LD + 32 * w + 16 + 4 * fq) = s1;
                LDS_BAR();
            }
        }
#undef DN_LOAD_A
    } else {
        const int w2 = w - 4;
        bf16x8 cq[4][4], cm[4][2];
#define DN_LOAD_B(set, st) do { const size_t it_ = item0 + (st); const bf16* qp_ = QD + (it_ * 64 + 16 * w2 + fr) * 128 + 8 * fq; const bf16* mp_ = QKm + (it_ * 64 + 16 * w2 + fr) * 64 + 8 * fq; \
            _Pragma("unroll") for (int ks = 0; ks < 4; ++ks) cq[set][ks] = *(const bf16x8*)(qp_ + 32 * ks); \
            cm[set][0] = *(const bf16x8*)(mp_); cm[set][1] = *(const bf16x8*)(mp_ + 32); } while (0)
        DN_LOAD_B(0, 0); DN_LOAD_B(1, 1); DN_LOAD_B(2, 2);
        for (int n0 = 0; n0 < 128; n0 += 4) {
#pragma unroll
            for (int k = 0; k < 4; ++k) {
                const int n = n0 + k, ns = (n + 3 < 128) ? n + 3 : 127;
                DN_LOAD_B((k + 3) & 3, ns);
                LAS bf16* Sc = SbT + (k & 1) * 16 * SB_LD;
                f32x4 o = {0.f, 0.f, 0.f, 0.f};
                { bf16x8 sb[4];
#pragma unroll
                  for (int ks = 0; ks < 4; ++ks) sb[ks] = *(const LAS bf16x8*)(Sc + fr * SB_LD + 32 * ks + 8 * fq);
                  __builtin_amdgcn_sched_barrier(0);
#pragma unroll
                  for (int ks = 0; ks < 4; ++ks) o = MFMA16(cq[k][ks], sb[ks], o); }
                LDS_BAR();
                o = MFMA16(cm[k][0], *(const LAS bf16x8*)(VnT + fr * VN_LD + 8 * fq), o);
                o = MFMA16(cm[k][1], *(const LAS bf16x8*)(VnT + fr * VN_LD + 32 + 8 * fq), o);
                float* op = O + ((size_t)b * SEQ + (size_t)n * 64 + 16 * w2 + 4 * fq) * 512 + hh * 128 + dv0 + fr;
                op[0] = o[0]; op[512] = o[1]; op[1024] = o[2]; op[1536] = o[3];
                LDS_BAR();
            }
        }
#undef DN_LOAD_B
    }
    __syncthreads();
}
__device__ __forceinline__ int perm32k_inv(int s) { return (s < 16) ? (8 * (s >> 2) + (s & 3)) : (8 * ((s - 16) >> 2) + 4 + (s & 3)); }
__device__ __forceinline__ bf16x8 pack_p(const f32x4 a, const f32x4 b) { u32x4 w; w.x = pk2(a[0], a[1]); w.y = pk2(a[2], a[3]); w.z = pk2(b[0], b[1]); w.w = pk2(b[2], b[3]); return __builtin_bit_cast(bf16x8, w); }

__device__ __forceinline__ void xattn_mfma(const Ctx& C, const bf16* QX, const bf16* KX, const bf16* VXT, bf16* OX) {
    const int lane = C.lane, fr = lane & 15, fq = lane >> 4;
    for (int it = C.gw; it < (NT / 16) * 4; it += C.ngw) {
        const int hd = it & 3, qt = it >> 2, row0 = qt * 16, b = row0 >> 13;
        bf16x8 qf[8];
        const bf16* qp = QX + (size_t)(row0 + fr) * 1024 + hd * 256 + 8 * fq;
#pragma unroll
        for (int ks = 0; ks < 8; ++ks) qf[ks] = *(const bf16x8*)(qp + 32 * ks);
        f32x4 st[16];
        const bf16* kp = KX + (size_t)(b * NMEM + fr) * 1024 + hd * 256 + 8 * fq;
#pragma unroll
        for (int kt = 0; kt < 16; ++kt) { f32x4 acc = {0.f, 0.f, 0.f, 0.f};
#pragma unroll
            for (int ks = 0; ks < 8; ++ks) acc = MFMA16(*(const bf16x8*)(kp + (size_t)kt * 16 * 1024 + 32 * ks), qf[ks], acc);
            st[kt] = acc; }
        float mx = -INFINITY;
#pragma unroll
        for (int kt = 0; kt < 16; ++kt) mx = fmaxf(mx, fmaxf(fmaxf(st[kt][0], st[kt][1]), fmaxf(st[kt][2], st[kt][3])));
        mx = fmaxf(mx, __shfl_xor(mx, 16)); mx = fmaxf(mx, __shfl_xor(mx, 32));
        float sum = 0.f; const float mxs = mx * 0.0625f;
#pragma unroll
        for (int kt = 0; kt < 16; ++kt) {
#pragma unroll
            for (int r = 0; r < 4; ++r) { const float p = __expf(st[kt][r] * 0.0625f - mxs); st[kt][r] = p; sum += p; } }
        sum += __shfl_xor(sum, 16); sum += __shfl_xor(sum, 32);
        const float inv = 1.0f / sum;
        bf16x8 pf[8];
#pragma unroll
        for (int kk = 0; kk < 8; ++kk) pf[kk] = pack_p(st[2 * kk], st[2 * kk + 1]);
        const bf16* vp = VXT + (size_t)(hd * 256 + fr) * 512 + b * NMEM + 8 * fq;
        bf16* op = OX + (size_t)(row0 + fr) * 1024 + hd * 256 + 4 * fq;
#pragma unroll 4
        for (int dt = 0; dt < 16; ++dt) { f32x4 acc = {0.f, 0.f, 0.f, 0.f};
#pragma unroll
            for (int kk = 0; kk < 8; ++kk) acc = MFMA16(*(const bf16x8*)(vp + (size_t)dt * 16 * 512 + 32 * kk), pf[kk], acc);
            u32x2 w; w.x = pk2(acc[0] * inv, acc[1] * inv); w.y = pk2(acc[2] * inv, acc[3] * inv);
            *(u32x2*)(op + 16 * dt) = w; }
    }
}

__device__ __forceinline__ void moba_item(const bf16* PQ, const bf16* VT, const float* KMEAN, bf16* MIX, int bh, int tile, int lane) {
    const int fr = lane & 15, fq = lane >> 4, h = bh & 7, b = bh >> 3, qb = tile >> 3;
    const int row0 = b * SEQ + tile * 32;
    unsigned mask = 0u;
    if (qb > 0) {
        float q[64];
        { const u32x4* qp = (const u32x4*)(PQ + (size_t)(row0 + (lane & 31)) * 1536 + h * 64);
#pragma unroll
          for (int i = 0; i < 8; ++i) unpack8(qp[i], q + 8 * i); }
        float b0 = -INFINITY, b1 = -INFINITY, b2 = -INFINITY; int i0 = -1, i1 = -1, i2 = -1;
        const float* km = KMEAN + (size_t)bh * 32 * 64;
        for (int j = 0; j < qb; ++j) { float s = 0.f;
#pragma unroll
            for (int d = 0; d < 64; ++d) s += q[d] * km[j * 64 + d];
            if (s > b0) { b2 = b1; i2 = i1; b1 = b0; i1 = i0; b0 = s; i0 = j; } else if (s > b1) { b2 = b1; i2 = i1; b1 = s; i1 = j; } else if (s > b2) { b2 = s; i2 = j; } }
        if (i0 >= 0) mask |= 1u << i0; if (i1 >= 0) mask |= 1u << i1; if (i2 >= 0) mask |= 1u << i2;
    }
    const unsigned m0 = (unsigned)__shfl((int)mask, fr), m1 = (unsigned)__shfl((int)mask, 16 + fr);
    bf16x8 qf[2][2];
#pragma unroll
    for (int qt = 0; qt < 2; ++qt)
#pragma unroll
        for (int ks = 0; ks < 2; ++ks) qf[qt][ks] = *(const bf16x8*)(PQ + (size_t)(row0 + 16 * qt + fr) * 1536 + h * 64 + 32 * ks + 8 * fq);
    f32x4 oacc[2][4];
#pragma unroll
    for (int qt = 0; qt < 2; ++qt)
#pragma unroll
        for (int dt = 0; dt < 4; ++dt) oacc[qt][dt] = (f32x4){0.f, 0.f, 0.f, 0.f};
    float mrow[2] = {-INFINITY, -INFINITY}, lrow[2] = {0.f, 0.f};
    const int qoff0 = (tile & 7) * 32;
    for (int bi = 0; bi <= qb; ++bi) {
        const int blk = (bi == 0) ? qb : bi - 1; const bool own = (bi == 0);
        if (!own && !__any((int)(((m0 | m1) >> blk) & 1u))) continue;
        const bool s0 = own || ((m0 >> blk) & 1u), s1 = own || ((m1 >> blk) & 1u);
        for (int hf = 0; hf < 2; ++hf) {
            if (own && hf * 128 > qoff0 + 31) continue;
            const int key0 = b * SEQ + blk * 256 + hf * 128;
            f32x4 st[2][8];
            const bf16* kp = PQ + (size_t)(key0 + fr) * 1536 + 512 + h * 64 + 8 * fq;
#pragma unroll
            for (int kt = 0; kt < 8; ++kt) { const bf16x8 k0 = *(const bf16x8*)(kp + (size_t)kt * 16 * 1536), k1 = *(const bf16x8*)(kp + (size_t)kt * 16 * 1536 + 32);
#pragma unroll
                for (int qt = 0; qt < 2; ++qt) { f32x4 acc = {0.f, 0.f, 0.f, 0.f}; acc = MFMA16(k0, qf[qt][0], acc); acc = MFMA16(k1, qf[qt][1], acc); st[qt][kt] = acc; } }
            bf16x8 pf[2][4];
#pragma unroll
            for (int qt = 0; qt < 2; ++qt) {
                const bool sel = qt == 0 ? s0 : s1; const int qoff = qoff0 + 16 * qt + fr;
                float mx = -INFINITY;
#pragma unroll
                for (int kt = 0; kt < 8; ++kt)
#pragma unroll
                    for (int r = 0; r < 4; ++r) { float s = st[qt][kt][r] * 0.125f; const int kin = hf * 128 + 16 * kt + 4 * fq + r;
                        if (!sel || (own && kin > qoff)) s = -INFINITY; st[qt][kt][r] = s; mx = fmaxf(mx, s); }
                mx = fmaxf(mx, __shfl_xor(mx, 16)); mx = fmaxf(mx, __shfl_xor(mx, 32));
                const float mn = fmaxf(mrow[qt], mx);
                const float corr = __expf(mrow[qt] - mn); mrow[qt] = mn;
                float ps = 0.f;
#pragma unroll
                for (int kt = 0; kt < 8; ++kt)
#pragma unroll
                    for (int r = 0; r < 4; ++r) { const float p = __expf(st[qt][kt][r] - mn); st[qt][kt][r] = p; ps += p; }
                lrow[qt] = lrow[qt] * corr + ps;
#pragma unroll
                for (int dt = 0; dt < 4; ++dt) oacc[qt][dt] = oacc[qt][dt] * corr;
#pragma unroll
                for (int kk = 0; kk < 4; ++kk) pf[qt][kk] = pack_p(st[qt][2 * kk], st[qt][2 * kk + 1]);
            }
            const bf16* vp = VT + (size_t)(h * 64 + fr) * NT + key0 + 8 * fq;
#pragma unroll
            for (int dt = 0; dt < 4; ++dt)
#pragma unroll
                for (int kk = 0; kk < 4; ++kk) { const bf16x8 vf = *(const bf16x8*)(vp + (size_t)dt * 16 * NT + 32 * kk);
                    oacc[0][dt] = MFMA16(vf, pf[0][kk], oacc[0][dt]); oacc[1][dt] = MFMA16(vf, pf[1][kk], oacc[1][dt]); }
        }
    }
#pragma unroll
    for (int qt = 0; qt < 2; ++qt) {
        float l = lrow[qt]; l += __shfl_xor(l, 16); l += __shfl_xor(l, 32); const float inv = 1.0f / l;
        bf16* op = MIX + (size_t)(row0 + 16 * qt + fr) * 1024 + h * 64 + 4 * fq;
#pragma unroll
        for (int dt = 0; dt < 4; ++dt) { u32x2 w; w.x = pk2(oacc[qt][dt][0] * inv, oacc[qt][dt][1] * inv); w.y = pk2(oacc[qt][dt][2] * inv, oacc[qt][dt][3] * inv); *(u32x2*)(op + 16 * dt) = w; }
    }
}
__device__ __forceinline__ void moba_mfma(const Ctx& C, const bf16* PQ, const bf16* VT, const float* KMEAN, bf16* MIX) {
    for (int pi = C.gw; pi < 2048; pi += C.ngw) {
        const int bh = pi >> 7, pp = pi & 127;
        moba_item(PQ, VT, KMEAN, MIX, bh, pp, C.lane);
        moba_item(PQ, VT, KMEAN, MIX, bh, 255 - pp, C.lane);
    }
}
__device__ __forceinline__ void pool_mfma(const Ctx& C, const bf16* PQ, const bf16* PWT, const float* pool_scale, bf16* MIX) {
    const int lane = C.lane, fr = lane & 15, fq = lane >> 4;
    for (int it = C.gw; it < (NT / 16) * 4; it += C.ngw) {
        const int g = it & 3, tt = it >> 2, row = tt * 16 + fr, tl = row & (SEQ - 1), w = 2 << g;
        const int cnt = (tl + 1 < w) ? tl + 1 : w; const float icnt = 1.0f / (float)cnt;
        bf16x8 bfr[4];
#pragma unroll
        for (int ks = 0; ks < 4; ++ks) {
            const bf16* p = PQ + (size_t)row * 1536 + 1024 + g * 128 + 32 * ks + 8 * fq;
            float cur[8], s[8]; unpack8(*(const u32x4*)p, cur);
#pragma unroll
            for (int e = 0; e < 8; ++e) s[e] = cur[e];
            for (int i = 1; i < cnt; ++i) { float f[8]; unpack8(*(const u32x4*)(p - (size_t)i * 1536), f);
#pragma unroll
                for (int e = 0; e < 8; ++e) s[e] += f[e]; }
            u32x4 wv; wv.x = pk2(s[0] * icnt - cur[0], s[1] * icnt - cur[1]); wv.y = pk2(s[2] * icnt - cur[2], s[3] * icnt - cur[3]);
            wv.z = pk2(s[4] * icnt - cur[4], s[5] * icnt - cur[5]); wv.w = pk2(s[6] * icnt - cur[6], s[7] * icnt - cur[7]);
            bfr[ks] = __builtin_bit_cast(bf16x8, wv);
        }
        const bf16* ap = PWT + (size_t)g * 128 * 128 + (size_t)fr * 128 + 8 * fq;
        bf16* op = MIX + (size_t)row * 1024 + 512 + g * 128 + 4 * fq; const float* sp = pool_scale + g * 128 + 4 * fq;
#pragma unroll 2
        for (int dt = 0; dt < 8; ++dt) { f32x4 acc = {0.f, 0.f, 0.f, 0.f};
#pragma unroll
            for (int ks = 0; ks < 4; ++ks) acc = MFMA16(*(const bf16x8*)(ap + (size_t)dt * 16 * 128 + 32 * ks), bfr[ks], acc);
            const f32x4 sc = *(const f32x4*)(sp + 16 * dt);
            u32x2 wv; wv.x = pk2(acc[0] * sc.x, acc[1] * sc.y); wv.y = pk2(acc[2] * sc.z, acc[3] * sc.w); *(u32x2*)(op + 16 * dt) = wv; }
    }
}
__device__ __forceinline__ void sgu_mfma(const Ctx& C, const bf16* Z, const bf16* VNT, const bf16* Wb, const float* sgu_b, bf16* MIX, int gw0, int ngw0) {
    const int lane = C.lane, fr = lane & 15, fq = lane >> 4;
    for (int it = gw0; it < 128 * 4 * 8; it += ngw0) {
        const int tt = it & 7, g = (it >> 3) & 3, n = it >> 5, nks = (tt >> 1) + 1;
        const int row = n * 128 + tt * 16 + fr;
        bf16x8 bfr[4];
#pragma unroll
        for (int ks = 0; ks < 4; ++ks) bfr[ks] = (ks < nks) ? *(const bf16x8*)(Wb + (size_t)(g * 128 + tt * 16 + fr) * 128 + 32 * ks + 8 * fq) : (bf16x8){0, 0, 0, 0, 0, 0, 0, 0};
        const float bias = sgu_b[g * 128 + tt * 16 + fr];
        const bf16* ap = VNT + ((size_t)n * 512 + g * 128 + fr) * 128 + 8 * fq;
        const bf16* up = Z + (size_t)row * 1024 + g * 128 + 4 * fq; bf16* op = MIX + (size_t)row * 1024 + g * 128 + 4 * fq;
#pragma unroll 2
        for (int ct = 0; ct < 8; ++ct) { f32x4 acc = {0.f, 0.f, 0.f, 0.f};
#pragma unroll
            for (int ks = 0; ks < 4; ++ks) if (ks < nks) acc = MFMA16(*(const bf16x8*)(ap + (size_t)ct * 16 * 128 + 32 * ks), bfr[ks], acc);
            const u32x2 uw = *(const u32x2*)(up + 16 * ct);
            u32x2 wv; wv.x = pk2(lo16(uw.x) * (acc[0] + bias), hi16(uw.x) * (acc[1] + bias)); wv.y = pk2(lo16(uw.y) * (acc[2] + bias), hi16(uw.y) * (acc[3] + bias)); *(u32x2*)(op + 16 * ct) = wv; }
    }
}
__device__ __forceinline__ void sgu_w_convert(const Ctx& C, const float* sw, bf16* Wb) {
    for (int idx = C.gtid; idx < 4 * 128 * 128; idx += C.nthr) { const int s = idx & 127, t = (idx >> 7) & 127; Wb[idx] = (bf16)((s <= t) ? f2bf(sw[idx]) : 0u); }
}
constexpr int MK_LD = 72, MV_LD = 136;
constexpr int MK_BYTES = 128 * MK_LD * 2, MV_BYTES = 64 * MV_LD * 2;
__device__ __forceinline__ void moba_wg_block(const Ctx& C, const bf16* PQ, const bf16* VT, const float* KMEAN, bf16* MIX, int bh, int qb) {
    const int lane = C.lane, fr = lane & 15, fq = lane >> 4, h = bh & 7, b = bh >> 3, w = C.wave, tid = C.tid;
    const int tile = qb * 8 + w, row0 = b * SEQ + tile * 32;
    LAS bf16* Kb0 = (LAS bf16*)C.lds; LAS bf16* Vb0 = (LAS bf16*)(C.lds + 2 * MK_BYTES);
    unsigned mask = 0u;
    if (qb > 0) {
        float q[64];
        { const u32x4* qp = (const u32x4*)(PQ + (size_t)(row0 + (lane & 31)) * 1536 + h * 64);
#pragma unroll
          for (int i = 0; i < 8; ++i) unpack8(qp[i], q + 8 * i); }
        float b0 = -INFINITY, b1 = -INFINITY, b2 = -INFINITY; int i0 = -1, i1 = -1, i2 = -1;
        const float* km = KMEAN + (size_t)bh * 32 * 64;
        for (int j = 0; j < qb; ++j) { float s = 0.f;
#pragma unroll
            for (int d = 0; d < 64; ++d) s += q[d] * km[j * 64 + d];
            if (s > b0) { b2 = b1; i2 = i1; b1 = b0; i1 = i0; b0 = s; i0 = j; } else if (s > b1) { b2 = b1; i2 = i1; b1 = s; i1 = j; } else if (s > b2) { b2 = s; i2 = j; } }
        if (i0 >= 0) mask |= 1u << i0; if (i1 >= 0) mask |= 1u << i1; if (i2 >= 0) mask |= 1u << i2;
    }
    const unsigned m0 = (unsigned)__shfl((int)mask, fr), m1 = (unsigned)__shfl((int)mask, 16 + fr);
    bf16x8 qf[2][2];
#pragma unroll
    for (int qt = 0; qt < 2; ++qt)
#pragma unroll
        for (int ks = 0; ks < 2; ++ks) qf[qt][ks] = *(const bf16x8*)(PQ + (size_t)(row0 + 16 * qt + fr) * 1536 + h * 64 + 32 * ks + 8 * fq);
    f32x4 oacc[2][4];
#pragma unroll
    for (int qt = 0; qt < 2; ++qt)
#pragma unroll
        for (int dt = 0; dt < 4; ++dt) oacc[qt][dt] = (f32x4){0.f, 0.f, 0.f, 0.f};
    float mrow[2] = {-INFINITY, -INFINITY}, lrow[2] = {0.f, 0.f};
    const int qoff0 = w * 32;
    const int kr = tid >> 3, kc = tid & 7, vr = tid >> 4, vc = tid & 15;
    const int nh = 2 * (qb + 1);
    u32x4 kq0, kq1, vq0, vq1;
#define MOBA_KEY0(i) (b * SEQ + (((i) < 2) ? qb : (((i) - 2) >> 1)) * 256 + ((i) & 1) * 128)
#define MOBA_GLOAD(i) do { const int k0_ = MOBA_KEY0(i); \
        kq0 = *(const u32x4*)(PQ + (size_t)(k0_ + kr) * 1536 + 512 + h * 64 + 8 * kc); kq1 = *(const u32x4*)(PQ + (size_t)(k0_ + kr + 64) * 1536 + 512 + h * 64 + 8 * kc); \
        vq0 = *(const u32x4*)(VT + (size_t)(h * 64 + vr) * NT + k0_ + 8 * vc); vq1 = *(const u32x4*)(VT + (size_t)(h * 64 + vr + 32) * NT + k0_ + 8 * vc); } while (0)
#define MOBA_LSTORE(buf) do { LAS bf16* kb_ = Kb0 + (buf) * (MK_BYTES / 2); LAS bf16* vb_ = Vb0 + (buf) * (MV_BYTES / 2); \
        *(LAS u32x4*)(kb_ + kr * MK_LD + 8 * kc) = kq0; *(LAS u32x4*)(kb_ + (kr + 64) * MK_LD + 8 * kc) = kq1; \
        *(LAS u32x4*)(vb_ + vr * MV_LD + 8 * vc) = vq0; *(LAS u32x4*)(vb_ + (vr + 32) * MV_LD + 8 * vc) = vq1; } while (0)
    MOBA_GLOAD(0); MOBA_LSTORE(0);
    WG_BAR();
    for (int i = 0; i < nh; ++i) {
        if (i + 1 < nh) MOBA_GLOAD(i + 1);
        const bool own = i < 2; const int blk = own ? qb : ((i - 2) >> 1), hf = i & 1;
        const bool s0 = own || ((m0 >> blk) & 1u), s1 = own || ((m1 >> blk) & 1u);
        const bool need = own ? !(hf * 128 > qoff0 + 31) : (__any((int)(((m0 | m1) >> blk) & 1u)) != 0);
        if (need) {
            const bool nq0 = own || (__any((int)((m0 >> blk) & 1u)) != 0), nq1 = own || (__any((int)((m1 >> blk) & 1u)) != 0);
            const LAS bf16* Kb = Kb0 + (i & 1) * (MK_BYTES / 2); const LAS bf16* Vb = Vb0 + (i & 1) * (MV_BYTES / 2);
            f32x4 st[2][8];
#pragma unroll
            for (int kt = 0; kt < 8; ++kt) { const bf16x8 k0 = *(const LAS bf16x8*)(Kb + (16 * kt + fr) * MK_LD + 8 * fq), k1 = *(const LAS bf16x8*)(Kb + (16 * kt + fr) * MK_LD + 32 + 8 * fq);
#pragma unroll
                for (int qt = 0; qt < 2; ++qt) if (qt == 0 ? nq0 : nq1) { f32x4 acc = {0.f, 0.f, 0.f, 0.f}; acc = MFMA16(k0, qf[qt][0], acc); acc = MFMA16(k1, qf[qt][1], acc); st[qt][kt] = acc; } }
            bf16x8 pf[2][4];
            constexpr float SC2 = 0.125f * 1.4426950408889634f;
#pragma unroll
            for (int qt = 0; qt < 2; ++qt) if (qt == 0 ? nq0 : nq1) {
                const bool sel = qt == 0 ? s0 : s1; const int qoff = qoff0 + 16 * qt + fr;
                float mx = -INFINITY;
                if (own) {
#pragma unroll
                    for (int kt = 0; kt < 8; ++kt)
#pragma unroll
                        for (int r = 0; r < 4; ++r) { const int kin = hf * 128 + 16 * kt + 4 * fq + r; if (kin > qoff) st[qt][kt][r] = -INFINITY; }
                }
#pragma unroll
                for (int kt = 0; kt < 8; ++kt) mx = fmaxf(mx, fmaxf(fmaxf(st[qt][kt][0], st[qt][kt][1]), fmaxf(st[qt][kt][2], st[qt][kt][3])));
                mx *= SC2;
                if (!sel) mx = -INFINITY;
                mx = fmaxf(mx, __shfl_xor(mx, 16)); mx = fmaxf(mx, __shfl_xor(mx, 32));
                const float mn = fmaxf(mrow[qt], mx);
                const float corr = __builtin_amdgcn_exp2f(mrow[qt] - mn); mrow[qt] = mn;
                float ps = 0.f;
#pragma unroll
                for (int kt = 0; kt < 8; ++kt)
#pragma unroll
                    for (int r = 0; r < 4; ++r) { const float p = __builtin_amdgcn_exp2f(__builtin_fmaf(st[qt][kt][r], SC2, -mn)); st[qt][kt][r] = p; ps += p; }
                if (!sel) ps = 0.f;
                lrow[qt] = lrow[qt] * corr + ps;
#pragma unroll
                for (int dt = 0; dt < 4; ++dt) oacc[qt][dt] = oacc[qt][dt] * corr;
#pragma unroll
                for (int kk = 0; kk < 4; ++kk) { bf16x8 pv = pack_p(st[qt][2 * kk], st[qt][2 * kk + 1]); if (!sel) pv = (bf16x8){0, 0, 0, 0, 0, 0, 0, 0}; pf[qt][kk] = pv; }
            }
#pragma unroll
            for (int dt = 0; dt < 4; ++dt)
#pragma unroll
                for (int kk = 0; kk < 4; ++kk) { const bf16x8 vf = *(const LAS bf16x8*)(Vb + (16 * dt + fr) * MV_LD + 32 * kk + 8 * fq);
                    if (nq0) oacc[0][dt] = MFMA16(vf, pf[0][kk], oacc[0][dt]); if (nq1) oacc[1][dt] = MFMA16(vf, pf[1][kk], oacc[1][dt]); }
        }
        if (i + 1 < nh) MOBA_LSTORE((i + 1) & 1);
        WG_BAR();
    }
#undef MOBA_KEY0
#undef MOBA_GLOAD
#undef MOBA_LSTORE
#pragma unroll
    for (int qt = 0; qt < 2; ++qt) {
        float l = lrow[qt]; l += __shfl_xor(l, 16); l += __shfl_xor(l, 32); const float inv = 1.0f / l;
        bf16* op = MIX + (size_t)(row0 + 16 * qt + fr) * 1024 + h * 64 + 4 * fq;
#pragma unroll
        for (int dt = 0; dt < 4; ++dt) { u32x2 wv; wv.x = pk2(oacc[qt][dt][0] * inv, oacc[qt][dt][1] * inv); wv.y = pk2(oacc[qt][dt][2] * inv, oacc[qt][dt][3] * inv); *(u32x2*)(op + 16 * dt) = wv; }
    }
}
__device__ __forceinline__ void moba_wg(const Ctx& C, const bf16* PQ, const bf16* VT, const float* KMEAN, bf16* MIX) {
    for (int it = blockIdx.x; it < 256; it += C.G) {
        const int bh = it & 15, pp = it >> 4;
        moba_wg_block(C, PQ, VT, KMEAN, MIX, bh, 31 - pp);
        moba_wg_block(C, PQ, VT, KMEAN, MIX, bh, pp);
    }
}
constexpr int XK_LD = 264, XV_LD = 136;
constexpr int XK_BYTES = 128 * XK_LD * 2, XV_BYTES = 256 * XV_LD * 2;
static_assert(XK_BYTES + XV_BYTES <= LDS_BYTES - 256, "xattn LDS");
__device__ __forceinline__ void xattn_wg(const Ctx& C, const bf16* QX, const bf16* KX, const bf16* VXT, bf16* OX) {
    const int lane = C.lane, fr = lane & 15, fq = lane >> 4, w = C.wave, tid = C.tid;
    LAS bf16* Kb = (LAS bf16*)C.lds; LAS bf16* Vb = (LAS bf16*)(C.lds + XK_BYTES);
    constexpr float SC2 = 0.0625f * 1.4426950408889634f;
    for (int it = blockIdx.x; it < 512; it += C.G) {
        const int hd = it & 3, bq = it >> 2, row0 = bq * 128 + w * 16, b = bq >> 6;
        bf16x8 qf[8];
        { const bf16* qp = QX + (size_t)(row0 + fr) * 1024 + hd * 256 + 8 * fq;
#pragma unroll
          for (int ks = 0; ks < 8; ++ks) qf[ks] = *(const bf16x8*)(qp + 32 * ks); }
        f32x4 oacc[16];
#pragma unroll
        for (int dt = 0; dt < 16; ++dt) oacc[dt] = (f32x4){0.f, 0.f, 0.f, 0.f};
        float mrow = -INFINITY, lrow = 0.f;
        for (int hf = 0; hf < 2; ++hf) {
            WG_BAR();
#pragma unroll
            for (int i = 0; i < 8; ++i) { const int id = tid + 512 * i;
                { const int r = id >> 5, c = id & 31; *(LAS u32x4*)(Kb + r * XK_LD + 8 * c) = *(const u32x4*)(KX + (size_t)(b * NMEM + 128 * hf + r) * 1024 + hd * 256 + 8 * c); }
                { const int r = id >> 4, c = id & 15; *(LAS u32x4*)(Vb + r * XV_LD + 8 * c) = *(const u32x4*)(VXT + (size_t)(hd * 256 + r) * 512 + b * NMEM + 128 * hf + 8 * c); } }
            WG_BAR();
            f32x4 st[8];
#pragma unroll
            for (int kt = 0; kt < 8; ++kt) { f32x4 acc = {0.f, 0.f, 0.f, 0.f};
#pragma unroll
                for (int ks = 0; ks < 8; ++ks) acc = MFMA16(*(const LAS bf16x8*)(Kb + (16 * kt + fr) * XK_LD + 32 * ks + 8 * fq), qf[ks], acc);
                st[kt] = acc; }
            float mx = -INFINITY;
#pragma unroll
            for (int kt = 0; kt < 8; ++kt)
#pragma unroll
                for (int r = 0; r < 4; ++r) { const float sv = st[kt][r] * SC2; st[kt][r] = sv; mx = fmaxf(mx, sv); }
            mx = fmaxf(mx, __shfl_xor(mx, 16)); mx = fmaxf(mx, __shfl_xor(mx, 32));
            const float mn = fmaxf(mrow, mx), corr = __builtin_amdgcn_exp2f(mrow - mn); mrow = mn;
            float ps = 0.f;
#pragma unroll
            for (int kt = 0; kt < 8; ++kt)
#pragma unroll
                for (int r = 0; r < 4; ++r) { const float p = __builtin_amdgcn_exp2f(st[kt][r] - mn); st[kt][r] = p; ps += p; }
            lrow = lrow * corr + ps;
            bf16x8 pf[4];
#pragma unroll
            for (int kk = 0; kk < 4; ++kk) pf[kk] = pack_p(st[2 * kk], st[2 * kk + 1]);
#pragma unroll
            for (int dt = 0; dt < 16; ++dt) { f32x4 acc = oacc[dt] * corr;
#pragma unroll
                for (int kk = 0; kk < 4; ++kk) acc = MFMA16(*(const LAS bf16x8*)(Vb + (16 * dt + fr) * XV_LD + 32 * kk + 8 * fq), pf[kk], acc);
                oacc[dt] = acc; }
        }
        lrow += __shfl_xor(lrow, 16); lrow += __shfl_xor(lrow, 32);
        const float inv = 1.0f / lrow;
        bf16* op = OX + (size_t)(row0 + fr) * 1024 + hd * 256 + 4 * fq;
#pragma unroll
        for (int dt = 0; dt < 16; ++dt) { u32x2 wv; wv.x = pk2(oacc[dt][0] * inv, oacc[dt][1] * inv); wv.y = pk2(oacc[dt][2] * inv, oacc[dt][3] * inv); *(u32x2*)(op + 16 * dt) = wv; }
    }
    WG_BAR();
}
__device__ __forceinline__ void l1_prep(const Ctx& C, ArgsP a, const bf16* Z, const bf16* QKV, bf16* VNT, bf16* QN, bf16* KN, bf16* VV) {
    const int lane = C.lane;
    const float* lng = INP(a, I_SGUG); const float* lnb = INP(a, I_SGUB); const float* cw = INP(a, I_DNCONV);
    for (int blk = C.gw; blk < NT / 8; blk += C.ngw) {
        const int row0 = blk * 8;
        {
            const f32x4 g0 = *((const f32x4*)lng + 2 * lane), g1 = *((const f32x4*)lng + 2 * lane + 1), c0 = *((const f32x4*)lnb + 2 * lane), c1 = *((const f32x4*)lnb + 2 * lane + 1);
            unsigned vt[8][4];
#pragma unroll
            for (int e = 0; e < 8; ++e)
#pragma unroll
                for (int q = 0; q < 4; ++q) vt[e][q] = 0u;
#pragma unroll
            for (int r = 0; r < 8; ++r) {
                float f[8]; unpack8(*((const u32x4*)(Z + (size_t)(row0 + r) * 1024 + 512) + lane), f);
                float s = 0.f;
#pragma unroll
                for (int e = 0; e < 8; ++e) s += f[e];
                const float mu = wave_sum(s) * (1.0f / 512.0f); float q = 0.f;
#pragma unroll
                for (int e = 0; e < 8; ++e) { f[e] -= mu; q += f[e] * f[e]; }
                const float rstd = 1.0f / sqrtf(wave_sum(q) * (1.0f / 512.0f) + EPS);
                const float y[8] = {f[0] * rstd * g0.x + c0.x, f[1] * rstd * g0.y + c0.y, f[2] * rstd * g0.z + c0.z, f[3] * rstd * g0.w + c0.w,
                                    f[4] * rstd * g1.x + c1.x, f[5] * rstd * g1.y + c1.y, f[6] * rstd * g1.z + c1.z, f[7] * rstd * g1.w + c1.w};
#pragma unroll
                for (int e = 0; e < 8; ++e) vt[e][r >> 1] |= f2bf(y[e]) << (16 * (r & 1));
            }
            bf16* vp = VNT + ((size_t)(row0 >> 7) * 512 + 8 * lane) * 128 + (row0 & 127);
#pragma unroll
            for (int e = 0; e < 8; ++e) { u32x4 w; w.x = vt[e][0]; w.y = vt[e][1]; w.z = vt[e][2]; w.w = vt[e][3]; *(u32x4*)(vp + (size_t)e * 128) = w; }
        }
        const bool hist = (row0 & (SEQ - 1)) != 0;
#pragma unroll 1
        for (int s3 = 0; s3 < 3; ++s3) {
            const int cs = s3 * 512 + 8 * lane;
            float w[4][8];
#pragma unroll
            for (int j = 0; j < 4; ++j) { const f32x4 a0 = *(const f32x4*)(cw + j * 1536 + cs), a1 = *(const f32x4*)(cw + j * 1536 + cs + 4);
                w[j][0] = a0.x; w[j][1] = a0.y; w[j][2] = a0.z; w[j][3] = a0.w; w[j][4] = a1.x; w[j][5] = a1.y; w[j][6] = a1.z; w[j][7] = a1.w; }
            float x0[8], x1[8], x2[8];
            if (hist) { unpack8(*(const u32x4*)(QKV + (size_t)(row0 - 3) * 1536 + cs), x0); unpack8(*(const u32x4*)(QKV + (size_t)(row0 - 2) * 1536 + cs), x1); unpack8(*(const u32x4*)(QKV + (size_t)(row0 - 1) * 1536 + cs), x2); }
            else {
#pragma unroll
                for (int e = 0; e < 8; ++e) { x0[e] = 0.f; x1[e] = 0.f; x2[e] = 0.f; } }
            bf16* dst = (s3 == 0 ? QN : s3 == 1 ? KN : VV) + (size_t)row0 * 512 + 8 * lane;
#pragma unroll
            for (int r = 0; r < 8; ++r) {
                float x3[8]; unpack8(*(const u32x4*)(QKV + (size_t)(row0 + r) * 1536 + cs), x3);
                float y[8], ss = 0.f;
#pragma unroll
                for (int e = 0; e < 8; ++e) { y[e] = silu_f(w[0][e] * x0[e] + w[1][e] * x1[e] + w[2][e] * x2[e] + w[3][e] * x3[e]); ss += y[e] * y[e]; }
                float sc = 1.0f;
                if (s3 < 2) { ss += __shfl_xor(ss, 1); ss += __shfl_xor(ss, 2); ss += __shfl_xor(ss, 4); ss += __shfl_xor(ss, 8);
                    sc = 1.0f / sqrtf(ss + EPS); if (s3 == 0) sc *= 0.08838834764831845f; }
                u32x4 o; o.x = pk2(y[0] * sc, y[1] * sc); o.y = pk2(y[2] * sc, y[3] * sc); o.z = pk2(y[4] * sc, y[5] * sc); o.w = pk2(y[6] * sc, y[7] * sc);
                *(u32x4*)(dst + (size_t)r * 512) = o;
#pragma unroll
                for (int e = 0; e < 8; ++e) { x0[e] = x1[e]; x1[e] = x2[e]; x2[e] = x3[e]; }
            }
        }
    }
}

#ifndef MK_MULTI
#define MK_MULTI 0
#endif
enum { OP_PRO0 = 0, OP_KMEAN, OP_MOBA, OP_RMSX, OP_XATTN, OP_RMSF, OP_ACT, OP_PRO1, OP_L1PREP, OP_DNPREP, OP_DNSCAN, OP_DNGATE, OP_FINAL, OP_GSTORE, OP_GRESID, OP_GCONV };
struct PD { int op, sync, L, hb, M, N, K; unsigned long long a, b, p0, p1, p2; int ld0, ld1, ld2, t1, t2, gelu0, basex, rot; long long ss; };
#define PH_TABLE \
  {OP_PRO0, 1, 0, 0, 0, 0, 0, 0ull, 0ull, 0ull, 0ull, 0ull, 0, 0, 0, 0, 0, 0, 0, 0, -1ll}, \
  {OP_GSTORE, 0, 0, 0, 16384, 1536, 1024, 38797312ull, 4194304ull, 141557760ull, 0ull, 0ull, 1536, 0, 0, 1000, 1000, 0, 0, 0, -1ll}, \
  {OP_GSTORE, 1, 0, 0, 512, 16384, 1024, 7340032ull, 208666624ull, 191889408ull, 0ull, 0ull, 16384, 0, 0, 1000, 1000, 0, 0, 128, -1ll}, \
  {OP_KMEAN, 0, 0, 0, 0, 0, 0, 0ull, 0ull, 0ull, 0ull, 0ull, 0, 0, 0, 0, 0, 0, 0, 0, -1ll}, \
  {OP_GSTORE, 0, 0, 0, 512, 1024, 1024, 0ull, 14680064ull, 72351744ull, 0ull, 0ull, 1024, 0, 0, 1000, 1000, 0, 0, 64, -1ll}, \
  {OP_GSTORE, 1, 0, 0, 1024, 512, 1024, 16777216ull, 2097152ull, 73400320ull, 0ull, 0ull, 512, 0, 0, 1000, 1000, 0, 0, 72, -1ll}, \
  {OP_MOBA, 1, 0, 0, 0, 0, 0, 0ull, 0ull, 0ull, 0ull, 0ull, 0, 0, 0, 0, 0, 0, 0, 0, -1ll}, \
  {OP_GRESID, 1, 0, 0, 16384, 1024, 1024, 74448896ull, 10485760ull, 0ull, 0ull, 0ull, 0, 0, 0, 0, 0, 0, 1, 0, 260046848ll}, \
  {OP_GSTORE, 1, 0, 0, 16384, 1024, 1024, 38797312ull, 12582912ull, 108003328ull, 0ull, 0ull, 1024, 0, 0, 1000, 1000, 0, 0, 0, 260046848ll}, \
  {OP_XATTN, 1, 0, 0, 0, 0, 0, 0ull, 0ull, 0ull, 0ull, 0ull, 0, 0, 0, 0, 0, 0, 0, 0, -1ll}, \
  {OP_GRESID, 1, 0, 0, 16384, 1024, 1024, 74448896ull, 18874368ull, 0ull, 0ull, 0ull, 0, 0, 0, 0, 0, 0, 0, 0, 260046848ll}, \
  {OP_GCONV, 1, 0, 0, 17408, 5632, 1024, 38797312ull, 20971520ull, 74448896ull, 0ull, 0ull, 0, 0, 0, 0, 0, 0, 0, 0, 260046848ll}, \
  {OP_GRESID, 1, 0, 2, 16384, 1024, 2816, 74448896ull, 32505856ull, 0ull, 0ull, 0ull, 0, 0, 0, 0, 0, 0, 0, 0, -1ll}, \
  {OP_PRO1, 1, 0, 0, 0, 0, 0, 0ull, 0ull, 0ull, 0ull, 0ull, 0, 0, 0, 0, 0, 0, 0, 0, -1ll}, \
  {OP_GSTORE, 1, 0, 0, 16384, 3072, 1024, 38797312ull, 4194304ull, 141557760ull, 175112192ull, 225443840ull, 1024, 1536, 512, 4, 10, 1, 0, 0, -1ll}, \
  {OP_L1PREP, 1, 0, 0, 0, 0, 0, 0ull, 0ull, 0ull, 0ull, 0ull, 0, 0, 0, 0, 0, 0, 0, 0, -1ll}, \
  {OP_DNPREP, 0, 0, 0, 0, 0, 0, 0ull, 0ull, 0ull, 0ull, 0ull, 0, 0, 0, 0, 0, 0, 0, 0, -1ll}, \
  {OP_GSTORE, 0, 0, 0, 512, 1024, 1024, 0ull, 14680064ull, 72351744ull, 0ull, 0ull, 1024, 0, 0, 1000, 1000, 0, 0, 128, -1ll}, \
  {OP_GSTORE, 1, 0, 0, 1024, 512, 1024, 16777216ull, 2097152ull, 73400320ull, 0ull, 0ull, 512, 0, 0, 1000, 1000, 0, 0, 136, -1ll}, \
  {OP_DNSCAN, 1, 0, 0, 0, 0, 0, 0ull, 0ull, 0ull, 0ull, 0ull, 0, 0, 0, 0, 0, 0, 0, 0, -1ll}, \
  {OP_DNGATE, 1, 0, 0, 0, 0, 0, 0ull, 0ull, 0ull, 0ull, 0ull, 0, 0, 0, 0, 0, 0, 0, 0, -1ll}, \
  {OP_GRESID, 1, 0, 1, 16384, 1024, 1024, 74448896ull, 10485760ull, 0ull, 0ull, 0ull, 0, 0, 0, 0, 0, 0, 0, 0, 260046848ll}, \
  {OP_GSTORE, 1, 0, 0, 16384, 1024, 1024, 38797312ull, 12582912ull, 108003328ull, 0ull, 0ull, 1024, 0, 0, 1000, 1000, 0, 0, 0, 260046848ll}, \
  {OP_XATTN, 1, 1, 0, 0, 0, 0, 0ull, 0ull, 0ull, 0ull, 0ull, 0, 0, 0, 0, 0, 0, 0, 0, -1ll}, \
  {OP_GRESID, 1, 0, 0, 16384, 1024, 1024, 74448896ull, 18874368ull, 0ull, 0ull, 0ull, 0, 0, 0, 0, 0, 0, 0, 0, 260046848ll}, \
  {OP_GCONV, 1, 1, 0, 17408, 5632, 1024, 38797312ull, 20971520ull, 74448896ull, 0ull, 0ull, 0, 0, 0, 0, 0, 0, 0, 0, 260046848ll}, \
  {OP_GRESID, 1, 0, 0, 16384, 1024, 2816, 74448896ull, 32505856ull, 0ull, 0ull, 0ull, 0, 0, 0, 0, 0, 0, 0, 0, -1ll}, \
  {OP_FINAL, 0, 0, 0, 0, 0, 0, 0ull, 0ull, 0ull, 0ull, 0ull, 0, 0, 0, 0, 0, 0, 0, 0, -1ll},
constexpr int NENT = 28;
__constant__ PD PH_DEV[NENT] = { PH_TABLE };
#define XB_TMO      128
#define XB_XCNT(j)  (256  + 64 * (j))
#define XB_XSUB(j)  (1280 + 64 * (j))
#define XB_XGEN(j)  (2304 + 64 * (j))
#define XB_TOP      3328
#define XB_TOPGEN   3392
#define XCD_BAR_WORDS 3456
#define XB_SPIN_CAP (1u << 18)

__device__ __forceinline__ unsigned xb_ld(unsigned* p)              { return __hip_atomic_load(p, __ATOMIC_RELAXED, __HIP_MEMORY_SCOPE_AGENT); }
__device__ __forceinline__ unsigned xb_add(unsigned* p, unsigned v) { return __hip_atomic_fetch_add(p, v, __ATOMIC_RELAXED, __HIP_MEMORY_SCOPE_AGENT); }
__device__ __forceinline__ unsigned xb_xcc_id() { return (unsigned)__builtin_amdgcn_s_getreg((3 << 11) | 20) & 0xFu; }
#define XB_SPIN(cond, bar) do { unsigned _sp = 0; while (cond) { __builtin_amdgcn_s_sleep(1); \
    if ((++_sp & 255u) == 0u) { if (xb_ld(&(bar)[XB_TMO])) break; if (_sp > XB_SPIN_CAP) { atomicAdd(&(bar)[XB_TMO], 1u); break; } } } } while (0)

struct XcdBarrier {
    unsigned* bar; unsigned x;
    volatile LAS unsigned* st;
};

__device__ __forceinline__ XcdBarrier xcd_barrier_post(unsigned* bar, volatile LAS unsigned* st) {
    XcdBarrier b; b.bar = bar; b.x = xb_xcc_id(); b.st = st;
    if (threadIdx.x == 0) (void)xb_add(&bar[XB_XCNT(b.x)], 1u);
    return b;
}
__device__ __forceinline__ void xcd_barrier_complete(unsigned* bar, unsigned x, unsigned& nloc, unsigned& nx) {
    const unsigned G = gridDim.x * gridDim.y * gridDim.z;
    unsigned sum, cnt, mine, sp = 0u;
    for (;;) {
        sum = 0u; cnt = 0u; mine = 0u;
#pragma unroll
        for (unsigned j = 0; j < 16; ++j) { const unsigned c = xb_ld(&bar[XB_XCNT(j)]); sum += c; cnt += (c > 0u) ? 1u : 0u; mine = (j == x) ? c : mine; }
        if (sum == G) break;
        __builtin_amdgcn_s_sleep(1);
        if ((++sp & 255u) == 0u) { if (xb_ld(&bar[XB_TMO])) break; if (sp > XB_SPIN_CAP) { atomicAdd(&bar[XB_TMO], 1u); break; } }
    }
    nloc = mine > 0u ? mine : 1u; nx = cnt > 0u ? cnt : 1u;
}

__device__ __forceinline__ void xcd_barrier(const XcdBarrier& b) {
    asm volatile("s_waitcnt vmcnt(0)" ::: "memory");
    __syncthreads();
    if (threadIdx.x == 0) {
        unsigned* bar = b.bar;
        __builtin_amdgcn_s_waitcnt(0);
        unsigned nloc = b.st[0], nx = b.st[1];
        if (nloc == 0u) { xcd_barrier_complete(bar, b.x, nloc, nx); b.st[0] = nloc; b.st[1] = nx; }
        const unsigned old = xb_add(&bar[XB_XSUB(b.x)], 1u);
        const unsigned gen = old / nloc;
        if (old + 1u == (gen + 1u) * nloc) {
            __builtin_amdgcn_fence(__ATOMIC_RELEASE, "agent");
            asm volatile("s_waitcnt vmcnt(0)" ::: "memory");
            const unsigned og = xb_add(&bar[XB_TOP], 1u);
            const unsigned tg = og / nx;
            if (og + 1u == (tg + 1u) * nx) xb_add(&bar[XB_TOPGEN], 1u);
            else XB_SPIN(xb_ld(&bar[XB_TOPGEN]) == tg, bar);
            __builtin_amdgcn_fence(__ATOMIC_ACQUIRE, "agent");
            xb_add(&bar[XB_XGEN(b.x)], 1u);
            asm volatile("s_waitcnt vmcnt(0)" ::: "memory");
        } else {
            XB_SPIN(xb_ld(&bar[XB_XGEN(b.x)]) == gen, bar);
            __builtin_amdgcn_fence(__ATOMIC_ACQUIRE, "agent");
            asm volatile("s_waitcnt vmcnt(0)" ::: "memory");
        }
    }
    __syncthreads();
}

constexpr size_t WS_CTL = 3 * MiB, CTL_BYTES = 64 * 1024;
constexpr int MISC_OFF = LDS_BYTES - 128;

static const PD PH_HOST[NENT] = { PH_TABLE };

__global__ void __launch_bounds__(512, 2) mega_fwd(Args a) {
    extern __shared__ __attribute__((aligned(16))) unsigned char lds_raw[];
    cg::grid_group grid = cg::this_grid();
    Ctx C; C.lds = (LAS unsigned char*)lds_raw; C.tid = threadIdx.x; C.lane = C.tid & 63; C.wave = __builtin_amdgcn_readfirstlane(C.tid >> 6);
    C.G = gridDim.x; C.gw = blockIdx.x * 8 + C.wave; C.ngw = C.G * 8; C.gtid = blockIdx.x * 512 + C.tid; C.nthr = C.G * 512;
    unsigned char* ws = a.ws;
    float* H = a.out;
    for (int u = C.tid; u < 128 / 4; u += 512) ((LAS unsigned*)(C.lds + MISC_OFF))[u] = 0u;
    __syncthreads();
    (void)xcd_barrier_post((unsigned*)(ws + WS_CTL), (volatile LAS unsigned*)(C.lds + MISC_OFF) + 8);
    const ArgsP ap0 = (ArgsP)__builtin_amdgcn_kernarg_segment_ptr();
    unsigned char* const ws0 = ws; float* const H0 = H;
    for (int e = a.ph_lo; e < a.ph_hi; ++e) {
        ws = ws0; H = H0; ArgsP ap = ap0; asm volatile("" : "+s"(ap));
        { int t_ = threadIdx.x; asm volatile("" : "+v"(t_)); int g_ = gridDim.x, bx_ = blockIdx.x; asm volatile("" : "+s"(g_), "+s"(bx_));
          C.tid = t_; C.lane = t_ & 63; C.wave = __builtin_amdgcn_readfirstlane(t_ >> 6); C.G = g_; C.gw = bx_ * 8 + C.wave; C.ngw = g_ * 8; C.gtid = bx_ * 512 + t_; C.nthr = g_ * 512; }
        { GAS1 unsigned char* wg = (GAS1 unsigned char*)ws; GAS1 float* hg = (GAS1 float*)H; asm volatile("" : "+s"(wg), "+s"(hg)); ws = (unsigned char*)wg; H = (float*)hg; }
        const int op = PH_DEV[e].op, L = PH_DEV[e].L;
        if (op == OP_GSTORE) {
            const PD& d = PH_DEV[e];
            pg8::Gemm g{(const bf16*)(ws + d.a), (const bf16*)(ws + d.b), d.M, d.N, d.K}; pg8::StaticOrder S; S.init(g.M, g.N, C.G, (int)((blockIdx.x + C.G - d.rot) % C.G));
            pg8::EpiSeg E{(bf16*)(ws + d.p0), (bf16*)(ws + d.p1), (bf16*)(ws + d.p2), d.ld0, d.ld1, d.ld2, d.t1, d.t2, d.gelu0, d.ss >= 0 ? (const float*)(ws + d.ss) : (const float*)nullptr};
            __syncthreads();
            pg8::gemm_phase<pg8::EpiSeg, pg8::StaticOrder, true, true>((PG8_LAS unsigned char*)C.lds, g, S, E, C.tid);
            __syncthreads();
        } else if (op == OP_GCONV) {
            const PD& d = PH_DEV[e];
            pg8::Gemm g{(const bf16*)(ws + d.a), (const bf16*)(ws + d.b), d.M, d.N, d.K, 2, 34, SEQ}; pg8::StaticOrder S; S.init(g.M, g.N, C.G, (int)((blockIdx.x + C.G - d.rot) % C.G));
            pg8::EpiConv E{(bf16*)(ws + d.p0), (const float*)(ws + d.ss), INP(ap, I_FCONV) + (size_t)L * 3 * DFF2, 34, SEQ, DFF};
            __syncthreads();
            pg8::gemm_phase<pg8::EpiConv, pg8::StaticOrder, true, true>((PG8_LAS unsigned char*)C.lds, g, S, E, C.tid);
            __syncthreads();
        } else if (op == OP_GRESID) {
            const PD& d = PH_DEV[e];
            pg8::Gemm g{(const bf16*)(ws + d.a), (const bf16*)(ws + d.b), d.M, d.N, d.K}; pg8::StaticOrder S; S.init(g.M, g.N, C.G, (int)((blockIdx.x + C.G - d.rot) % C.G));
            pg8::EpiResid E{d.basex ? INP(ap, I_X) : (const float*)nullptr, (d.hb & 1) ? (const bf16*)H : (const bf16*)(ws + WS_HB), (d.hb & 2) ? (bf16*)H : (bf16*)(ws + WS_HB), d.ss >= 0 ? (float*)(ws + d.ss) : (float*)nullptr, DM};
            __syncthreads();
            pg8::gemm_phase<pg8::EpiResid, pg8::StaticOrder, true, true>((PG8_LAS unsigned char*)C.lds, g, S, E, C.tid);
            __syncthreads();
        } else if (op == OP_PRO0) {
            convert_weights(C, ap, 0, 0, C.gw, C.ngw);
            rms_all_rows(C, INP(ap, I_X), INP(ap, I_NMIX), (bf16*)(ws + WS_XN), NT, (bf16*)(ws + WS_XNP));
            rms_all_rows(C, INP(ap, I_MEM), INP(ap, I_MEMNORM), (bf16*)(ws + WS_MEMN), 2 * NMEM, (bf16*)(ws + WS_MEMNP));
        } else if (op == OP_KMEAN) {
            kmean_pooled(C, (const bf16*)(ws + WS_PROJ0), (float*)(ws + WS_KMEAN));
            if (C.G > 80) { if ((int)blockIdx.x >= 80) convert_weights(C, ap, 0, 1, C.gw - 80 * 8, C.ngw - 80 * 8); } else convert_weights(C, ap, 0, 1, C.gw, C.ngw);
        }
        else if (op == OP_MOBA) { moba_wg(C, (const bf16*)(ws + WS_PROJ0), (const bf16*)(ws + WS_VT), (const float*)(ws + WS_KMEAN), (bf16*)(ws + WS_MIX));
                                  pool_mfma(C, (const bf16*)(ws + WS_PROJ0), (const bf16*)(ws + WS_PWT), INP(ap, I_POOLS), (bf16*)(ws + WS_MIX)); }
        else if (op == OP_PRO1) { convert_weights(C, ap, 1, 0, C.gw, C.ngw); sgu_w_convert(C, INP(ap, I_SGUW), (bf16*)(ws + WS_WB)); rms_rows_bg(C, ap, (const bf16*)H, (bf16*)(ws + WS_XN), (float*)(ws + WS_BG)); }
        else if (op == OP_L1PREP) { l1_prep(C, ap, (const bf16*)(ws + WS_Z), (const bf16*)(ws + WS_QKV), (bf16*)(ws + WS_VNT), (bf16*)(ws + WS_QN), (bf16*)(ws + WS_KN), (bf16*)(ws + WS_VV)); }
        else if (op == OP_DNPREP) {
            dn_chunk_prep(C, (const bf16*)(ws + WS_QN), (const bf16*)(ws + WS_KN), (const bf16*)(ws + WS_VV), (const float*)(ws + WS_BG), (bf16*)(ws + WS_U), (bf16*)(ws + WS_W), (bf16*)(ws + WS_QD), (bf16*)(ws + WS_KDT), (bf16*)(ws + WS_QKM), (float*)(ws + WS_GL));
        }
        else if (op == OP_DNSCAN) {
            const int nscan = C.G > 64 ? 64 : 0;
            if ((int)blockIdx.x < nscan || nscan == 0) for (int it = blockIdx.x; it < 64; it += C.G) dn_scan(C, (const bf16*)(ws + WS_U), (const bf16*)(ws + WS_W), (const bf16*)(ws + WS_QD), (const bf16*)(ws + WS_KDT), (const bf16*)(ws + WS_QKM), (const float*)(ws + WS_GL), (float*)(ws + WS_O), it);
            if ((int)blockIdx.x >= nscan) { const int gw0 = C.gw - nscan * 8, ngw0 = C.ngw - nscan * 8;
                sgu_mfma(C, (const bf16*)(ws + WS_Z), (const bf16*)(ws + WS_VNT), (const bf16*)(ws + WS_WB), INP(ap, I_SGUBS), (bf16*)(ws + WS_MIX), gw0, ngw0);
                convert_weights(C, ap, 1, 1, gw0, ngw0); }
        }
        else if (op == OP_DNGATE) { dn_out_gate(C, ap, (const float*)(ws + WS_O), (const bf16*)(ws + WS_GATE), (bf16*)(ws + WS_MIX)); }
        else if (op == OP_RMSX) { rms_all_rows(C, H, INP(ap, I_NXATTN) + L * DM, (bf16*)(ws + WS_XN), NT); }
        else if (op == OP_XATTN) { xattn_wg(C, (const bf16*)(ws + WS_QX), (const bf16*)(ws + WS_KVX), (const bf16*)(ws + WS_VXT), (bf16*)(ws + WS_MIX)); }
        else if (op == OP_RMSF) { rms_all_rows(C, H, INP(ap, I_NFFN) + L * DM, (bf16*)(ws + WS_XN), NT); }
        else if (op == OP_ACT) { ffn_act(C, (const bf16*)(ws + WS_HUP), INP(ap, I_FCONV) + (size_t)L * 3 * DFF2, (bf16*)(ws + WS_ACT), PH_DEV[e].hb); }
        else if (op == OP_FINAL) { final_norm(C, (const bf16*)(ws + WS_HB), H, INP(ap, I_FNORM)); }
        if (PH_DEV[e].sync && e + 1 < a.ph_hi) { if (e < 0) grid.sync();   else { XcdBarrier bar; bar.bar = (unsigned*)(ws + WS_CTL); bar.x = xb_xcc_id(); bar.st = (volatile LAS unsigned*)(C.lds + MISC_OFF) + 8; xcd_barrier(bar); } }
    }
}

extern "C" void kernel_launch(void* const* d_in, const int* in_sizes, int n_in, void* d_out, int out_size, void* d_ws, size_t ws_size, hipStream_t stream) {
    static int grid = 0;
    if (grid == 0) {
        if (n_in != 27 || out_size != NT * DM || ws_size < WS_END) { fprintf(stderr, "kernel_launch: unexpected sizes n_in %d out %d ws %zu\n", n_in, out_size, ws_size); grid = -1; return; }
        int dev = 0, cus = 0, per_cu = 0;
        (void)hipGetDevice(&dev); (void)hipDeviceGetAttribute(&cus, hipDeviceAttributeMultiprocessorCount, dev);
        if (hipFuncSetAttribute((const void*)mega_fwd, hipFuncAttributeMaxDynamicSharedMemorySize, LDS_BYTES) != hipSuccess) { fprintf(stderr, "kernel_launch: hipFuncSetAttribute failed\n"); }
        if (hipOccupancyMaxActiveBlocksPerMultiprocessor(&per_cu, (const void*)mega_fwd, 512, LDS_BYTES) != hipSuccess || per_cu < 1) { fprintf(stderr, "kernel_launch: occupancy query says %d\n", per_cu); per_cu = 1; }
        (void)hipGetLastError();
        grid = cus * 1;
        if (grid <= 0) grid = 256;
    }
    if (grid < 0) return;
    if (hipMemsetAsync((char*)d_ws + WS_CTL, 0, CTL_BYTES, stream) != hipSuccess) { fprintf(stderr, "kernel_launch: hipMemsetAsync failed\n"); return; }
    Args a{};
    for (int i = 0; i < 27; ++i) a.in[i] = (const float*)d_in[i];
    a.out = (float*)d_out; a.ws = (unsigned char*)d_ws;
#if MK_MULTI
    for (int e0 = 0; e0 < NENT;) { int e1 = e0; while (e1 < NENT - 1 && !PH_HOST[e1].sync) ++e1; ++e1;
        a.ph_lo = e0; a.ph_hi = e1; void* args[] = {&a};
        hipError_t er = hipLaunchCooperativeKernel((const void*)mega_fwd, dim3(grid), dim3(512), args, LDS_BYTES, stream);
        if (er != hipSuccess) { fprintf(stderr, "launch %d failed: %s\n", e0, hipGetErrorString(er)); break; }
        e0 = e1; }
#else
    a.ph_lo = 0; a.ph_hi = NENT; void* args[] = {&a};
    hipError_t er = hipLaunchCooperativeKernel((const void*)mega_fwd, dim3(grid), dim3(512), args, LDS_BYTES, stream);
    if (er != hipSuccess) fprintf(stderr, "cooperative launch failed: %s (grid %d)\n", hipGetErrorString(er), grid);
#endif
}
```

```cpp
#include <hip/hip_runtime.h>
#include <hip/hip_cooperative_groups.h>
#include <cstdio>
#include <cstdint>
namespace cg = cooperative_groups;
namespace pg8 {
#define PG8_LAS __attribute__((address_space(3)))
typedef unsigned short bf16_t;
typedef short bf16x8 __attribute__((ext_vector_type(8)));
typedef float f32x4 __attribute__((ext_vector_type(4)));
typedef unsigned u32x4 __attribute__((ext_vector_type(4)));
constexpr int BM = 256, BK = 64, HALF = 128, HTB = HALF * BK * 2  , STAGE_BYTES = 8 * HTB, NXCD = 8, WGM = 8;

__host__ __device__ __forceinline__ int lds_byte(int r, int c) { const int st = (r >> 4) * 2 + (c >> 5), rr = r & 15, cc = c & 31, ob = rr * 64 + cc * 2; return st * 1024 + (ob ^ (((ob >> 9) & 1) << 5)); }
__host__ __device__ __forceinline__ void stage_rc(int b, int& R, int& C) { const int st = b / 1024, sb = b % 1024, swz = sb ^ (((sb >> 9) & 1) << 5); R = (st >> 1) * 16 + swz / 64; C = (st & 1) * 32 + (swz % 64) / 2; }
__host__ __device__ __forceinline__ int perm32(int rho) { const int n = rho >> 4, i = rho & 15; return 8 * (i >> 2) + 4 * n + (i & 3); }

struct Unit { int pm, pn; };
struct Gemm { const bf16_t* A; const bf16_t* Bt; int M, N, K; int ov, tpb, seq; };

struct StaticOrder {
    int nM, nN, nwg, G, c;
    __host__ __device__ void init(int M, int N, int G_, int c_) { nM = M / BM; nN = N / BM; nwg = nM * nN; G = G_; c = c_; }
    __host__ __device__ bool next(int i, Unit& u) const {
        const long L = (long)i * G + c; if (L >= nwg) return false;
        int wgid = (int)L; { const int q = nwg / NXCD, r = nwg % NXCD, xcd = wgid % NXCD, off = wgid / NXCD; wgid = (xcd < r ? xcd * (q + 1) : r * (q + 1) + (xcd - r) * q) + off; }
        const int nig = WGM * nN, gid = wgid / nig, fm = gid * WGM, gsz = (nM - fm) < WGM ? (nM - fm) : WGM;
        u.pm = fm + ((wgid % nig) % gsz); u.pn = (wgid % nig) / gsz; return true;
    }
    __device__ __forceinline__ void a_ready(const Unit&) const {}
    __device__ __forceinline__ void done(const Unit&) const {}
};

__device__ __forceinline__ unsigned cvt_pk_bf16(float lo, float hi) { unsigned r; asm volatile("v_cvt_pk_bf16_f32 %0, %1, %2" : "=v"(r) : "v"(lo), "v"(hi)); return r; }
__device__ __forceinline__ float gelu_tanh(float x) { const float u2 = 1.5957691216057308f * (x + 0.044715f * x * x * x); return x * __builtin_amdgcn_rcpf(1.0f + __expf(-u2)); }

struct EpiSeg {
    static constexpr bool PERM = true, AFTER_DRAIN = false;
    bf16_t* p0; bf16_t* p1; bf16_t* p2; int ld0, ld1, ld2, t1, t2, gelu0; const float* ss;
    __device__ __forceinline__ void operator()(const f32x4 (&acc)[2][2][4][2], const Unit& u, int wr, int wc, int fr, int fq) const {
        bf16_t* base; int ld, colt; bool act = false;
        if (u.pn < t1) { base = p0; ld = ld0; colt = u.pn * BM; act = gelu0 != 0; }
        else if (u.pn < t2) { base = p1; ld = ld1; colt = (u.pn - t1) * BM; }
        else { base = p2; ld = ld2; colt = (u.pn - t2) * BM; }
        const int row0 = u.pm * BM + wr * 64 + fr, col0 = colt + wc * 32 + 8 * fq;
#pragma unroll
        for (int ai = 0; ai < 2; ++ai)
#pragma unroll
            for (int m = 0; m < 4; ++m) { bf16_t* rowp = base + (size_t)(row0 + ai * HALF + m * 16) * ld + col0;
                float rs = 1.0f;
                if (ss) { const f32x4* sp = (const f32x4*)(ss + (size_t)(row0 + ai * HALF + m * 16) * 16); const f32x4 s0 = sp[0], s1 = sp[1], s2 = sp[2], s3 = sp[3];
                    const float tot = ((s0[0] + s0[1]) + (s0[2] + s0[3])) + ((s1[0] + s1[1]) + (s1[2] + s1[3])) + ((s2[0] + s2[1]) + (s2[2] + s2[3])) + ((s3[0] + s3[1]) + (s3[2] + s3[3]));
                    rs = 1.0f / sqrtf(tot * (1.0f / 1024.0f) + 1e-6f); }
#pragma unroll
                for (int bj = 0; bj < 2; ++bj) { f32x4 v0 = acc[ai][bj][m][0] * rs, v1 = acc[ai][bj][m][1] * rs;
                    if (act) { v0 = (f32x4){gelu_tanh(v0[0]), gelu_tanh(v0[1]), gelu_tanh(v0[2]), gelu_tanh(v0[3])}; v1 = (f32x4){gelu_tanh(v1[0]), gelu_tanh(v1[1]), gelu_tanh(v1[2]), gelu_tanh(v1[3])}; }
                    u32x4 w; w.x = cvt_pk_bf16(v0[0], v0[1]); w.y = cvt_pk_bf16(v0[2], v0[3]); w.z = cvt_pk_bf16(v1[0], v1[1]); w.w = cvt_pk_bf16(v1[2], v1[3]);
                    *(u32x4*)(rowp + bj * HALF) = w; } }
    }
};
struct EpiResid {
    static constexpr bool PERM = true, AFTER_DRAIN = false;
    const float* basef; const bf16_t* baseh; bf16_t* hb; float* ss; int ld;
    __device__ __forceinline__ void operator()(const f32x4 (&acc)[2][2][4][2], const Unit& u, int wr, int wc, int fr, int fq) const {
        const int col0 = u.pn * BM + wc * 32 + 8 * fq;
#pragma unroll
        for (int ai = 0; ai < 2; ++ai)
#pragma unroll
            for (int m = 0; m < 4; ++m) { const size_t off = (size_t)(u.pm * BM + ai * HALF + wr * 64 + m * 16 + fr) * ld + col0; float sq = 0.f;
#pragma unroll
                for (int bj = 0; bj < 2; ++bj) { f32x4 b0, b1;
                    if (basef) { b0 = *(const f32x4*)(basef + off + bj * HALF); b1 = *(const f32x4*)(basef + off + bj * HALF + 4); }
                    else { const u32x4 w = *(const u32x4*)(baseh + off + bj * HALF);
                        b0[0] = __uint_as_float(w.x << 16); b0[1] = __uint_as_float(w.x & 0xffff0000u); b0[2] = __uint_as_float(w.y << 16); b0[3] = __uint_as_float(w.y & 0xffff0000u);
                        b1[0] = __uint_as_float(w.z << 16); b1[1] = __uint_as_float(w.z & 0xffff0000u); b1[2] = __uint_as_float(w.w << 16); b1[3] = __uint_as_float(w.w & 0xffff0000u); }
                    const f32x4 o0 = b0 + acc[ai][bj][m][0], o1 = b1 + acc[ai][bj][m][1];
                    sq += ((o0[0] * o0[0] + o0[1] * o0[1]) + (o0[2] * o0[2] + o0[3] * o0[3])) + ((o1[0] * o1[0] + o1[1] * o1[1]) + (o1[2] * o1[2] + o1[3] * o1[3]));
                    u32x4 w2; w2.x = cvt_pk_bf16(o0[0], o0[1]); w2.y = cvt_pk_bf16(o0[2], o0[3]); w2.z = cvt_pk_bf16(o1[0], o1[1]); w2.w = cvt_pk_bf16(o1[2], o1[3]); *(u32x4*)(hb + off + bj * HALF) = w2; }
                if (ss) { sq += __shfl_xor(sq, 16); sq += __shfl_xor(sq, 32); if (fq == 0) ss[(size_t)(u.pm * BM + ai * HALF + wr * 64 + m * 16 + fr) * 16 + u.pn * 4 + wc] = sq; } }
    }
};
struct EpiConv {
    static constexpr bool PERM = true, AFTER_DRAIN = false;
    static __device__ __forceinline__ float shr16(float oldv, float v, int d) { const int o = __builtin_bit_cast(int, oldv), x = __builtin_bit_cast(int, v); const int y = d == 1 ? __builtin_amdgcn_update_dpp(o, x, 0x111, 0xf, 0xf, false) : __builtin_amdgcn_update_dpp(o, x, 0x112, 0xf, 0xf, false); return __builtin_bit_cast(float, y); }
    static __device__ __forceinline__ float ror16(float v, int d) { const int x = __builtin_bit_cast(int, v); const int y = d == 1 ? __builtin_amdgcn_mov_dpp(x, 0x121, 0xf, 0xf, false) : __builtin_amdgcn_mov_dpp(x, 0x122, 0xf, 0xf, false); return __builtin_bit_cast(float, y); }
    bf16_t* O; const float* ss; const float* cw; int tpb, seq, dff;
    __device__ __forceinline__ void operator()(const f32x4 (&acc)[2][2][4][2], const Unit& u, int wr, int wc, int fr, int fq) const {
        const int lane = fq * 16 + fr, b = u.pm / tpb, pmm = u.pm % tpb, ch0 = u.pn * 128 + wc * 32 + 8 * fq;
#pragma unroll
        for (int ai = 0; ai < 2; ++ai) {
            const int tl0 = pmm * 248 + (2 * ai + wr) * 62 - 2;
            float rs[4];
#pragma unroll
            for (int m = 0; m < 4; ++m) { const int tl = tl0 + 16 * m + fr; float r_ = 0.f;
                if (tl >= 0 && tl < seq) { const f32x4* sp = (const f32x4*)(ss + ((size_t)b * seq + tl) * 16); const f32x4 s0 = sp[0], s1 = sp[1], s2 = sp[2], s3 = sp[3];
                    const float tot = ((s0[0] + s0[1]) + (s0[2] + s0[3])) + ((s1[0] + s1[1]) + (s1[2] + s1[3])) + ((s2[0] + s2[1]) + (s2[2] + s2[3])) + ((s3[0] + s3[1]) + (s3[2] + s3[3]));
                    r_ = 1.0f / sqrtf(tot * (1.0f / 1024.0f) + 1e-6f); }
                rs[m] = r_; }
#pragma unroll
            for (int n = 0; n < 2; ++n) {
                f32x4 wg[3], wu[3];
#pragma unroll
                for (int k = 0; k < 3; ++k) { wg[k] = *(const f32x4*)(cw + (size_t)k * 2 * dff + ch0 + 4 * n); wu[k] = *(const f32x4*)(cw + (size_t)k * 2 * dff + dff + ch0 + 4 * n); }
                float pv[2][4];
#pragma unroll
                for (int bj = 0; bj < 2; ++bj)
#pragma unroll
                    for (int i = 0; i < 4; ++i) pv[bj][i] = 0.f;
#pragma unroll
                for (int m = 0; m < 4; ++m) {
                    const int tl = tl0 + 16 * m + fr; const bool ok = (16 * m + fr >= 2) && tl < seq;
                    float o[4];
#pragma unroll
                    for (int i = 0; i < 4; ++i) { float cv[2];
#pragma unroll
                        for (int bj = 0; bj < 2; ++bj) {
                            const float cur = rs[m] > 0.f ? acc[ai][bj][m][n][i] * rs[m] : 0.f;
                            const float p1 = shr16(ror16(pv[bj][i], 1), cur, 1), p2 = shr16(ror16(pv[bj][i], 2), cur, 2);
                            pv[bj][i] = cur;
                            cv[bj] = bj == 0 ? (wg[0][i] * p2 + wg[1][i] * p1 + wg[2][i] * cur) : (wu[0][i] * p2 + wu[1][i] * p1 + wu[2][i] * cur); }
                        o[i] = cv[0] * __builtin_amdgcn_rcpf(1.0f + __expf(-cv[0])) * cv[1]; }
                    if (ok) { typedef unsigned u32x2e __attribute__((ext_vector_type(2))); u32x2e w; w.x = cvt_pk_bf16(o[0], o[1]); w.y = cvt_pk_bf16(o[2], o[3]);
                        *(u32x2e*)(O + ((size_t)b * seq + tl) * dff + ch0 + 4 * n) = w; }
                }
            }
        }
    }
};
template <class Epi, class Sched, bool ALIGN_EPI = false, bool SP2 = false>
__device__ __forceinline__ void gemm_phase(PG8_LAS unsigned char* lds, const Gemm g, const Sched& S, const Epi& E, const int tid_in) {
    const int tid = tid_in, wid = __builtin_amdgcn_readfirstlane(tid >> 6), lane = tid & 63, wr = wid >> 2, wc = wid & 3, fr = lane & 15, fq = lane >> 4;
    const int K = g.K, nt = K / BK;
    unsigned voffA[2], voffB[2];
#pragma unroll
    for (int i = 0; i < 2; ++i) { int R, C; stage_rc(tid * 16 + i * 8192, R, C); const int Rb = Epi::PERM ? ((R & ~31) + perm32(R & 31)) : R;
        voffA[i] = (unsigned)((R - (R >> 6) * g.ov) * K + C) * 2u; voffB[i] = (unsigned)(Rb * K + C) * 2u; }
    const size_t kstep = (size_t)(BK * 2);
    const size_t hstep = (size_t)HALF * K * 2;
    const size_t tstep = 2 * hstep;
    const size_t hstepA = (size_t)(HALF - 2 * g.ov) * K * 2;
#define PG8_ABASE(pm_) ((const char*)g.A + (g.ov ? ((size_t)((pm_) / g.tpb) * g.seq + (size_t)((pm_) % g.tpb) * (BM - 4 * g.ov)) * K * 2 - (size_t)g.ov * K * 2 : (size_t)(pm_) * tstep))
    const unsigned ldsw = (unsigned)wid * 1024u;
    const int aoff = lds_byte(wr * 64 + fr, fq * 8), boff = lds_byte(wc * 32 + fr, fq * 8);
#define PG8_SA(b, h) (((b) * 2 + (h)) * HTB)
#define PG8_SB(b, h) ((4 + (b) * 2 + (h)) * HTB)
#define PG8_STAGE(bufoff, gbase, voff) do { _Pragma("unroll") for (int _i = 0; _i < 2; ++_i) \
        __builtin_amdgcn_global_load_lds((const unsigned*)((const char*)(gbase) + (voff)[_i]), (PG8_LAS unsigned*)(lds + (bufoff) + ldsw + _i * 8192), 16, 0, 0); } while (0)
#define PG8_LDA(dst, b, h) do { _Pragma("unroll") for (int m = 0; m < 4; ++m) _Pragma("unroll") for (int k = 0; k < 2; ++k) dst[m][k] = *(const PG8_LAS bf16x8*)(lds + PG8_SA(b, h) + aoff + m * 2048 + k * 1024); } while (0)
#define PG8_LDB(dst, b, h) do { _Pragma("unroll") for (int n = 0; n < 2; ++n) _Pragma("unroll") for (int k = 0; k < 2; ++k) dst[n][k] = *(const PG8_LAS bf16x8*)(lds + PG8_SB(b, h) + boff + n * 2048 + k * 1024); } while (0)
#define PG8_MMA(ai, bj, At, Bt) do { __builtin_amdgcn_s_setprio(1); _Pragma("unroll") for (int m = 0; m < 4; ++m) _Pragma("unroll") for (int n = 0; n < 2; ++n) _Pragma("unroll") for (int k = 0; k < 2; ++k) \
        acc[ai][bj][m][n] = __builtin_amdgcn_mfma_f32_16x16x32_bf16(Bt[n][k], At[m][k], acc[ai][bj][m][n], 0, 0, 0); __builtin_amdgcn_s_setprio(0); } while (0)
#define PG8_WAIT_V(n) asm volatile("s_waitcnt vmcnt(" #n ")" ::: "memory")
#define PG8_WAIT_L(n) asm volatile("s_waitcnt lgkmcnt(" #n ")" ::: "memory")
#define PG8_BAR __builtin_amdgcn_s_barrier()
#define PG8_SCHED __builtin_amdgcn_sched_barrier(0)
    Unit cur, nxt; int ui = 0;
    if (!S.next(0, cur)) return;
    f32x4 acc[2][2][4][2];
#pragma unroll
    for (int a = 0; a < 2; ++a)
#pragma unroll
        for (int b = 0; b < 2; ++b)
#pragma unroll
            for (int m = 0; m < 4; ++m)
#pragma unroll
                for (int n = 0; n < 2; ++n) acc[a][b][m][n] = (f32x4){0.f, 0.f, 0.f, 0.f};
    bf16x8 At[4][2], B0[2][2], B1[2][2];
    const char* cA = PG8_ABASE(cur.pm); const char* cB = (const char*)g.Bt + (size_t)cur.pn * tstep;
    S.a_ready(cur);
    if constexpr (SP2) {
        PG8_STAGE(PG8_SB(0, 0), cB, voffB); PG8_STAGE(PG8_SB(0, 1), cB + hstep, voffB); PG8_STAGE(PG8_SA(0, 0), cA, voffA); PG8_STAGE(PG8_SA(0, 1), cA + hstepA, voffA);
        if (wr == 1) PG8_BAR;
        PG8_WAIT_V(2); PG8_BAR;
        PG8_STAGE(PG8_SB(1, 0), cB + kstep, voffB); PG8_STAGE(PG8_SA(1, 0), cA + kstep, voffA); PG8_STAGE(PG8_SB(1, 1), cB + hstep + kstep, voffB);
        PG8_WAIT_V(6); PG8_BAR;
    } else {
        PG8_STAGE(PG8_SB(0, 0), cB, voffB); PG8_STAGE(PG8_SA(0, 0), cA, voffA); PG8_STAGE(PG8_SB(0, 1), cB + hstep, voffB); PG8_STAGE(PG8_SA(0, 1), cA + hstepA, voffA);
        if (wr == 1) PG8_BAR;
        PG8_WAIT_V(4); PG8_BAR;
        PG8_STAGE(PG8_SB(1, 0), cB + kstep, voffB); PG8_STAGE(PG8_SA(1, 0), cA + kstep, voffA); PG8_STAGE(PG8_SB(1, 1), cB + hstep + kstep, voffB);
        PG8_WAIT_V(6); PG8_BAR;
    }
    for (;;) {
        const bool has_next = S.next(ui + 1, nxt);
        const char* nA = has_next ? PG8_ABASE(nxt.pm) : cA; const char* nB = has_next ? (const char*)g.Bt + (size_t)nxt.pn * tstep : cB;
        for (int t = 0; t < nt; t += 2) {
            const bool last = (t == nt - 2);
            const char* a1 = cA + (size_t)(t + 1) * kstep;
            const char* a2 = last ? nA : cA + (size_t)(t + 2) * kstep; const char* b2 = last ? nB : cB + (size_t)(t + 2) * kstep;
            const char* a3 = a2 + kstep; const char* b3 = b2 + kstep;
            if (last && has_next) S.a_ready(nxt);
            if constexpr (SP2) {
            PG8_LDB(B0, 0, 0); PG8_LDB(B1, 0, 1); PG8_SCHED; PG8_LDA(At, 0, 0); PG8_STAGE(PG8_SA(1, 1), a1 + hstepA, voffA);
            PG8_WAIT_V(8); PG8_WAIT_L(0); PG8_BAR; PG8_MMA(0, 0, At, B0); PG8_MMA(0, 1, At, B1); PG8_BAR; PG8_SCHED;
            PG8_LDA(At, 0, 1); PG8_STAGE(PG8_SB(0, 0), b2, voffB); PG8_STAGE(PG8_SB(0, 1), b2 + hstep, voffB); PG8_STAGE(PG8_SA(0, 0), a2, voffA);
            PG8_WAIT_V(8); PG8_WAIT_L(0); PG8_BAR; PG8_MMA(1, 0, At, B0); PG8_MMA(1, 1, At, B1); PG8_BAR; PG8_SCHED;
            PG8_LDB(B0, 1, 0); PG8_LDB(B1, 1, 1); PG8_SCHED; PG8_LDA(At, 1, 0); PG8_STAGE(PG8_SA(0, 1), a2 + hstepA, voffA);
            PG8_WAIT_V(8); PG8_WAIT_L(0); PG8_BAR; PG8_MMA(0, 0, At, B0); PG8_MMA(0, 1, At, B1); PG8_BAR; PG8_SCHED;
            PG8_LDA(At, 1, 1); PG8_STAGE(PG8_SB(1, 0), b3, voffB); PG8_STAGE(PG8_SB(1, 1), b3 + hstep, voffB); PG8_STAGE(PG8_SA(1, 0), a3, voffA);
            PG8_WAIT_V(8); PG8_WAIT_L(0); PG8_BAR; PG8_MMA(1, 0, At, B0); PG8_MMA(1, 1, At, B1); PG8_BAR; PG8_SCHED;
            } else {
            PG8_LDB(B0, 0, 0); PG8_SCHED; PG8_LDA(At, 0, 0); PG8_STAGE(PG8_SA(1, 1), a1 + hstepA, voffA);
            PG8_WAIT_L(8); PG8_BAR; PG8_WAIT_L(0); PG8_MMA(0, 0, At, B0); PG8_BAR; PG8_SCHED;
            PG8_LDB(B1, 0, 1); PG8_STAGE(PG8_SB(0, 0), b2, voffB);
            PG8_BAR; PG8_WAIT_L(0); PG8_MMA(0, 1, At, B1); PG8_BAR;
            PG8_LDA(At, 0, 1); PG8_STAGE(PG8_SA(0, 0), a2, voffA);
            PG8_BAR; PG8_WAIT_L(0); PG8_MMA(1, 0, At, B0); PG8_BAR; PG8_SCHED;
            PG8_STAGE(PG8_SB(0, 1), b2 + hstep, voffB);
            PG8_WAIT_V(6); PG8_BAR; PG8_MMA(1, 1, At, B1); PG8_BAR;
            PG8_LDB(B0, 1, 0); PG8_SCHED; PG8_LDA(At, 1, 0); PG8_STAGE(PG8_SA(0, 1), a2 + hstepA, voffA);
            PG8_WAIT_L(8); PG8_BAR; PG8_WAIT_L(0); PG8_MMA(0, 0, At, B0); PG8_BAR; PG8_SCHED;
            PG8_LDB(B1, 1, 1); PG8_STAGE(PG8_SB(1, 0), b3, voffB);
            PG8_BAR; PG8_WAIT_L(0); PG8_MMA(0, 1, At, B1); PG8_BAR;
            PG8_LDA(At, 1, 1); PG8_STAGE(PG8_SA(1, 0), a3, voffA);
            PG8_BAR; PG8_WAIT_L(0); PG8_MMA(1, 0, At, B0); PG8_BAR; PG8_SCHED;
            PG8_STAGE(PG8_SB(1, 1), b3 + hstep, voffB);
            PG8_WAIT_V(6); PG8_BAR; PG8_MMA(1, 1, At, B1); PG8_BAR;
            }
        }
        if constexpr (ALIGN_EPI) { if (wr == 0) PG8_BAR; }
        if constexpr (!Epi::AFTER_DRAIN) { E(acc, cur, wr, wc, fr, fq); S.done(cur); }
        if (!has_next) break;
#pragma unroll
        for (int a = 0; a < 2; ++a)
#pragma unroll
            for (int b = 0; b < 2; ++b)
#pragma unroll
                for (int m = 0; m < 4; ++m)
#pragma unroll
                    for (int n = 0; n < 2; ++n) acc[a][b][m][n] = (f32x4){0.f, 0.f, 0.f, 0.f};
        cur = nxt; cA = nA; cB = nB; ++ui;
        if constexpr (ALIGN_EPI) { if (wr == 1) PG8_BAR; }
    }
    PG8_WAIT_V(0);
    if constexpr (!ALIGN_EPI) { if (wr == 0) PG8_BAR; }
    PG8_BAR;
    if constexpr (Epi::AFTER_DRAIN) { E.fused(acc, cur, wr, wc, fr, fq, lds, wid, lane); S.done(cur); }
#undef PG8_ABASE
#undef PG8_SA
#undef PG8_SB
#undef PG8_STAGE
#undef PG8_LDA
#undef PG8_LDB
#undef PG8_MMA
#undef PG8_WAIT_V
#undef PG8_WAIT_L
#undef PG8_BAR
#undef PG8_SCHED
}
}

constexpr int NT = 16384, SEQ = 8192, DM = 1024, NMEM = 256, DFF = 2816, DFF2 = 5632;
constexpr float EPS = 1e-6f;
#define LAS __attribute__((address_space(3)))
typedef unsigned short bf16;
typedef float f32x4 __attribute__((ext_vector_type(4)));
typedef unsigned u32x4 __attribute__((ext_vector_type(4)));
typedef unsigned u32x2 __attribute__((ext_vector_type(2)));
constexpr size_t MiB = 1u << 20;
constexpr size_t WS_MEMN = 0, WS_BG = 1 * MiB, WS_KMEAN = 1 * MiB + 512 * 1024;
constexpr size_t WS_WTS = 4 * MiB;
constexpr size_t W_IN = WS_WTS, W_OUT = WS_WTS + 6 * MiB, W_Q = WS_WTS + 8 * MiB, W_KV = WS_WTS + 10 * MiB, W_O = WS_WTS + 14 * MiB, W_UP = WS_WTS + 16 * MiB, W_DN = WS_WTS + 27 * MiB;
constexpr size_t WS_XN = 37 * MiB, WS_KVX = 69 * MiB, WS_MIX = 71 * MiB, WS_QX = 103 * MiB, WS_F = 135 * MiB;
constexpr size_t WS_PROJ0 = WS_F, WS_Z = WS_F, WS_QKV = WS_F + 32 * MiB, WS_GATE = WS_F + 80 * MiB, WS_O = WS_QX;
constexpr size_t WS_U = WS_F + 32 * MiB, WS_W = WS_F + 48 * MiB, WS_KDT = WS_F + 64 * MiB, WS_QD = WS_F + 96 * MiB, WS_QKM = WS_F + 112 * MiB, WS_GL = 1 * MiB + 768 * 1024;
constexpr size_t WS_VT = WS_F + 48 * MiB, WS_XNP = WS_F + 64 * MiB, WS_MEMNP = 2 * MiB, WS_VXT = WS_KVX + 1 * MiB;
constexpr size_t WS_PWT = 3 * MiB + 64 * 1024, WS_WB = 3 * MiB + 256 * 1024;
constexpr size_t WS_VNT = WS_XN, WS_HB = WS_XN, WS_SS = 248 * MiB;
constexpr size_t WS_POOLED = WS_QX, WS_VN = WS_XN, WS_VV = WS_XN + 16 * MiB, WS_QN = WS_QX, WS_KN = WS_QX + 16 * MiB;
constexpr size_t WS_ACT = WS_MIX, WS_HUP = WS_MIX + 88 * MiB, WS_END = 256 * MiB;
static_assert(WS_HUP + 88 * MiB <= WS_END && WS_GATE + 16 * MiB <= WS_QD && WS_QKM + 8 * MiB <= WS_END, "ws map");
constexpr int LDS_BYTES = 147456;

__device__ __forceinline__ float bf2f(unsigned v) { return __uint_as_float(v << 16); }
__device__ __forceinline__ unsigned f2bf(float f) { unsigned u = __float_as_uint(f); return (u + 0x7fffu + ((u >> 16) & 1u)) >> 16; }
__device__ __forceinline__ unsigned pk2(float lo, float hi) { return f2bf(lo) | (f2bf(hi) << 16); }
__device__ __forceinline__ float lo16(unsigned w) { return __uint_as_float(w << 16); }
__device__ __forceinline__ float hi16(unsigned w) { return __uint_as_float(w & 0xffff0000u); }
__device__ __forceinline__ float wave_sum(float v) {
#pragma unroll
    for (int o = 1; o < 64; o <<= 1) v += __shfl_xor(v, o);
    return v;
}
__device__ __forceinline__ float wave_max(float v) {
#pragma unroll
    for (int o = 1; o < 64; o <<= 1) v = fmaxf(v, __shfl_xor(v, o));
    return v;
}
__device__ __forceinline__ float silu_f(float x) { return x * __builtin_amdgcn_rcpf(1.0f + __expf(-x)); }
#define LDS_WAIT() asm volatile("s_waitcnt lgkmcnt(0)" ::: "memory")

struct Args { const float* in[27]; float* out; unsigned char* ws; int ph_lo, ph_hi; };
typedef const __attribute__((address_space(4))) Args* ArgsP;
#define GAS1 __attribute__((address_space(1)))
__device__ __forceinline__ const float* inp_ptr(ArgsP ap, int i) { GAS1 const float* g = (GAS1 const float*)ap->in[i]; asm volatile("" : "+s"(g)); return (const float*)g; }
__device__ __forceinline__ unsigned char* ws_ptr(ArgsP ap) { GAS1 unsigned char* g = (GAS1 unsigned char*)ap->ws; asm volatile("" : "+s"(g)); return (unsigned char*)g; }
#define INP(ap, i) inp_ptr((ap), (i))
enum { I_X = 0, I_MEM, I_MEMNORM, I_NMIX, I_NXATTN, I_NFFN, I_EVIN, I_POOLW, I_POOLS, I_EVOUT, I_ODIN, I_SGUG, I_SGUB, I_SGUW, I_SGUBS, I_DNCONV, I_DNALOG, I_DNDT, I_DNNG, I_ODOUT,
       I_WQ, I_WKV, I_WO, I_FUP, I_FCONV, I_FDN, I_FNORM };

struct Ctx { LAS unsigned char* lds; int tid, lane, wave, G, gw, ngw, gtid, nthr; };

__device__ __forceinline__ void transpose_item(const float* W, int ldw, int K, int ncols, bf16* WT, LAS float* scr, int item, int lane, const float* gain = nullptr, int guperm = 0) {
    const int nblk = ncols / 32, kb = item / nblk, nb = item % nblk, k0 = 64 * kb, n0 = 32 * nb;
#pragma unroll
    for (int i = 0; i < 8; ++i) { const int kk = 8 * i + (lane >> 3), c4 = lane & 7;
        const f32x4 v = *(const f32x4*)(W + (size_t)(k0 + kk) * ldw + n0 + 4 * c4); const float gk = gain ? gain[k0 + kk] : 1.0f;
        LAS float* d = scr + kk * 33 + 4 * c4; d[0] = v.x * gk; d[1] = v.y * gk; d[2] = v.z * gk; d[3] = v.w * gk; }
    LDS_WAIT();
    const int c = lane & 7;
    int drow = n0; if (guperm) { const int isu = n0 >= guperm ? 1 : 0, nn = n0 - isu * guperm; drow = 256 * (nn >> 7) + 128 * isu + (nn & 127); }
#pragma unroll
    for (int j = 0; j < 4; ++j) { const int n = (lane >> 3) + 8 * j; const LAS float* s = scr + (8 * c) * 33 + n;
        u32x4 o; o.x = pk2(s[0 * 33], s[1 * 33]); o.y = pk2(s[2 * 33], s[3 * 33]); o.z = pk2(s[4 * 33], s[5 * 33]); o.w = pk2(s[6 * 33], s[7 * 33]);
        *(u32x4*)(WT + (size_t)(drow + n) * K + k0 + 8 * c) = o; }
    LDS_WAIT();
}
__device__ __forceinline__ void convert_weights(const Ctx& C, ArgsP a, int L, int part, int gw0, int ngw0) {
    LAS float* scr = (LAS float*)(C.lds + C.wave * 16384);
    unsigned char* ws = ws_ptr(a);
    const float* w_in = L == 0 ? INP(a, I_EVIN) : INP(a, I_ODIN); const int n_in = L == 0 ? 2048 : 3072, ld_in = L == 0 ? 2048 : 3080;
    const float* w_out = L == 0 ? INP(a, I_EVOUT) : INP(a, I_ODOUT);
    const float* wq = INP(a, I_WQ) + (size_t)L * DM * DM; const float* wkv = INP(a, I_WKV) + (size_t)L * DM * 2 * DM; const float* wo = INP(a, I_WO) + (size_t)L * DM * DM;
    const float* wup = INP(a, I_FUP) + (size_t)L * DM * DFF2; const float* wdn = INP(a, I_FDN) + (size_t)L * DFF * DM;
    const int i0 = (DM / 64) * (n_in / 32), i1 = (DM / 64) * (DM / 32), i2 = i1, i3 = (DM / 64) * (2 * DM / 32), i4 = i1, i5 = (DM / 64) * (DFF2 / 32), i6 = (DFF / 64) * (DM / 32);
    const int total = i0 + i1 + i2 + i3 + i4 + i5 + i6;
    for (int it = gw0; it < total; it += ngw0) {
        int r = it;
        { const bool first = (r < i0 + i1) || (r >= i0 + i1 + i2 && r < i0 + i1 + i2 + i3); if ((part == 0 && !first) || (part == 1 && first)) continue; }
        if (r < i0) {
            if (L == 0) {
                const int ia = (DM / 64) * (1024 / 32), ib = (DM / 64) * (512 / 32);
                if (r < ia) transpose_item(w_in, ld_in, DM, 1024, (bf16*)(ws + W_IN), scr, r, C.lane);
                else if (r < ia + ib) transpose_item(w_in + 1536, ld_in, DM, 512, (bf16*)(ws + W_IN) + (size_t)1024 * DM, scr, r - ia, C.lane);
                else transpose_item(w_in + 1024, ld_in, DM, 512, (bf16*)(ws + W_IN) + (size_t)1536 * DM, scr, r - ia - ib, C.lane);
            } else transpose_item(w_in, ld_in, DM, n_in, (bf16*)(ws + W_IN), scr, r, C.lane);
            continue; } r -= i0;
        if (r < i1) { transpose_item(w_out, DM, DM, DM, (bf16*)(ws + W_OUT), scr, r, C.lane); continue; } r -= i1;
        if (r < i2) { transpose_item(wq, DM, DM, DM, (bf16*)(ws + W_Q), scr, r, C.lane, INP(a, I_NXATTN) + L * DM); continue; } r -= i2;
        if (r < i3) { transpose_item(wkv, 2 * DM, DM, 2 * DM, (bf16*)(ws + W_KV), scr, r, C.lane); continue; } r -= i3;
        if (r < i4) { transpose_item(wo, DM, DM, DM, (bf16*)(ws + W_O), scr, r, C.lane); continue; } r -= i4;
        if (r < i5) { transpose_item(wup, DFF2, DM, DFF2, (bf16*)(ws + W_UP), scr, r, C.lane, INP(a, I_NFFN) + L * DM, DFF); continue; } r -= i5;
        transpose_item(wdn, DM, DFF, DM, (bf16*)(ws + W_DN), scr, r, C.lane);
    }
    if (L == 0) for (int it = gw0; it < 32; it += ngw0) { const int g = it >> 3; transpose_item(INP(a, I_POOLW) + (size_t)g * 128 * 128, 128, 128, 128, (bf16*)(ws + WS_PWT) + (size_t)g * 128 * 128, scr, it & 7, C.lane); }
}
__device__ __forceinline__ void rms_row_bf16(const float* xrow, const float* gain, bf16* orow, int lane, bf16* orow2 = nullptr) {
    const f32x4* xr = (const f32x4*)xrow + lane; const f32x4* gr = (const f32x4*)gain + lane;
    f32x4 v[4]; float s = 0.f;
#pragma unroll
    for (int j = 0; j < 4; ++j) { v[j] = xr[64 * j]; s += (v[j].x * v[j].x + v[j].y * v[j].y) + (v[j].z * v[j].z + v[j].w * v[j].w); }
    const float r = 1.0f / sqrtf(wave_sum(s) * (1.0f / DM) + EPS);
    u32x2* o8 = (u32x2*)orow + lane;
#pragma unroll
    for (int j = 0; j < 4; ++j) { const f32x4 g = gr[64 * j]; u32x2 w; w.x = pk2(v[j].x * r * g.x, v[j].y * r * g.y); w.y = pk2(v[j].z * r * g.z, v[j].w * r * g.w); o8[64 * j] = w; if (orow2) ((u32x2*)orow2 + lane)[64 * j] = w; }
}
__device__ __forceinline__ int perm32k_pos(int s) { return (s < 16) ? (8 * (s >> 2) + (s & 3)) : (8 * ((s - 16) >> 2) + 4 + (s & 3)); }
__device__ __forceinline__ void rms_all_rows(const Ctx& C, const float* src, const float* gain, bf16* dst, int nrows, bf16* dstp = nullptr) {
    for (int m = C.gw; m < nrows; m += C.ngw) rms_row_bf16(src + (size_t)m * DM, gain, dst + (size_t)m * DM, C.lane, dstp ? dstp + (size_t)((m & ~31) + perm32k_pos(m & 31)) * DM : nullptr);
}
__device__ __forceinline__ void rms_rows_bg(const Ctx& C, ArgsP a, const bf16* HBin, bf16* XN, float* BG) {
    const float* gain = INP(a, I_NMIX) + DM; const float* W = INP(a, I_ODIN);
    const int lane = C.lane;
    for (int m = C.gw; m < NT; m += C.ngw) {
        const u32x2* xr = (const u32x2*)(HBin + (size_t)m * DM) + lane; const f32x4* gr = (const f32x4*)gain + lane;
        f32x4 v[4]; float s = 0.f;
#pragma unroll
        for (int j = 0; j < 4; ++j) { const u32x2 w_ = xr[64 * j]; v[j].x = lo16(w_.x); v[j].y = hi16(w_.x); v[j].z = lo16(w_.y); v[j].w = hi16(w_.y); s += (v[j].x * v[j].x + v[j].y * v[j].y) + (v[j].z * v[j].z + v[j].w * v[j].w); }
        const float r = 1.0f / sqrtf(wave_sum(s) * (1.0f / DM) + EPS);
        u32x2* o8 = (u32x2*)(XN + (size_t)m * DM) + lane;
        float d[8];
#pragma unroll
        for (int c = 0; c < 8; ++c) d[c] = 0.f;
#pragma unroll
        for (int j = 0; j < 4; ++j) { const f32x4 g = gr[64 * j]; f32x4 y; y.x = v[j].x * r * g.x; y.y = v[j].y * r * g.y; y.z = v[j].z * r * g.z; y.w = v[j].w * r * g.w;
            u32x2 w; w.x = pk2(y.x, y.y); w.y = pk2(y.z, y.w); o8[64 * j] = w;
#pragma unroll
            for (int e = 0; e < 4; ++e) { const int k = 4 * lane + 256 * j + e; const f32x4 w0 = *(const f32x4*)(W + (size_t)k * 3080 + 3072), w1 = *(const f32x4*)(W + (size_t)k * 3080 + 3076);
                const float ye = y[e]; d[0] += ye * w0.x; d[1] += ye * w0.y; d[2] += ye * w0.z; d[3] += ye * w0.w; d[4] += ye * w1.x; d[5] += ye * w1.y; d[6] += ye * w1.z; d[7] += ye * w1.w; } }
#pragma unroll
        for (int c = 0; c < 8; ++c) d[c] = wave_sum(d[c]);
        if (lane < 4) {
            const float braw = lane == 0 ? d[0] : lane == 1 ? d[1] : lane == 2 ? d[2] : d[3];
            const float araw = lane == 0 ? d[4] : lane == 1 ? d[5] : lane == 2 ? d[6] : d[7];
            const float beta = 1.0f / (1.0f + expf(-braw));
            const float xx = araw + INP(a, I_DNDT)[lane];
            const float sp = xx > 20.f ? xx : log1pf(expf(xx));
            BG[(size_t)m * 8 + lane] = beta; BG[(size_t)m * 8 + 4 + lane] = -expf(INP(a, I_DNALOG)[lane]) * sp;
        }
    }
}
__device__ __forceinline__ void final_norm(const Ctx& C, const bf16* HBin, float* out, const float* gain) {
    for (int m = C.gw; m < NT; m += C.ngw) {
        const u32x2* xr = (const u32x2*)(HBin + (size_t)m * DM) + C.lane; const f32x4* gr = (const f32x4*)gain + C.lane; f32x4* orow = (f32x4*)(out + (size_t)m * DM) + C.lane;
        f32x4 v[4]; float s = 0.f;
#pragma unroll
        for (int j = 0; j < 4; ++j) { const u32x2 w_ = xr[64 * j]; v[j].x = lo16(w_.x); v[j].y = hi16(w_.x); v[j].z = lo16(w_.y); v[j].w = hi16(w_.y); s += (v[j].x * v[j].x + v[j].y * v[j].y) + (v[j].z * v[j].z + v[j].w * v[j].w); }
        const float r = 1.0f / sqrtf(wave_sum(s) * (1.0f / DM) + EPS);
#pragma unroll
        for (int j = 0; j < 4; ++j) { const f32x4 g = gr[64 * j]; f32x4 y; y.x = v[j].x * r * g.x; y.y = v[j].y * r * g.y; y.z = v[j].z * r * g.z; y.w = v[j].w * r * g.w; orow[64 * j] = y; }
    }
}
__device__ __forceinline__ void kmean_pooled(const Ctx& C, const bf16* PROJ, float* KMEAN) {
    const int lane = C.lane, d4 = lane & 15, rq = lane >> 4;
    for (int it = C.gw; it < 2 * 8 * 32; it += C.ngw) {
        const int blk = it & 31, h = (it >> 5) & 7, b = it >> 8;
        const bf16* p = PROJ + (size_t)(b * SEQ + blk * 256 + rq * 64) * 1536 + 512 + h * 64 + 4 * d4; float s0 = 0.f, s1 = 0.f, s2 = 0.f, s3 = 0.f;
#pragma unroll 8
        for (int r = 0; r < 64; ++r) { const u32x2 w = *(const u32x2*)(p + (size_t)r * 1536); s0 += lo16(w.x); s1 += hi16(w.x); s2 += lo16(w.y); s3 += hi16(w.y); }
        s0 += __shfl_xor(s0, 16); s1 += __shfl_xor(s1, 16); s2 += __shfl_xor(s2, 16); s3 += __shfl_xor(s3, 16);
        s0 += __shfl_xor(s0, 32); s1 += __shfl_xor(s1, 32); s2 += __shfl_xor(s2, 32); s3 += __shfl_xor(s3, 32);
        if (rq == 0) { f32x4 o; o.x = s0 * (1.0f / 256.0f); o.y = s1 * (1.0f / 256.0f); o.z = s2 * (1.0f / 256.0f); o.w = s3 * (1.0f / 256.0f); *(f32x4*)(KMEAN + (size_t)it * 64 + 4 * d4) = o; }
    }
}
__device__ __forceinline__ void unpack8(const u32x4 w, float* f) { f[0] = lo16(w.x); f[1] = hi16(w.x); f[2] = lo16(w.y); f[3] = hi16(w.y); f[4] = lo16(w.z); f[5] = hi16(w.z); f[6] = lo16(w.w); f[7] = hi16(w.w); }
__device__ __forceinline__ void moba_naive(const Ctx& C, const bf16* PROJ, const float* KMEAN, bf16* MIX) {
    for (int idx = C.gtid; idx < 2 * 8 * SEQ; idx += C.nthr) {
        const int t = idx & (SEQ - 1), bh = idx >> 13, h = bh & 7, b = bh >> 3, row = b * SEQ + t, qb = t >> 8;
        float q[64];
        { const u32x4* qp = (const u32x4*)(PROJ + (size_t)row * 2048 + h * 64);
#pragma unroll
          for (int i = 0; i < 8; ++i) unpack8(qp[i], q + 8 * i); }
        float b0 = -INFINITY, b1 = -INFINITY, b2 = -INFINITY; int i0 = -1, i1 = -1, i2 = -1;
        const float* km = KMEAN + (size_t)bh * 32 * 64;
        for (int j = 0; j < qb; ++j) { float s = 0.f;
#pragma unroll
            for (int d = 0; d < 64; ++d) s += q[d] * km[j * 64 + d];
            if (s > b0) { b2 = b1; i2 = i1; b1 = b0; i1 = i0; b0 = s; i0 = j; } else if (s > b1) { b2 = b1; i2 = i1; b1 = s; i1 = j; } else if (s > b2) { b2 = s; i2 = j; } }
        float m = -INFINITY, l = 0.f, o[64];
#pragma unroll
        for (int d = 0; d < 64; ++d) o[d] = 0.f;
        for (int si = 0; si < 4; ++si) {
            const int blk = si == 0 ? i0 : si == 1 ? i1 : si == 2 ? i2 : qb;
            if (blk < 0) continue;
            const int nk = (si == 3) ? (t - qb * 256 + 1) : 256;
            const bf16* kp = PROJ + (size_t)(b * SEQ + blk * 256) * 2048 + 512 + h * 64;
            for (int kk = 0; kk < nk; ++kk) {
                const u32x4* kr = (const u32x4*)(kp + (size_t)kk * 2048); const u32x4* vr = (const u32x4*)(kp + (size_t)kk * 2048 + 512);
                float s = 0.f;
#pragma unroll
                for (int i = 0; i < 8; ++i) { float f[8]; unpack8(kr[i], f);
#pragma unroll
                    for (int e = 0; e < 8; ++e) s += q[8 * i + e] * f[e]; }
                s *= 0.125f;
                const float mn = fmaxf(m, s), corr = __expf(m - mn), p = __expf(s - mn);
                l = l * corr + p; m = mn;
#pragma unroll
                for (int i = 0; i < 8; ++i) { float f[8]; unpack8(vr[i], f);
#pragma unroll
                    for (int e = 0; e < 8; ++e) o[8 * i + e] = o[8 * i + e] * corr + p * f[e]; }
            }
        }
        const float il = 1.0f / l; u32x4* op = (u32x4*)(MIX + (size_t)row * 1024 + h * 64);
#pragma unroll
        for (int i = 0; i < 8; ++i) { u32x4 w; w.x = pk2(o[8 * i] * il, o[8 * i + 1] * il); w.y = pk2(o[8 * i + 2] * il, o[8 * i + 3] * il); w.z = pk2(o[8 * i + 4] * il, o[8 * i + 5] * il); w.w = pk2(o[8 * i + 6] * il, o[8 * i + 7] * il); op[i] = w; }
    }
}
__device__ __forceinline__ void pool_linear_naive(const Ctx& C, const bf16* POOLED, const float* pool_w, const float* pool_scale, bf16* MIX) {
    for (size_t idx = C.gtid; idx < (size_t)NT * 512; idx += C.nthr) {
        const int co = (int)(idx & 511), row = (int)(idx >> 9), g = co >> 7, d = co & 127;
        const bf16* pp = POOLED + (size_t)row * 512 + g * 128; const float* w = pool_w + (size_t)g * 128 * 128 + d; float s = 0.f;
        for (int c = 0; c < 128; ++c) s += bf2f(pp[c]) * w[(size_t)c * 128];
        MIX[(size_t)row * 1024 + 512 + co] = (bf16)f2bf(s * pool_scale[co]);
    }
}
__device__ __forceinline__ void xattn_naive(const Ctx& C, const bf16* QX, const bf16* KVX, bf16* OX) {
    LAS float* qs = (LAS float*)(C.lds + C.wave * 2048); LAS float* ps = qs + 256; const int lane = C.lane;
    for (int it = C.gw; it < NT * 4; it += C.ngw) {
        const int row = it >> 2, hd = it & 3, b = row >> 13;
        { const u32x2 w = *((const u32x2*)(QX + (size_t)row * 1024 + hd * 256) + lane); qs[4 * lane] = lo16(w.x); qs[4 * lane + 1] = hi16(w.x); qs[4 * lane + 2] = lo16(w.y); qs[4 * lane + 3] = hi16(w.y); }
        LDS_WAIT();
        float s[4];
#pragma unroll
        for (int i = 0; i < 4; ++i) { const int j = lane + 64 * i; const u32x4* kr = (const u32x4*)(KVX + (size_t)(b * NMEM + j) * 2048 + hd * 256); float acc = 0.f;
            for (int d8 = 0; d8 < 32; ++d8) { float f[8]; unpack8(kr[d8], f); const f32x4 qa = *(const LAS f32x4*)(qs + 8 * d8), qb = *(const LAS f32x4*)(qs + 8 * d8 + 4);
                acc += f[0] * qa.x + f[1] * qa.y + f[2] * qa.z + f[3] * qa.w + f[4] * qb.x + f[5] * qb.y + f[6] * qb.z + f[7] * qb.w; }
            s[i] = acc * 0.0625f; }
        const float mx = wave_max(fmaxf(fmaxf(s[0], s[1]), fmaxf(s[2], s[3])));
        float p[4], sum = 0.f;
#pragma unroll
        for (int i = 0; i < 4; ++i) { p[i] = __expf(s[i] - mx); sum += p[i]; }
        sum = wave_sum(sum); const float inv = 1.0f / sum;
#pragma unroll
        for (int i = 0; i < 4; ++i) ps[lane + 64 * i] = p[i] * inv;
        LDS_WAIT();
        float o0 = 0.f, o1 = 0.f, o2 = 0.f, o3 = 0.f; const bf16* vb = KVX + (size_t)(b * NMEM) * 2048 + 1024 + hd * 256 + 4 * lane;
        for (int j = 0; j < 256; ++j) { const float pj = ps[j]; const u32x2 w = *(const u32x2*)(vb + (size_t)j * 2048); o0 += pj * lo16(w.x); o1 += pj * hi16(w.x); o2 += pj * lo16(w.y); o3 += pj * hi16(w.y); }
        u32x2 w; w.x = pk2(o0, o1); w.y = pk2(o2, o3); *((u32x2*)(OX + (size_t)row * 1024 + hd * 256) + lane) = w;
        LDS_WAIT();
    }
}
__device__ __forceinline__ void ffn_act(const Ctx& C, const bf16* HUP, const float* cw, bf16* ACT, int hb) {
    for (int idx = C.gtid; idx < (SEQ / 8) * 352; idx += C.nthr) {
        const int c8 = idx % 352, rb = idx / 352, c = c8 * 8, t0 = rb * 8;
        float wg[3][8], wu[3][8];
#pragma unroll
        for (int k = 0; k < 3; ++k) { const f32x4 a0 = *(const f32x4*)(cw + (size_t)k * DFF2 + c), a1 = *(const f32x4*)(cw + (size_t)k * DFF2 + c + 4), b0 = *(const f32x4*)(cw + (size_t)k * DFF2 + DFF + c), b1 = *(const f32x4*)(cw + (size_t)k * DFF2 + DFF + c + 4);
            wg[k][0] = a0.x; wg[k][1] = a0.y; wg[k][2] = a0.z; wg[k][3] = a0.w; wg[k][4] = a1.x; wg[k][5] = a1.y; wg[k][6] = a1.z; wg[k][7] = a1.w;
            wu[k][0] = b0.x; wu[k][1] = b0.y; wu[k][2] = b0.z; wu[k][3] = b0.w; wu[k][4] = b1.x; wu[k][5] = b1.y; wu[k][6] = b1.z; wu[k][7] = b1.w; }
        float g0[8], g1[8], u0[8], u1[8];
        if (t0 >= 2) { unpack8(*(const u32x4*)(HUP + (size_t)(t0 - 2) * DFF2 + c), g0); unpack8(*(const u32x4*)(HUP + (size_t)(t0 - 2) * DFF2 + DFF + c), u0);
                       unpack8(*(const u32x4*)(HUP + (size_t)(t0 - 1) * DFF2 + c), g1); unpack8(*(const u32x4*)(HUP + (size_t)(t0 - 1) * DFF2 + DFF + c), u1); }
        else {
#pragma unroll
            for (int e = 0; e < 8; ++e) { g0[e] = 0.f; g1[e] = 0.f; u0[e] = 0.f; u1[e] = 0.f; } }
#pragma unroll
        for (int r = 0; r < 8; ++r) {
            float g2[8], u2[8]; unpack8(*(const u32x4*)(HUP + (size_t)(t0 + r) * DFF2 + c), g2); unpack8(*(const u32x4*)(HUP + (size_t)(t0 + r) * DFF2 + DFF + c), u2);
            float o[8];
#pragma unroll
            for (int e = 0; e < 8; ++e) { const float gv = wg[0][e] * g0[e] + wg[1][e] * g1[e] + wg[2][e] * g2[e], uv = wu[0][e] * u0[e] + wu[1][e] * u1[e] + wu[2][e] * u2[e]; o[e] = silu_f(gv) * uv; }
            u32x4 w; w.x = pk2(o[0], o[1]); w.y = pk2(o[2], o[3]); w.z = pk2(o[4], o[5]); w.w = pk2(o[6], o[7]);
            *(u32x4*)(ACT + (size_t)(hb * SEQ + t0 + r) * DFF + c) = w;
#pragma unroll
            for (int e = 0; e < 8; ++e) { g0[e] = g1[e]; g1[e] = g2[e]; u0[e] = u1[e]; u1[e] = u2[e]; }
        }
    }
}
__device__ __forceinline__ void l1_prep_naive(const Ctx& C, ArgsP a, const bf16* Z, const bf16* QKV, bf16* VN, bf16* QN, bf16* KN, bf16* VV) {
    const int lane = C.lane;
    const float* lng = INP(a, I_SGUG); const float* lnb = INP(a, I_SGUB); const float* cw = INP(a, I_DNCONV);
    for (int row = C.gw; row < NT; row += C.ngw) {
        float f[8]; unpack8(*((const u32x4*)(Z + (size_t)row * 1024 + 512) + lane), f);
        float s = 0.f;
#pragma unroll
        for (int e = 0; e < 8; ++e) s += f[e];
        const float mu = wave_sum(s) * (1.0f / 512.0f); float q = 0.f;
#pragma unroll
        for (int e = 0; e < 8; ++e) { f[e] -= mu; q += f[e] * f[e]; }
        const float rstd = 1.0f / sqrtf(wave_sum(q) * (1.0f / 512.0f) + EPS);
        const f32x4 g0 = *((const f32x4*)lng + 2 * lane), g1 = *((const f32x4*)lng + 2 * lane + 1), c0 = *((const f32x4*)lnb + 2 * lane), c1 = *((const f32x4*)lnb + 2 * lane + 1);
        u32x4 w; w.x = pk2(f[0] * rstd * g0.x + c0.x, f[1] * rstd * g0.y + c0.y); w.y = pk2(f[2] * rstd * g0.z + c0.z, f[3] * rstd * g0.w + c0.w);
        w.z = pk2(f[4] * rstd * g1.x + c1.x, f[5] * rstd * g1.y + c1.y); w.w = pk2(f[6] * rstd * g1.z + c1.z, f[7] * rstd * g1.w + c1.w);
        { bf16* vt = VN + ((size_t)(row >> 7) * 512 + 8 * lane) * 128 + (row & 127);
          vt[0] = (bf16)(w.x & 0xffffu); vt[128] = (bf16)(w.x >> 16); vt[256] = (bf16)(w.y & 0xffffu); vt[384] = (bf16)(w.y >> 16);
          vt[512] = (bf16)(w.z & 0xffffu); vt[640] = (bf16)(w.z >> 16); vt[768] = (bf16)(w.w & 0xffffu); vt[896] = (bf16)(w.w >> 16); }
    }
    for (int it = C.gw; it < NT * 4; it += C.ngw) {
        const int row = it >> 2, hh = it & 3, tl = row & (SEQ - 1), c = hh * 128 + 2 * lane;
        float y[3][2];
#pragma unroll
        for (int s3 = 0; s3 < 3; ++s3) { const int cs = s3 * 512 + c; float a0 = 0.f, a1 = 0.f;
#pragma unroll
            for (int j = 0; j < 4; ++j) { const int ts = tl - 3 + j; if (ts < 0) continue;
                const unsigned w = *(const unsigned*)(QKV + (size_t)(row - 3 + j) * 1536 + cs); a0 += cw[j * 1536 + cs] * lo16(w); a1 += cw[j * 1536 + cs + 1] * hi16(w); }
            y[s3][0] = silu_f(a0); y[s3][1] = silu_f(a1); }
        const float rq = 1.0f / sqrtf(wave_sum(y[0][0] * y[0][0] + y[0][1] * y[0][1]) + EPS) * 0.08838834764831845f;
        const float rk = 1.0f / sqrtf(wave_sum(y[1][0] * y[1][0] + y[1][1] * y[1][1]) + EPS);
        *(unsigned*)(QN + (size_t)row * 512 + c) = pk2(y[0][0] * rq, y[0][1] * rq);
        *(unsigned*)(KN + (size_t)row * 512 + c) = pk2(y[1][0] * rk, y[1][1] * rk);
        *(unsigned*)(VV + (size_t)row * 512 + c) = pk2(y[2][0], y[2][1]);
    }
}
__device__ __forceinline__ void sgu_naive(const Ctx& C, ArgsP a, const bf16* Z, const bf16* VN, bf16* MIX, int blk0, int nblk) {
    const float* sw = INP(a, I_SGUW); const float* sb = INP(a, I_SGUBS);
    const size_t start = (size_t)(blockIdx.x - blk0) * 512 + C.tid, stride = (size_t)nblk * 512;
    for (size_t idx = start; idx < (size_t)NT * 512; idx += stride) {
        const int ch = (int)(idx & 511), row = (int)(idx >> 9), g = ch >> 7, tl = row & 127, r0 = row & ~127;
        const float* w = sw + (size_t)(g * 128 + tl) * 128; const bf16* vp = VN + (size_t)r0 * 512 + ch; float s = 0.f;
        for (int k = 0; k <= tl; ++k) s += w[k] * bf2f(vp[(size_t)k * 512]);
        s += sb[g * 128 + tl];
        MIX[(size_t)row * 1024 + ch] = (bf16)f2bf(bf2f(Z[(size_t)row * 1024 + ch]) * s);
    }
}
__device__ __forceinline__ void dn_recurrent(const Ctx& C, const bf16* QN, const bf16* KN, const bf16* VV, const float* BG, float* O, int bh) {
    const int b = bh >> 2, hh = bh & 3, dv = C.tid & 127, g4 = C.tid >> 7;
    LAS float* red1 = (LAS float*)C.lds; LAS float* red2 = red1 + 512;
    float S[32];
#pragma unroll
    for (int i = 0; i < 32; ++i) S[i] = 0.f;
    for (int t = 0; t < SEQ; ++t) {
        const size_t row = (size_t)b * SEQ + t;
        const u32x4* kp = (const u32x4*)(KN + row * 512 + hh * 128 + 32 * g4); const u32x4* qp = (const u32x4*)(QN + row * 512 + hh * 128 + 32 * g4);
        float kk[32], qq[32];
#pragma unroll
        for (int i = 0; i < 4; ++i) { unpack8(kp[i], kk + 8 * i); unpack8(qp[i], qq + 8 * i); }
        const float vv = bf2f(VV[row * 512 + hh * 128 + dv]), beta = BG[row * 8 + hh], av = __expf(BG[row * 8 + 4 + hh]);
        float part = 0.f;
#pragma unroll
        for (int i = 0; i < 32; ++i) part += kk[i] * S[i];
        red1[g4 * 128 + dv] = part; __syncthreads();
        const float kS = (red1[dv] + red1[128 + dv]) + (red1[256 + dv] + red1[384 + dv]);
        const float vnew = beta * (vv - av * kS);
        float op = 0.f;
#pragma unroll
        for (int i = 0; i < 32; ++i) { S[i] = av * S[i] + kk[i] * vnew; op += qq[i] * S[i]; }
        red2[g4 * 128 + dv] = op; __syncthreads();
        if (g4 == 0) O[row * 512 + hh * 128 + dv] = (red2[dv] + red2[128 + dv]) + (red2[256 + dv] + red2[384 + dv]);
    }
    __syncthreads();
}
__device__ __forceinline__ void dn_out_gate(const Ctx& C, ArgsP a, const float* O, const bf16* GATE, bf16* MIX) {
    const float* ng = INP(a, I_DNNG); const int lane = C.lane;
    const f32x4 n0 = *(const f32x4*)(ng + ((8 * lane) & 127)), n1 = *(const f32x4*)(ng + ((8 * lane) & 127) + 4);
    for (int row = C.gw; row < NT; row += C.ngw) {
        const f32x4 o0 = *((const f32x4*)(O + (size_t)row * 512) + 2 * lane), o1 = *((const f32x4*)(O + (size_t)row * 512) + 2 * lane + 1);
        float ss = ((o0.x * o0.x + o0.y * o0.y) + (o0.z * o0.z + o0.w * o0.w)) + ((o1.x * o1.x + o1.y * o1.y) + (o1.z * o1.z + o1.w * o1.w));
        ss += __shfl_xor(ss, 1); ss += __shfl_xor(ss, 2); ss += __shfl_xor(ss, 4); ss += __shfl_xor(ss, 8);
        const float r = 1.0f / sqrtf(ss * (1.0f / 128.0f) + EPS);
        float g[8]; unpack8(*((const u32x4*)(GATE + (size_t)row * 512) + lane), g);
        u32x4 w; w.x = pk2(o0.x * r * n0.x * silu_f(g[0]), o0.y * r * n0.y * silu_f(g[1])); w.y = pk2(o0.z * r * n0.z * silu_f(g[2]), o0.w * r * n0.w * silu_f(g[3]));
        w.z = pk2(o1.x * r * n1.x * silu_f(g[4]), o1.y * r * n1.y * silu_f(g[5])); w.w = pk2(o1.z * r * n1.z * silu_f(g[6]), o1.w * r * n1.w * silu_f(g[7]));
        *((u32x4*)(MIX + (size_t)row * 1024 + 512) + lane) = w;
    }
}
typedef short bf16x8 __attribute__((ext_vector_type(8)));
#define MFMA16(a, b, c) __builtin_amdgcn_mfma_f32_16x16x32_bf16((a), (b), (c), 0, 0, 0)
__device__ __forceinline__ float rdlane(float v, int i) { return __uint_as_float(__builtin_amdgcn_readlane(__float_as_uint(v), i)); }
#define WG_BAR() do { asm volatile("s_waitcnt vmcnt(0) lgkmcnt(0)" ::: "memory"); __builtin_amdgcn_s_barrier(); asm volatile("" ::: "memory"); } while (0)
#define LDS_BAR() do { asm volatile("s_waitcnt lgkmcnt(0)" ::: "memory"); __builtin_amdgcn_s_barrier(); asm volatile("" ::: "memory"); } while (0)

#define FRAG_W(i, k)  (((((i) >> 4) * 4 + ((k) >> 5)) * 64 + (((k) >> 3) & 3) * 16 + ((i) & 15)) * 8 + ((k) & 7))
#define FRAG_QK(i, j) (((((i) >> 4) * 2 + ((j) >> 5)) * 64 + (((j) >> 3) & 3) * 16 + ((i) & 15)) * 8 + ((j) & 7))
#define FRAG_KD(d, t) ((((((d) >> 5) * 2 + (((d) >> 4) & 1)) * 2 + ((t) >> 5)) * 64 + (((t) >> 3) & 3) * 16 + ((d) & 15)) * 8 + ((t) & 7))
#define FRAG_U(i, v)  (((((v) >> 4) * 4 + ((i) >> 4)) * 64 + (((i) >> 2) & 3) * 16 + ((v) & 15)) * 4 + ((i) & 3))
__device__ __forceinline__ void dn_chunk_prep(const Ctx& C, const bf16* QN, const bf16* KN, const bf16* VV, const float* BG, bf16* U, bf16* Wm, bf16* QD, bf16* KDT, bf16* QKm, float* GL) {
    LAS float* Am = (LAS float*)(C.lds + C.wave * 16384);
    const int lane = C.lane, fr = lane & 15, fq = lane >> 4;
    for (int it4 = C.gw; it4 < 4096; it4 += C.ngw) {
        const int it = it4 >> 2, ps = it4 & 3;
        const int n = it & 127, hh = (it >> 7) & 3, b = it >> 9;
        const size_t row0 = (size_t)b * SEQ + (size_t)n * 64;
        const float beta = BG[(row0 + lane) * 8 + hh], gg = BG[(row0 + lane) * 8 + 4 + hh];
        float gc = gg;
#pragma unroll
        for (int o = 1; o < 64; o <<= 1) { const float t = __shfl_up(gc, o); if (lane >= o) gc += t; }
        const float gcl = rdlane(gc, 63);
        const bf16* Kb = KN + row0 * 512 + hh * 128; const bf16* Qb = QN + row0 * 512 + hh * 128; const bf16* Vb = VV + row0 * 512 + hh * 128;
        bf16* qkm = QKm + (size_t)it * 4096;
#pragma unroll 1
        for (int mt = 0; mt < 4; ++mt) {
            bf16x8 ak[4], aq[4];
#pragma unroll
            for (int ks = 0; ks < 4; ++ks) { ak[ks] = *(const bf16x8*)(Kb + (size_t)(16 * mt + fr) * 512 + 32 * ks + 8 * fq); aq[ks] = *(const bf16x8*)(Qb + (size_t)(16 * mt + fr) * 512 + 32 * ks + 8 * fq); }
#pragma unroll 1
            for (int nt = 0; nt < 4; ++nt) {
                const int j = 16 * nt + fr;
                if (nt > mt) {
                    if (ps == 0) {
#pragma unroll
                        for (int r = 0; r < 4; ++r) qkm[FRAG_QK(16 * mt + 4 * fq + r, j)] = 0; }
                    continue;
                }
                f32x4 ckk = {0.f, 0.f, 0.f, 0.f}, cqk = {0.f, 0.f, 0.f, 0.f};
#pragma unroll
                for (int ks = 0; ks < 4; ++ks) { const bf16x8 bk = *(const bf16x8*)(Kb + (size_t)(16 * nt + fr) * 512 + 32 * ks + 8 * fq); ckk = MFMA16(ak[ks], bk, ckk); cqk = MFMA16(aq[ks], bk, cqk); }
                const float gj = __shfl(gc, j);
#pragma unroll
                for (int r = 0; r < 4; ++r) { const int i = 16 * mt + 4 * fq + r; const float gi = __shfl(gc, i), bi = __shfl(beta, i);
                    const float dec = (i >= j) ? __expf(gi - gj) : 0.f;
                    Am[i * 64 + j] = (i > j) ? bi * ckk[r] * dec : 0.f;
                    if (ps == 0) qkm[FRAG_QK(i, j)] = (bf16)f2bf((i >= j) ? cqk[r] * dec : 0.f); }
            }
        }
        LDS_WAIT();
        { const int p = ps;
            const int c = lane + 64 * (p & 1); const bf16* src = (p < 2 ? Vb : Kb) + c; bf16* dstb = (p < 2 ? U : Wm) + (size_t)it * 8192;
            float x[64];
#pragma unroll
            for (int i = 0; i < 64; ++i) { const float bi = rdlane(beta, i), gi = rdlane(gc, i); x[i] = bf2f(src[(size_t)i * 512]) * (p < 2 ? bi : bi * __expf(gi)); if ((i & 7) == 7) __builtin_amdgcn_sched_barrier(0); }
#pragma unroll
            for (int i = 1; i < 64; ++i) {
                float acc = x[i];
#pragma unroll
                for (int j4 = 0; j4 < (i + 3) / 4; ++j4) { const f32x4 av = *(const LAS f32x4*)(Am + i * 64 + 4 * j4);
                    if (4 * j4 + 0 < i) acc -= av.x * x[4 * j4 + 0];
                    if (4 * j4 + 1 < i) acc -= av.y * x[4 * j4 + 1];
                    if (4 * j4 + 2 < i) acc -= av.z * x[4 * j4 + 2];
                    if (4 * j4 + 3 < i) acc -= av.w * x[4 * j4 + 3]; }
                x[i] = acc;
                if ((i & 3) == 3) asm volatile("" ::: "memory");
            }
#pragma unroll
            for (int i = 0; i < 64; ++i) dstb[p < 2 ? FRAG_U(i, c) : FRAG_W(i, c)] = (bf16)f2bf(x[i]);
        }
        bf16* qd = QD + (size_t)it * 8192;
        if (ps == 1)
#pragma unroll 4
        for (int i = 0; i < 64; ++i) { const float e = __expf(__shfl(gc, i)); const unsigned w = *(const unsigned*)(Qb + (size_t)i * 512 + 2 * lane); *(unsigned*)(qd + FRAG_W(i, 2 * lane)) = pk2(lo16(w) * e, hi16(w) * e); }
        bf16* kdt = KDT + (size_t)it * 8192; const float ek = __expf(gcl - gc);
        if (ps == 2)
#pragma unroll 2
        for (int d8 = 0; d8 < 16; ++d8) { float f[8]; unpack8(*(const u32x4*)(Kb + (size_t)lane * 512 + 8 * d8), f);
#pragma unroll
            for (int e = 0; e < 8; ++e) kdt[FRAG_KD(8 * d8 + e, lane)] = (bf16)f2bf(f[e] * ek); }
        if (ps == 3 && lane == 0) GL[it] = __expf(gcl);
        LDS_WAIT();
    }
}
constexpr int SB_LD = 136, VN_LD = 72;
__device__ __forceinline__ void dn_scan(const Ctx& C, const bf16* U, const bf16* Wm, const bf16* QD, const bf16* KDT, const bf16* QKm, const float* GL, float* O, int it) {
    const int bh = it & 7, sl = it >> 3, hh = bh & 3, b = bh >> 2, dv0 = sl * 16;
    LAS bf16* SbT = (LAS bf16*)C.lds;
    LAS bf16* VnT = (LAS bf16*)(C.lds + 16384);
    LAS float* glb = (LAS float*)(C.lds + 24576);
    for (int i = C.tid; i < 2 * 16 * SB_LD / 2; i += 512) ((LAS unsigned*)SbT)[i] = 0u;
    if (C.tid < 128) glb[C.tid] = GL[(size_t)(it & 7) * 128 + C.tid];
    __syncthreads();
    const int w = C.wave, lane = C.lane, fr = lane & 15, fq = lane >> 4;
    f32x4 S0 = {0.f, 0.f, 0.f, 0.f}, S1 = S0;
    const size_t item0 = (size_t)bh * 128;
    if (w < 4) {
        bf16x8 cw[4][4], ck[4][4]; float cu[4][4];
#define DN_LOAD_A(set, st) do { const size_t it_ = item0 + (st); \
            const bf16* wp_ = Wm + it_ * 8192 + (size_t)(w * 4 * 64 + lane) * 8; const bf16* up_ = U + it_ * 8192 + (size_t)((sl * 4 + w) * 64 + lane) * 4; const bf16* kp_ = KDT + it_ * 8192 + (size_t)(w * 4 * 64 + lane) * 8; \
            _Pragma("unroll") for (int ks = 0; ks < 4; ++ks) cw[set][ks] = *(const bf16x8*)(wp_ + 512 * ks); \
            { const u32x2 uw_ = *(const u32x2*)up_; cu[set][0] = lo16(uw_.x); cu[set][1] = hi16(uw_.x); cu[set][2] = lo16(uw_.y); cu[set][3] = hi16(uw_.y); } \
            ck[set][0] = *(const bf16x8*)(kp_); ck[set][1] = *(const bf16x8*)(kp_ + 512); ck[set][2] = *(const bf16x8*)(kp_ + 1024); ck[set][3] = *(const bf16x8*)(kp_ + 1536); } while (0)
        DN_LOAD_A(0, 0); DN_LOAD_A(1, 1); DN_LOAD_A(2, 2);
        for (int n0 = 0; n0 < 128; n0 += 4) {
#pragma unroll
            for (int k = 0; k < 4; ++k) {
                const int n = n0 + k, ns = (n + 3 < 128) ? n + 3 : 127;
                DN_LOAD_A((k + 3) & 3, ns);
                LAS bf16* Sc = SbT + (k & 1) * 16 * SB_LD; LAS bf16* Sn = SbT + ((k & 1) ^ 1) * 16 * SB_LD;
                f32x4 t1 = {0.f, 0.f, 0.f, 0.f};
                { bf16x8 sb[4];
#pragma unroll
                  for (int ks = 0; ks < 4; ++ks) sb[ks] = *(const LAS bf16x8*)(Sc + fr * SB_LD + 32 * ks + 8 * fq);
                  __builtin_amdgcn_sched_barrier(0);
#pragma unroll
                  for (int ks = 0; ks < 4; ++ks) t1 = MFMA16(cw[k][ks], sb[ks], t1); }
                u32x2 pw; pw.x = pk2(cu[k][0] - t1[0], cu[k][1] - t1[1]); pw.y = pk2(cu[k][2] - t1[2], cu[k][3] - t1[3]);
                *(LAS u32x2*)(VnT + fr * VN_LD + 16 * w + 4 * fq) = pw;
                LDS_BAR();
                bf16x8 vb[2];
                { const float gl = glb[n]; S0 = S0 * gl; S1 = S1 * gl; }
#pragma unroll
                for (int ks = 0; ks < 2; ++ks) vb[ks] = *(const LAS bf16x8*)(VnT + fr * VN_LD + 32 * ks + 8 * fq);
                __builtin_amdgcn_sched_barrier(0);
#pragma unroll
                for (int ks = 0; ks < 2; ++ks) { S0 = MFMA16(ck[k][ks], vb[ks], S0); S1 = MFMA16(ck[k][2 + ks], vb[ks], S1); }
                u32x2 s0; s0.x = pk2(S0[0], S0[1]); s0.y = pk2(S0[2], S0[3]); u32x2 s1; s1.x = pk2(S1[0], S1[1]); s1.y = pk2(S1[2], S1[3]);
                *(LAS u32x2*)(Sn + fr * SB_LD + 32 * w + 4 * fq) = s0; *(LAS u32x2*)(Sn + fr * SB_LD + 32 * w + 16 + 4 * fq) = s1;
                LDS_BAR();
            }
        }
#undef DN_LOAD_A
    } else {
        const int w2 = w - 4;
        bf16x8 cq[4][4], cm[4][2];
#define DN_LOAD_B(set, st) do { const size_t it_ = item0 + (st); const bf16* qp_ = QD + it_ * 8192 + (size_t)(w2 * 4 * 64 + lane) * 8; const bf16* mp_ = QKm + it_ * 4096 + (size_t)(w2 * 2 * 64 + lane) * 8; \
            _Pragma("unroll") for (int ks = 0; ks < 4; ++ks) cq[set][ks] = *(const bf16x8*)(qp_ + 512 * ks); \
            cm[set][0] = *(const bf16x8*)(mp_); cm[set][1] = *(const bf16x8*)(mp_ + 512); } while (0)
        DN_LOAD_B(0, 0); DN_LOAD_B(1, 1); DN_LOAD_B(2, 2);
        for (int n0 = 0; n0 < 128; n0 += 4) {
#pragma unroll
            for (int k = 0; k < 4; ++k) {
                const int n = n0 + k, ns = (n + 3 < 128) ? n + 3 : 127;
                DN_LOAD_B((k + 3) & 3, ns);
                LAS bf16* Sc = SbT + (k & 1) * 16 * SB_LD;
                f32x4 o = {0.f, 0.f, 0.f, 0.f};
                { bf16x8 sb[4];
#pragma unroll
                  for (int ks = 0; ks < 4; ++ks) sb[ks] = *(const LAS bf16x8*)(Sc + fr * SB_LD + 32 * ks + 8 * fq);
                  __builtin_amdgcn_sched_barrier(0);
#pragma unroll
                  for (int ks = 0; ks < 4; ++ks) o = MFMA16(cq[k][ks], sb[ks], o); }
                LDS_BAR();
                o = MFMA16(cm[k][0], *(const LAS bf16x8*)(VnT + fr * VN_LD + 8 * fq), o);
                o = MFMA16(cm[k][1], *(const LAS bf16x8*)(VnT + fr * VN_LD + 32 + 8 * fq), o);
                float* op = O + ((size_t)b * SEQ + (size_t)n * 64 + 16 * w2 + 4 * fq) * 512 + hh * 128 + dv0 + fr;
                op[0] = o[0]; op[512] = o[1]; op[1024] = o[2]; op[1536] = o[3];
                LDS_BAR();
            }
        }
#undef DN_LOAD_B
    }
    __syncthreads();
}
__device__ __forceinline__ int perm32k_inv(int s) { return (s < 16) ? (8 * (s >> 2) + (s & 3)) : (8 * ((s - 16) >> 2) + 4 + (s & 3)); }
__device__ __forceinline__ bf16x8 pack_p(const f32x4 a, const f32x4 b) { u32x4 w; w.x = pk2(a[0], a[1]); w.y = pk2(a[2], a[3]); w.z = pk2(b[0], b[1]); w.w = pk2(b[2], b[3]); return __builtin_bit_cast(bf16x8, w); }

__device__ __forceinline__ void xattn_mfma(const Ctx& C, const bf16* QX, const bf16* KX, const bf16* VXT, bf16* OX) {
    const int lane = C.lane, fr = lane & 15, fq = lane >> 4;
    for (int it = C.gw; it < (NT / 16) * 4; it += C.ngw) {
        const int hd = it & 3, qt = it >> 2, row0 = qt * 16, b = row0 >> 13;
        bf16x8 qf[8];
        const bf16* qp = QX + (size_t)(row0 + fr) * 1024 + hd * 256 + 8 * fq;
#pragma unroll
        for (int ks = 0; ks < 8; ++ks) qf[ks] = *(const bf16x8*)(qp + 32 * ks);
        f32x4 st[16];
        const bf16* kp = KX + (size_t)(b * NMEM + fr) * 1024 + hd * 256 + 8 * fq;
#pragma unroll
        for (int kt = 0; kt < 16; ++kt) { f32x4 acc = {0.f, 0.f, 0.f, 0.f};
#pragma unroll
            for (int ks = 0; ks < 8; ++ks) acc = MFMA16(*(const bf16x8*)(kp + (size_t)kt * 16 * 1024 + 32 * ks), qf[ks], acc);
            st[kt] = acc; }
        float mx = -INFINITY;
#pragma unroll
        for (int kt = 0; kt < 16; ++kt) mx = fmaxf(mx, fmaxf(fmaxf(st[kt][0], st[kt][1]), fmaxf(st[kt][2], st[kt][3])));
        mx = fmaxf(mx, __shfl_xor(mx, 16)); mx = fmaxf(mx, __shfl_xor(mx, 32));
        float sum = 0.f; const float mxs = mx * 0.0625f;
#pragma unroll
        for (int kt = 0; kt < 16; ++kt) {
#pragma unroll
            for (int r = 0; r < 4; ++r) { const float p = __expf(st[kt][r] * 0.0625f - mxs); st[kt][r] = p; sum += p; } }
        sum += __shfl_xor(sum, 16); sum += __shfl_xor(sum, 32);
        const float inv = 1.0f / sum;
        bf16x8 pf[8];
#pragma unroll
        for (int kk = 0; kk < 8; ++kk) pf[kk] = pack_p(st[2 * kk], st[2 * kk + 1]);
        const bf16* vp = VXT + (size_t)(hd * 256 + fr) * 512 + b * NMEM + 8 * fq;
        bf16* op = OX + (size_t)(row0 + fr) * 1024 + hd * 256 + 4 * fq;
#pragma unroll 4
        for (int dt = 0; dt < 16; ++dt) { f32x4 acc = {0.f, 0.f, 0.f, 0.f};
#pragma unroll
            for (int kk = 0; kk < 8; ++kk) acc = MFMA16(*(const bf16x8*)(vp + (size_t)dt * 16 * 512 + 32 * kk), pf[kk], acc);
            u32x2 w; w.x = pk2(acc[0] * inv, acc[1] * inv); w.y = pk2(acc[2] * inv, acc[3] * inv);
            *(u32x2*)(op + 16 * dt) = w; }
    }
}

__device__ __forceinline__ void moba_item(const bf16* PQ, const bf16* VT, const float* KMEAN, bf16* MIX, int bh, int tile, int lane) {
    const int fr = lane & 15, fq = lane >> 4, h = bh & 7, b = bh >> 3, qb = tile >> 3;
    const int row0 = b * SEQ + tile * 32;
    unsigned mask = 0u;
    if (qb > 0) {
        float q[64];
        { const u32x4* qp = (const u32x4*)(PQ + (size_t)(row0 + (lane & 31)) * 1536 + h * 64);
#pragma unroll
          for (int i = 0; i < 8; ++i) unpack8(qp[i], q + 8 * i); }
        float b0 = -INFINITY, b1 = -INFINITY, b2 = -INFINITY; int i0 = -1, i1 = -1, i2 = -1;
        const float* km = KMEAN + (size_t)bh * 32 * 64;
        for (int j = 0; j < qb; ++j) { float s = 0.f;
#pragma unroll
            for (int d = 0; d < 64; ++d) s += q[d] * km[j * 64 + d];
            if (s > b0) { b2 = b1; i2 = i1; b1 = b0; i1 = i0; b0 = s; i0 = j; } else if (s > b1) { b2 = b1; i2 = i1; b1 = s; i1 = j; } else if (s > b2) { b2 = s; i2 = j; } }
        if (i0 >= 0) mask |= 1u << i0; if (i1 >= 0) mask |= 1u << i1; if (i2 >= 0) mask |= 1u << i2;
    }
    const unsigned m0 = (unsigned)__shfl((int)mask, fr), m1 = (unsigned)__shfl((int)mask, 16 + fr);
    bf16x8 qf[2][2];
#pragma unroll
    for (int qt = 0; qt < 2; ++qt)
#pragma unroll
        for (int ks = 0; ks < 2; ++ks) qf[qt][ks] = *(const bf16x8*)(PQ + (size_t)(row0 + 16 * qt + fr) * 1536 + h * 64 + 32 * ks + 8 * fq);
    f32x4 oacc[2][4];
#pragma unroll
    for (int qt = 0; qt < 2; ++qt)
#pragma unroll
        for (int dt = 0; dt < 4; ++dt) oacc[qt][dt] = (f32x4){0.f, 0.f, 0.f, 0.f};
    float mrow[2] = {-INFINITY, -INFINITY}, lrow[2] = {0.f, 0.f};
    const int qoff0 = (tile & 7) * 32;
    for (int bi = 0; bi <= qb; ++bi) {
        const int blk = (bi == 0) ? qb : bi - 1; const bool own = (bi == 0);
        if (!own && !__any((int)(((m0 | m1) >> blk) & 1u))) continue;
        const bool s0 = own || ((m0 >> blk) & 1u), s1 = own || ((m1 >> blk) & 1u);
        for (int hf = 0; hf < 2; ++hf) {
            if (own && hf * 128 > qoff0 + 31) continue;
            const int key0 = b * SEQ + blk * 256 + hf * 128;
            f32x4 st[2][8];
            const bf16* kp = PQ + (size_t)(key0 + fr) * 1536 + 512 + h * 64 + 8 * fq;
#pragma unroll
            for (int kt = 0; kt < 8; ++kt) { const bf16x8 k0 = *(const bf16x8*)(kp + (size_t)kt * 16 * 1536), k1 = *(const bf16x8*)(kp + (size_t)kt * 16 * 1536 + 32);
#pragma unroll
                for (int qt = 0; qt < 2; ++qt) { f32x4 acc = {0.f, 0.f, 0.f, 0.f}; acc = MFMA16(k0, qf[qt][0], acc); acc = MFMA16(k1, qf[qt][1], acc); st[qt][kt] = acc; } }
            bf16x8 pf[2][4];
#pragma unroll
            for (int qt = 0; qt < 2; ++qt) {
                const bool sel = qt == 0 ? s0 : s1; const int qoff = qoff0 + 16 * qt + fr;
                float mx = -INFINITY;
#pragma unroll
                for (int kt = 0; kt < 8; ++kt)
#pragma unroll
                    for (int r = 0; r < 4; ++r) { float s = st[qt][kt][r] * 0.125f; const int kin = hf * 128 + 16 * kt + 4 * fq + r;
                        if (!sel || (own && kin > qoff)) s = -INFINITY; st[qt][kt][r] = s; mx = fmaxf(mx, s); }
                mx = fmaxf(mx, __shfl_xor(mx, 16)); mx = fmaxf(mx, __shfl_xor(mx, 32));
                const float mn = fmaxf(mrow[qt], mx);
                const float corr = __expf(mrow[qt] - mn); mrow[qt] = mn;
                float ps = 0.f;
#pragma unroll
                for (int kt = 0; kt < 8; ++kt)
#pragma unroll
                    for (int r = 0; r < 4; ++r) { const float p = __expf(st[qt][kt][r] - mn); st[qt][kt][r] = p; ps += p; }
                lrow[qt] = lrow[qt] * corr + ps;
#pragma unroll
                for (int dt = 0; dt < 4; ++dt) oacc[qt][dt] = oacc[qt][dt] * corr;
#pragma unroll
                for (int kk = 0; kk < 4; ++kk) pf[qt][kk] = pack_p(st[qt][2 * kk], st[qt][2 * kk + 1]);
            }
            const bf16* vp = VT + (size_t)(h * 64 + fr) * NT + key0 + 8 * fq;
#pragma unroll
            for (int dt = 0; dt < 4; ++dt)
#pragma unroll
                for (int kk = 0; kk < 4; ++kk) { const bf16x8 vf = *(const bf16x8*)(vp + (size_t)dt * 16 * NT + 32 * kk);
                    oacc[0][dt] = MFMA16(vf, pf[0][kk], oacc[0][dt]); oacc[1][dt] = MFMA16(vf, pf[1][kk], oacc[1][dt]); }
        }
    }
#pragma unroll
    for (int qt = 0; qt < 2; ++qt) {
        float l = lrow[qt]; l += __shfl_xor(l, 16); l += __shfl_xor(l, 32); const float inv = 1.0f / l;
        bf16* op = MIX + (size_t)(row0 + 16 * qt + fr) * 1024 + h * 64 + 4 * fq;
#pragma unroll
        for (int dt = 0; dt < 4; ++dt) { u32x2 w; w.x = pk2(oacc[qt][dt][0] * inv, oacc[qt][dt][1] * inv); w.y = pk2(oacc[qt][dt][2] * inv, oacc[qt][dt][3] * inv); *(u32x2*)(op + 16 * dt) = w; }
    }
}
__device__ __forceinline__ void moba_mfma(const Ctx& C, const bf16* PQ, const bf16* VT, const float* KMEAN, bf16* MIX) {
    for (int pi = C.gw; pi < 2048; pi += C.ngw) {
        const int bh = pi >> 7, pp = pi & 127;
        moba_item(PQ, VT, KMEAN, MIX, bh, pp, C.lane);
        moba_item(PQ, VT, KMEAN, MIX, bh, 255 - pp, C.lane);
    }
}
__device__ __forceinline__ void pool_mfma(const Ctx& C, const bf16* PQ, const bf16* PWT, const float* pool_scale, bf16* MIX) {
    const int lane = C.lane, fr = lane & 15, fq = lane >> 4;
    for (int it = C.gw; it < (NT / 16) * 4; it += C.ngw) {
        const int g = it & 3, tt = it >> 2, row = tt * 16 + fr, tl = row & (SEQ - 1), w = 2 << g;
        const int cnt = (tl + 1 < w) ? tl + 1 : w; const float icnt = 1.0f / (float)cnt;
        bf16x8 bfr[4];
#pragma unroll
        for (int ks = 0; ks < 4; ++ks) {
            const bf16* p = PQ + (size_t)row * 1536 + 1024 + g * 128 + 32 * ks + 8 * fq;
            float cur[8], s[8]; unpack8(*(const u32x4*)p, cur);
#pragma unroll
            for (int e = 0; e < 8; ++e) s[e] = cur[e];
            for (int i = 1; i < cnt; ++i) { float f[8]; unpack8(*(const u32x4*)(p - (size_t)i * 1536), f);
#pragma unroll
                for (int e = 0; e < 8; ++e) s[e] += f[e]; }
            u32x4 wv; wv.x = pk2(s[0] * icnt - cur[0], s[1] * icnt - cur[1]); wv.y = pk2(s[2] * icnt - cur[2], s[3] * icnt - cur[3]);
            wv.z = pk2(s[4] * icnt - cur[4], s[5] * icnt - cur[5]); wv.w = pk2(s[6] * icnt - cur[6], s[7] * icnt - cur[7]);
            bfr[ks] = __builtin_bit_cast(bf16x8, wv);
        }
        const bf16* ap = PWT + (size_t)g * 128 * 128 + (size_t)fr * 128 + 8 * fq;
        bf16* op = MIX + (size_t)row * 1024 + 512 + g * 128 + 4 * fq; const float* sp = pool_scale + g * 128 + 4 * fq;
#pragma unroll 2
        for (int dt = 0; dt < 8; ++dt) { f32x4 acc = {0.f, 0.f, 0.f, 0.f};
#pragma unroll
            for (int ks = 0; ks < 4; ++ks) acc = MFMA16(*(const bf16x8*)(ap + (size_t)dt * 16 * 128 + 32 * ks), bfr[ks], acc);
            const f32x4 sc = *(const f32x4*)(sp + 16 * dt);
            u32x2 wv; wv.x = pk2(acc[0] * sc.x, acc[1] * sc.y); wv.y = pk2(acc[2] * sc.z, acc[3] * sc.w); *(u32x2*)(op + 16 * dt) = wv; }
    }
}
__device__ __forceinline__ void sgu_mfma(const Ctx& C, const bf16* Z, const bf16* VNT, const bf16* Wb, const float* sgu_b, bf16* MIX, int gw0, int ngw0) {
    const int lane = C.lane, fr = lane & 15, fq = lane >> 4;
    for (int it = gw0; it < 128 * 4 * 8; it += ngw0) {
        const int tt = it & 7, g = (it >> 3) & 3, n = it >> 5, nks = (tt >> 1) + 1;
        const int row = n * 128 + tt * 16 + fr;
        bf16x8 bfr[4];
#pragma unroll
        for (int ks = 0; ks < 4; ++ks) bfr[ks] = (ks < nks) ? *(const bf16x8*)(Wb + (size_t)(g * 128 + tt * 16 + fr) * 128 + 32 * ks + 8 * fq) : (bf16x8){0, 0, 0, 0, 0, 0, 0, 0};
        const float bias = sgu_b[g * 128 + tt * 16 + fr];
        const bf16* ap = VNT + ((size_t)n * 512 + g * 128 + fr) * 128 + 8 * fq;
        const bf16* up = Z + (size_t)row * 1024 + g * 128 + 4 * fq; bf16* op = MIX + (size_t)row * 1024 + g * 128 + 4 * fq;
#pragma unroll 2
        for (int ct = 0; ct < 8; ++ct) { f32x4 acc = {0.f, 0.f, 0.f, 0.f};
#pragma unroll
            for (int ks = 0; ks < 4; ++ks) if (ks < nks) acc = MFMA16(*(const bf16x8*)(ap + (size_t)ct * 16 * 128 + 32 * ks), bfr[ks], acc);
            const u32x2 uw = *(const u32x2*)(up + 16 * ct);
            u32x2 wv; wv.x = pk2(lo16(uw.x) * (acc[0] + bias), hi16(uw.x) * (acc[1] + bias)); wv.y = pk2(lo16(uw.y) * (acc[2] + bias), hi16(uw.y) * (acc[3] + bias)); *(u32x2*)(op + 16 * ct) = wv; }
    }
}
__device__ __forceinline__ void sgu_w_convert(const Ctx& C, const float* sw, bf16* Wb) {
    for (int idx = C.gtid; idx < 4 * 128 * 128; idx += C.nthr) { const int s = idx & 127, t = (idx >> 7) & 127; Wb[idx] = (bf16)((s <= t) ? f2bf(sw[idx]) : 0u); }
}
constexpr int MK_LD = 72, MV_LD = 136;
constexpr int MK_BYTES = 128 * MK_LD * 2, MV_BYTES = 64 * MV_LD * 2;
__device__ __forceinline__ void moba_wg_block(const Ctx& C, const bf16* PQ, const bf16* VT, const float* KMEAN, bf16* MIX, int bh, int qb) {
    const int lane = C.lane, fr = lane & 15, fq = lane >> 4, h = bh & 7, b = bh >> 3, w = C.wave, tid = C.tid;
    const int tile = qb * 8 + w, row0 = b * SEQ + tile * 32;
    LAS bf16* Kb0 = (LAS bf16*)C.lds; LAS bf16* Vb0 = (LAS bf16*)(C.lds + 2 * MK_BYTES);
    unsigned mask = 0u;
    if (qb > 0) {
        float q[64];
        { const u32x4* qp = (const u32x4*)(PQ + (size_t)(row0 + (lane & 31)) * 1536 + h * 64);
#pragma unroll
          for (int i = 0; i < 8; ++i) unpack8(qp[i], q + 8 * i); }
        float b0 = -INFINITY, b1 = -INFINITY, b2 = -INFINITY; int i0 = -1, i1 = -1, i2 = -1;
        const float* km = KMEAN + (size_t)bh * 32 * 64;
        for (int j = 0; j < qb; ++j) { float s = 0.f;
#pragma unroll
            for (int d = 0; d < 64; ++d) s += q[d] * km[j * 64 + d];
            if (s > b0) { b2 = b1; i2 = i1; b1 = b0; i1 = i0; b0 = s; i0 = j; } else if (s > b1) { b2 = b1; i2 = i1; b1 = s; i1 = j; } else if (s > b2) { b2 = s; i2 = j; } }
        if (i0 >= 0) mask |= 1u << i0; if (i1 >= 0) mask |= 1u << i1; if (i2 >= 0) mask |= 1u << i2;
    }
    const unsigned m0 = (unsigned)__shfl((int)mask, fr), m1 = (unsigned)__shfl((int)mask, 16 + fr);
    bf16x8 qf[2][2];
#pragma unroll
    for (int qt = 0; qt < 2; ++qt)
#pragma unroll
        for (int ks = 0; ks < 2; ++ks) qf[qt][ks] = *(const bf16x8*)(PQ + (size_t)(row0 + 16 * qt + fr) * 1536 + h * 64 + 32 * ks + 8 * fq);
    f32x4 oacc[2][4];
#pragma unroll
    for (int qt = 0; qt < 2; ++qt)
#pragma unroll
        for (int dt = 0; dt < 4; ++dt) oacc[qt][dt] = (f32x4){0.f, 0.f, 0.f, 0.f};
    float mrow[2] = {-INFINITY, -INFINITY}, lrow[2] = {0.f, 0.f};
    const int qoff0 = w * 32;
    const int kr = tid >> 3, kc = tid & 7, vr = tid >> 4, vc = tid & 15;
    const int nh = 2 * (qb + 1);
    u32x4 kq0, kq1, vq0, vq1;
#define MOBA_KEY0(i) (b * SEQ + (((i) < 2) ? qb : (((i) - 2) >> 1)) * 256 + ((i) & 1) * 128)
#define MOBA_GLOAD(i) do { const int k0_ = MOBA_KEY0(i); \
        kq0 = *(const u32x4*)(PQ + (size_t)(k0_ + kr) * 1536 + 512 + h * 64 + 8 * kc); kq1 = *(const u32x4*)(PQ + (size_t)(k0_ + kr + 64) * 1536 + 512 + h * 64 + 8 * kc); \
        vq0 = *(const u32x4*)(VT + (size_t)(h * 64 + vr) * NT + k0_ + 8 * vc); vq1 = *(const u32x4*)(VT + (size_t)(h * 64 + vr + 32) * NT + k0_ + 8 * vc); } while (0)
#define MOBA_LSTORE(buf) do { LAS bf16* kb_ = Kb0 + (buf) * (MK_BYTES / 2); LAS bf16* vb_ = Vb0 + (buf) * (MV_BYTES / 2); \
        *(LAS u32x4*)(kb_ + kr * MK_LD + 8 * kc) = kq0; *(LAS u32x4*)(kb_ + (kr + 64) * MK_LD + 8 * kc) = kq1; \
        *(LAS u32x4*)(vb_ + vr * MV_LD + 8 * vc) = vq0; *(LAS u32x4*)(vb_ + (vr + 32) * MV_LD + 8 * vc) = vq1; } while (0)
    MOBA_GLOAD(0); MOBA_LSTORE(0);
    WG_BAR();
    for (int i = 0; i < nh; ++i) {
        if (i + 1 < nh) MOBA_GLOAD(i + 1);
        const bool own = i < 2; const int blk = own ? qb : ((i - 2) >> 1), hf = i & 1;
        const bool s0 = own || ((m0 >> blk) & 1u), s1 = own || ((m1 >> blk) & 1u);
        const bool need = own ? !(hf * 128 > qoff0 + 31) : (__any((int)(((m0 | m1) >> blk) & 1u)) != 0);
        if (need) {
            const LAS bf16* Kb = Kb0 + (i & 1) * (MK_BYTES / 2); const LAS bf16* Vb = Vb0 + (i & 1) * (MV_BYTES / 2);
            f32x4 st[2][8];
#pragma unroll
            for (int kt = 0; kt < 8; ++kt) { const bf16x8 k0 = *(const LAS bf16x8*)(Kb + (16 * kt + fr) * MK_LD + 8 * fq), k1 = *(const LAS bf16x8*)(Kb + (16 * kt + fr) * MK_LD + 32 + 8 * fq);
#pragma unroll
                for (int qt = 0; qt < 2; ++qt) { f32x4 acc = {0.f, 0.f, 0.f, 0.f}; acc = MFMA16(k0, qf[qt][0], acc); acc = MFMA16(k1, qf[qt][1], acc); st[qt][kt] = acc; } }
            bf16x8 pf[2][4];
            constexpr float SC2 = 0.125f * 1.4426950408889634f;
#pragma unroll
            for (int qt = 0; qt < 2; ++qt) {
                const bool sel = qt == 0 ? s0 : s1; const int qoff = qoff0 + 16 * qt + fr;
                float mx = -INFINITY;
                if (own) {
#pragma unroll
                    for (int kt = 0; kt < 8; ++kt)
#pragma unroll
                        for (int r = 0; r < 4; ++r) { const int kin = hf * 128 + 16 * kt + 4 * fq + r; if (kin > qoff) st[qt][kt][r] = -INFINITY; }
                }
#pragma unroll
                for (int kt = 0; kt < 8; ++kt) mx = fmaxf(mx, fmaxf(fmaxf(st[qt][kt][0], st[qt][kt][1]), fmaxf(st[qt][kt][2], st[qt][kt][3])));
                mx *= SC2;
                if (!sel) mx = -INFINITY;
                mx = fmaxf(mx, __shfl_xor(mx, 16)); mx = fmaxf(mx, __shfl_xor(mx, 32));
                const float mn = fmaxf(mrow[qt], mx);
                const float corr = __builtin_amdgcn_exp2f(mrow[qt] - mn); mrow[qt] = mn;
                float ps = 0.f;
#pragma unroll
                for (int kt = 0; kt < 8; ++kt)
#pragma unroll
                    for (int r = 0; r < 4; ++r) { const float p = __builtin_amdgcn_exp2f(__builtin_fmaf(st[qt][kt][r], SC2, -mn)); st[qt][kt][r] = p; ps += p; }
                if (!sel) ps = 0.f;
                lrow[qt] = lrow[qt] * corr + ps;
#pragma unroll
                for (int dt = 0; dt < 4; ++dt) oacc[qt][dt] = oacc[qt][dt] * corr;
#pragma unroll
                for (int kk = 0; kk < 4; ++kk) { bf16x8 pv = pack_p(st[qt][2 * kk], st[qt][2 * kk + 1]); if (!sel) pv = (bf16x8){0, 0, 0, 0, 0, 0, 0, 0}; pf[qt][kk] = pv; }
            }
#pragma unroll
            for (int dt = 0; dt < 4; ++dt)
#pragma unroll
                for (int kk = 0; kk < 4; ++kk) { const bf16x8 vf = *(const LAS bf16x8*)(Vb + (16 * dt + fr) * MV_LD + 32 * kk + 8 * fq);
                    oacc[0][dt] = MFMA16(vf, pf[0][kk], oacc[0][dt]); oacc[1][dt] = MFMA16(vf, pf[1][kk], oacc[1][dt]); }
        }
        if (i + 1 < nh) MOBA_LSTORE((i + 1) & 1);
        WG_BAR();
    }
#undef MOBA_KEY0
#undef MOBA_GLOAD
#undef MOBA_LSTORE
#pragma unroll
    for (int qt = 0; qt < 2; ++qt) {
        float l = lrow[qt]; l += __shfl_xor(l, 16); l += __shfl_xor(l, 32); const float inv = 1.0f / l;
        bf16* op = MIX + (size_t)(row0 + 16 * qt + fr) * 1024 + h * 64 + 4 * fq;
#pragma unroll
        for (int dt = 0; dt < 4; ++dt) { u32x2 wv; wv.x = pk2(oacc[qt][dt][0] * inv, oacc[qt][dt][1] * inv); wv.y = pk2(oacc[qt][dt][2] * inv, oacc[qt][dt][3] * inv); *(u32x2*)(op + 16 * dt) = wv; }
    }
}
__device__ __forceinline__ void moba_wg(const Ctx& C, const bf16* PQ, const bf16* VT, const float* KMEAN, bf16* MIX) {
    for (int it = blockIdx.x; it < 256; it += C.G) {
        const int bh = it & 15, pp = it >> 4;
        moba_wg_block(C, PQ, VT, KMEAN, MIX, bh, 31 - pp);
        moba_wg_block(C, PQ, VT, KMEAN, MIX, bh, pp);
    }
}
constexpr int XK_LD = 264, XV_LD = 136;
constexpr int XK_BYTES = 128 * XK_LD * 2, XV_BYTES = 256 * XV_LD * 2;
static_assert(XK_BYTES + XV_BYTES <= LDS_BYTES - 256, "xattn LDS");
__device__ __forceinline__ void xattn_wg(const Ctx& C, const bf16* QX, const bf16* KX, const bf16* VXT, bf16* OX) {
    const int lane = C.lane, fr = lane & 15, fq = lane >> 4, w = C.wave, tid = C.tid;
    LAS bf16* Kb = (LAS bf16*)C.lds; LAS bf16* Vb = (LAS bf16*)(C.lds + XK_BYTES);
    constexpr float SC2 = 0.0625f * 1.4426950408889634f;
    for (int it = blockIdx.x; it < 512; it += C.G) {
        const int hd = it & 3, bq = it >> 2, row0 = bq * 128 + w * 16, b = bq >> 6;
        bf16x8 qf[8];
        { const bf16* qp = QX + (size_t)(row0 + fr) * 1024 + hd * 256 + 8 * fq;
#pragma unroll
          for (int ks = 0; ks < 8; ++ks) qf[ks] = *(const bf16x8*)(qp + 32 * ks); }
        f32x4 oacc[16];
#pragma unroll
        for (int dt = 0; dt < 16; ++dt) oacc[dt] = (f32x4){0.f, 0.f, 0.f, 0.f};
        float mrow = -INFINITY, lrow = 0.f;
        for (int hf = 0; hf < 2; ++hf) {
            WG_BAR();
#pragma unroll
            for (int i = 0; i < 8; ++i) { const int id = tid + 512 * i;
                { const int r = id >> 5, c = id & 31; *(LAS u32x4*)(Kb + r * XK_LD + 8 * c) = *(const u32x4*)(KX + (size_t)(b * NMEM + 128 * hf + r) * 1024 + hd * 256 + 8 * c); }
                { const int r = id >> 4, c = id & 15; *(LAS u32x4*)(Vb + r * XV_LD + 8 * c) = *(const u32x4*)(VXT + (size_t)(hd * 256 + r) * 512 + b * NMEM + 128 * hf + 8 * c); } }
            WG_BAR();
            f32x4 st[8];
#pragma unroll
            for (int kt = 0; kt < 8; ++kt) { f32x4 acc = {0.f, 0.f, 0.f, 0.f};
#pragma unroll
                for (int ks = 0; ks < 8; ++ks) acc = MFMA16(*(const LAS bf16x8*)(Kb + (16 * kt + fr) * XK_LD + 32 * ks + 8 * fq), qf[ks], acc);
                st[kt] = acc; }
            float mx = -INFINITY;
#pragma unroll
            for (int kt = 0; kt < 8; ++kt)
#pragma unroll
                for (int r = 0; r < 4; ++r) { const float sv = st[kt][r] * SC2; st[kt][r] = sv; mx = fmaxf(mx, sv); }
            mx = fmaxf(mx, __shfl_xor(mx, 16)); mx = fmaxf(mx, __shfl_xor(mx, 32));
            const float mn = fmaxf(mrow, mx), corr = __builtin_amdgcn_exp2f(mrow - mn); mrow = mn;
            float ps = 0.f;
#pragma unroll
            for (int kt = 0; kt < 8; ++kt)
#pragma unroll
                for (int r = 0; r < 4; ++r) { const float p = __builtin_amdgcn_exp2f(st[kt][r] - mn); st[kt][r] = p; ps += p; }
            lrow = lrow * corr + ps;
            bf16x8 pf[4];
#pragma unroll
            for (int kk = 0; kk < 4; ++kk) pf[kk] = pack_p(st[2 * kk], st[2 * kk + 1]);
#pragma unroll
            for (int dt = 0; dt < 16; ++dt) { f32x4 acc = oacc[dt] * corr;
#pragma unroll
                for (int kk = 0; kk < 4; ++kk) acc = MFMA16(*(const LAS bf16x8*)(Vb + (16 * dt + fr) * XV_LD + 32 * kk + 8 * fq), pf[kk], acc);
                oacc[dt] = acc; }
        }
        lrow += __shfl_xor(lrow, 16); lrow += __shfl_xor(lrow, 32);
        const float inv = 1.0f / lrow;
        bf16* op = OX + (size_t)(row0 + fr) * 1024 + hd * 256 + 4 * fq;
#pragma unroll
        for (int dt = 0; dt < 16; ++dt) { u32x2 wv; wv.x = pk2(oacc[dt][0] * inv, oacc[dt][1] * inv); wv.y = pk2(oacc[dt][2] * inv, oacc[dt][3] * inv); *(u32x2*)(op + 16 * dt) = wv; }
    }
    WG_BAR();
}
__device__ __forceinline__ void l1_prep(const Ctx& C, ArgsP a, const bf16* Z, const bf16* QKV, bf16* VNT, bf16* QN, bf16* KN, bf16* VV) {
    const int lane = C.lane;
    const float* lng = INP(a, I_SGUG); const float* lnb = INP(a, I_SGUB); const float* cw = INP(a, I_DNCONV);
    for (int blk = C.gw; blk < NT / 8; blk += C.ngw) {
        const int row0 = blk * 8;
        {
            const f32x4 g0 = *((const f32x4*)lng + 2 * lane), g1 = *((const f32x4*)lng + 2 * lane + 1), c0 = *((const f32x4*)lnb + 2 * lane), c1 = *((const f32x4*)lnb + 2 * lane + 1);
            unsigned vt[8][4];
#pragma unroll
            for (int e = 0; e < 8; ++e)
#pragma unroll
                for (int q = 0; q < 4; ++q) vt[e][q] = 0u;
#pragma unroll
            for (int r = 0; r < 8; ++r) {
                float f[8]; unpack8(*((const u32x4*)(Z + (size_t)(row0 + r) * 1024 + 512) + lane), f);
                float s = 0.f;
#pragma unroll
                for (int e = 0; e < 8; ++e) s += f[e];
                const float mu = wave_sum(s) * (1.0f / 512.0f); float q = 0.f;
#pragma unroll
                for (int e = 0; e < 8; ++e) { f[e] -= mu; q += f[e] * f[e]; }
                const float rstd = 1.0f / sqrtf(wave_sum(q) * (1.0f / 512.0f) + EPS);
                const float y[8] = {f[0] * rstd * g0.x + c0.x, f[1] * rstd * g0.y + c0.y, f[2] * rstd * g0.z + c0.z, f[3] * rstd * g0.w + c0.w,
                                    f[4] * rstd * g1.x + c1.x, f[5] * rstd * g1.y + c1.y, f[6] * rstd * g1.z + c1.z, f[7] * rstd * g1.w + c1.w};
#pragma unroll
                for (int e = 0; e < 8; ++e) vt[e][r >> 1] |= f2bf(y[e]) << (16 * (r & 1));
            }
            bf16* vp = VNT + ((size_t)(row0 >> 7) * 512 + 8 * lane) * 128 + (row0 & 127);
#pragma unroll
            for (int e = 0; e < 8; ++e) { u32x4 w; w.x = vt[e][0]; w.y = vt[e][1]; w.z = vt[e][2]; w.w = vt[e][3]; *(u32x4*)(vp + (size_t)e * 128) = w; }
        }
        const bool hist = (row0 & (SEQ - 1)) != 0;
#pragma unroll 1
        for (int s3 = 0; s3 < 3; ++s3) {
            const int cs = s3 * 512 + 8 * lane;
            float w[4][8];
#pragma unroll
            for (int j = 0; j < 4; ++j) { const f32x4 a0 = *(const f32x4*)(cw + j * 1536 + cs), a1 = *(const f32x4*)(cw + j * 1536 + cs + 4);
                w[j][0] = a0.x; w[j][1] = a0.y; w[j][2] = a0.z; w[j][3] = a0.w; w[j][4] = a1.x; w[j][5] = a1.y; w[j][6] = a1.z; w[j][7] = a1.w; }
            float x0[8], x1[8], x2[8];
            if (hist) { unpack8(*(const u32x4*)(QKV + (size_t)(row0 - 3) * 1536 + cs), x0); unpack8(*(const u32x4*)(QKV + (size_t)(row0 - 2) * 1536 + cs), x1); unpack8(*(const u32x4*)(QKV + (size_t)(row0 - 1) * 1536 + cs), x2); }
            else {
#pragma unroll
                for (int e = 0; e < 8; ++e) { x0[e] = 0.f; x1[e] = 0.f; x2[e] = 0.f; } }
            bf16* dst = (s3 == 0 ? QN : s3 == 1 ? KN : VV) + (size_t)row0 * 512 + 8 * lane;
#pragma unroll
            for (int r = 0; r < 8; ++r) {
                float x3[8]; unpack8(*(const u32x4*)(QKV + (size_t)(row0 + r) * 1536 + cs), x3);
                float y[8], ss = 0.f;
#pragma unroll
                for (int e = 0; e < 8; ++e) { y[e] = silu_f(w[0][e] * x0[e] + w[1][e] * x1[e] + w[2][e] * x2[e] + w[3][e] * x3[e]); ss += y[e] * y[e]; }
                float sc = 1.0f;
                if (s3 < 2) { ss += __shfl_xor(ss, 1); ss += __shfl_xor(ss, 2); ss += __shfl_xor(ss, 4); ss += __shfl_xor(ss, 8);
                    sc = 1.0f / sqrtf(ss + EPS); if (s3 == 0) sc *= 0.08838834764831845f; }
                u32x4 o; o.x = pk2(y[0] * sc, y[1] * sc); o.y = pk2(y[2] * sc, y[3] * sc); o.z = pk2(y[4] * sc, y[5] * sc); o.w = pk2(y[6] * sc, y[7] * sc);
                *(u32x4*)(dst + (size_t)r * 512) = o;
#pragma unroll
                for (int e = 0; e < 8; ++e) { x0[e] = x1[e]; x1[e] = x2[e]; x2[e] = x3[e]; }
            }
        }
    }
}

#ifndef MK_MULTI
#define MK_MULTI 0
#endif
enum { OP_PRO0 = 0, OP_KMEAN, OP_MOBA, OP_RMSX, OP_XATTN, OP_RMSF, OP_ACT, OP_PRO1, OP_L1PREP, OP_DNPREP, OP_DNSCAN, OP_DNGATE, OP_FINAL, OP_GSTORE, OP_GRESID, OP_GCONV };
struct PD { int op, sync, L, hb, M, N, K; unsigned long long a, b, p0, p1, p2; int ld0, ld1, ld2, t1, t2, gelu0, basex, rot; long long ss; };
#define PH_TABLE \
  {OP_PRO0, 1, 0, 0, 0, 0, 0, 0ull, 0ull, 0ull, 0ull, 0ull, 0, 0, 0, 0, 0, 0, 0, 0, -1ll}, \
  {OP_GSTORE, 0, 0, 0, 16384, 1536, 1024, 38797312ull, 4194304ull, 141557760ull, 0ull, 0ull, 1536, 0, 0, 1000, 1000, 0, 0, 0, -1ll}, \
  {OP_GSTORE, 1, 0, 0, 512, 16384, 1024, 7340032ull, 208666624ull, 191889408ull, 0ull, 0ull, 16384, 0, 0, 1000, 1000, 0, 0, 128, -1ll}, \
  {OP_KMEAN, 0, 0, 0, 0, 0, 0, 0ull, 0ull, 0ull, 0ull, 0ull, 0, 0, 0, 0, 0, 0, 0, 0, -1ll}, \
  {OP_GSTORE, 0, 0, 0, 512, 1024, 1024, 0ull, 14680064ull, 72351744ull, 0ull, 0ull, 1024, 0, 0, 1000, 1000, 0, 0, 64, -1ll}, \
  {OP_GSTORE, 1, 0, 0, 1024, 512, 1024, 16777216ull, 2097152ull, 73400320ull, 0ull, 0ull, 512, 0, 0, 1000, 1000, 0, 0, 72, -1ll}, \
  {OP_MOBA, 1, 0, 0, 0, 0, 0, 0ull, 0ull, 0ull, 0ull, 0ull, 0, 0, 0, 0, 0, 0, 0, 0, -1ll}, \
  {OP_GRESID, 1, 0, 0, 16384, 1024, 1024, 74448896ull, 10485760ull, 0ull, 0ull, 0ull, 0, 0, 0, 0, 0, 0, 1, 0, 260046848ll}, \
  {OP_GSTORE, 1, 0, 0, 16384, 1024, 1024, 38797312ull, 12582912ull, 108003328ull, 0ull, 0ull, 1024, 0, 0, 1000, 1000, 0, 0, 0, 260046848ll}, \
  {OP_XATTN, 1, 0, 0, 0, 0, 0, 0ull, 0ull, 0ull, 0ull, 0ull, 0, 0, 0, 0, 0, 0, 0, 0, -1ll}, \
  {OP_GRESID, 1, 0, 0, 16384, 1024, 1024, 74448896ull, 18874368ull, 0ull, 0ull, 0ull, 0, 0, 0, 0, 0, 0, 0, 0, 260046848ll}, \
  {OP_GCONV, 1, 0, 0, 17408, 5632, 1024, 38797312ull, 20971520ull, 74448896ull, 0ull, 0ull, 0, 0, 0, 0, 0, 0, 0, 0, 260046848ll}, \
  {OP_GRESID, 1, 0, 2, 16384, 1024, 2816, 74448896ull, 32505856ull, 0ull, 0ull, 0ull, 0, 0, 0, 0, 0, 0, 0, 0, -1ll}, \
  {OP_PRO1, 1, 0, 0, 0, 0, 0, 0ull, 0ull, 0ull, 0ull, 0ull, 0, 0, 0, 0, 0, 0, 0, 0, -1ll}, \
  {OP_GSTORE, 1, 0, 0, 16384, 3072, 1024, 38797312ull, 4194304ull, 141557760ull, 175112192ull, 225443840ull, 1024, 1536, 512, 4, 10, 1, 0, 0, -1ll}, \
  {OP_L1PREP, 1, 0, 0, 0, 0, 0, 0ull, 0ull, 0ull, 0ull, 0ull, 0, 0, 0, 0, 0, 0, 0, 0, -1ll}, \
  {OP_DNPREP, 0, 0, 0, 0, 0, 0, 0ull, 0ull, 0ull, 0ull, 0ull, 0, 0, 0, 0, 0, 0, 0, 0, -1ll}, \
  {OP_GSTORE, 0, 0, 0, 512, 1024, 1024, 0ull, 14680064ull, 72351744ull, 0ull, 0ull, 1024, 0, 0, 1000, 1000, 0, 0, 128, -1ll}, \
  {OP_GSTORE, 1, 0, 0, 1024, 512, 1024, 16777216ull, 2097152ull, 73400320ull, 0ull, 0ull, 512, 0, 0, 1000, 1000, 0, 0, 136, -1ll}, \
  {OP_DNSCAN, 1, 0, 0, 0, 0, 0, 0ull, 0ull, 0ull, 0ull, 0ull, 0, 0, 0, 0, 0, 0, 0, 0, -1ll}, \
  {OP_DNGATE, 1, 0, 0, 0, 0, 0, 0ull, 0ull, 0ull, 0ull, 0ull, 0, 0, 0, 0, 0, 0, 0, 0, -1ll}, \
  {OP_GRESID, 1, 0, 1, 16384, 1024, 1024, 74448896ull, 10485760ull, 0ull, 0ull, 0ull, 0, 0, 0, 0, 0, 0, 0, 0, 260046848ll}, \
  {OP_GSTORE, 1, 0, 0, 16384, 1024, 1024, 38797312ull, 12582912ull, 108003328ull, 0ull, 0ull, 1024, 0, 0, 1000, 1000, 0, 0, 0, 260046848ll}, \
  {OP_XATTN, 1, 1, 0, 0, 0, 0, 0ull, 0ull, 0ull, 0ull, 0ull, 0, 0, 0, 0, 0, 0, 0, 0, -1ll}, \
  {OP_GRESID, 1, 0, 0, 16384, 1024, 1024, 74448896ull, 18874368ull, 0ull, 0ull, 0ull, 0, 0, 0, 0, 0, 0, 0, 0, 260046848ll}, \
  {OP_GCONV, 1, 1, 0, 17408, 5632, 1024, 38797312ull, 20971520ull, 74448896ull, 0ull, 0ull, 0, 0, 0, 0, 0, 0, 0, 0, 260046848ll}, \
  {OP_GRESID, 1, 0, 0, 16384, 1024, 2816, 74448896ull, 32505856ull, 0ull, 0ull, 0ull, 0, 0, 0, 0, 0, 0, 0, 0, -1ll}, \
  {OP_FINAL, 0, 0, 0, 0, 0, 0, 0ull, 0ull, 0ull, 0ull, 0ull, 0, 0, 0, 0, 0, 0, 0, 0, -1ll},
constexpr int NENT = 28;
__constant__ PD PH_DEV[NENT] = { PH_TABLE };
#define XB_TMO      128
#define XB_XCNT(j)  (256  + 64 * (j))
#define XB_XSUB(j)  (1280 + 64 * (j))
#define XB_XGEN(j)  (2304 + 64 * (j))
#define XB_TOP      3328
#define XB_TOPGEN   3392
#define XCD_BAR_WORDS 3456
#define XB_SPIN_CAP (1u << 18)

__device__ __forceinline__ unsigned xb_ld(unsigned* p)              { return __hip_atomic_load(p, __ATOMIC_RELAXED, __HIP_MEMORY_SCOPE_AGENT); }
__device__ __forceinline__ unsigned xb_add(unsigned* p, unsigned v) { return __hip_atomic_fetch_add(p, v, __ATOMIC_RELAXED, __HIP_MEMORY_SCOPE_AGENT); }
__device__ __forceinline__ unsigned xb_xcc_id() { return (unsigned)__builtin_amdgcn_s_getreg((3 << 11) | 20) & 0xFu; }
#define XB_SPIN(cond, bar) do { unsigned _sp = 0; while (cond) { __builtin_amdgcn_s_sleep(1); \
    if ((++_sp & 255u) == 0u) { if (xb_ld(&(bar)[XB_TMO])) break; if (_sp > XB_SPIN_CAP) { atomicAdd(&(bar)[XB_TMO], 1u); break; } } } } while (0)

struct XcdBarrier {
    unsigned* bar; unsigned x;
    volatile LAS unsigned* st;
};

__device__ __forceinline__ XcdBarrier xcd_barrier_post(unsigned* bar, volatile LAS unsigned* st) {
    XcdBarrier b; b.bar = bar; b.x = xb_xcc_id(); b.st = st;
    if (threadIdx.x == 0) (void)xb_add(&bar[XB_XCNT(b.x)], 1u);
    return b;
}
__device__ __forceinline__ void xcd_barrier_complete(unsigned* bar, unsigned x, unsigned& nloc, unsigned& nx) {
    const unsigned G = gridDim.x * gridDim.y * gridDim.z;
    unsigned sum, cnt, mine, sp = 0u;
    for (;;) {
        sum = 0u; cnt = 0u; mine = 0u;
#pragma unroll
        for (unsigned j = 0; j < 16; ++j) { const unsigned c = xb_ld(&bar[XB_XCNT(j)]); sum += c; cnt += (c > 0u) ? 1u : 0u; mine = (j == x) ? c : mine; }
        if (sum == G) break;
        __builtin_amdgcn_s_sleep(1);
        if ((++sp & 255u) == 0u) { if (xb_ld(&bar[XB_TMO])) break; if (sp > XB_SPIN_CAP) { atomicAdd(&bar[XB_TMO], 1u); break; } }
    }
    nloc = mine > 0u ? mine : 1u; nx = cnt > 0u ? cnt : 1u;
}

__device__ __forceinline__ void xcd_barrier(const XcdBarrier& b) {
    asm volatile("s_waitcnt vmcnt(0)" ::: "memory");
    __syncthreads();
    if (threadIdx.x == 0) {
        unsigned* bar = b.bar;
        __builtin_amdgcn_s_waitcnt(0);
        unsigned nloc = b.st[0], nx = b.st[1];
        if (nloc == 0u) { xcd_barrier_complete(bar, b.x, nloc, nx); b.st[0] = nloc; b.st[1] = nx; }
        const unsigned old = xb_add(&bar[XB_XSUB(b.x)], 1u);
        const unsigned gen = old / nloc;
        if (old + 1u == (gen + 1u) * nloc) {
            __builtin_amdgcn_fence(__ATOMIC_RELEASE, "agent");
            asm volatile("s_waitcnt vmcnt(0)" ::: "memory");
            const unsigned og = xb_add(&bar[XB_TOP], 1u);
            const unsigned tg = og / nx;
            if (og + 1u == (tg + 1u) * nx) xb_add(&bar[XB_TOPGEN], 1u);
            else XB_SPIN(xb_ld(&bar[XB_TOPGEN]) == tg, bar);
            __builtin_amdgcn_fence(__ATOMIC_ACQUIRE, "agent");
            xb_add(&bar[XB_XGEN(b.x)], 1u);
            asm volatile("s_waitcnt vmcnt(0)" ::: "memory");
        } else {
            XB_SPIN(xb_ld(&bar[XB_XGEN(b.x)]) == gen, bar);
            __builtin_amdgcn_fence(__ATOMIC_ACQUIRE, "agent");
            asm volatile("s_waitcnt vmcnt(0)" ::: "memory");
        }
    }
    __syncthreads();
}

constexpr size_t WS_CTL = 3 * MiB, CTL_BYTES = 64 * 1024;
constexpr int MISC_OFF = LDS_BYTES - 128;

static const PD PH_HOST[NENT] = { PH_TABLE };

__global__ void __launch_bounds__(512, 2) mega_fwd(Args a) {
    extern __shared__ __attribute__((aligned(16))) unsigned char lds_raw[];
    cg::grid_group grid = cg::this_grid();
    Ctx C; C.lds = (LAS unsigned char*)lds_raw; C.tid = threadIdx.x; C.lane = C.tid & 63; C.wave = __builtin_amdgcn_readfirstlane(C.tid >> 6);
    C.G = gridDim.x; C.gw = blockIdx.x * 8 + C.wave; C.ngw = C.G * 8; C.gtid = blockIdx.x * 512 + C.tid; C.nthr = C.G * 512;
    unsigned char* ws = a.ws;
    float* H = a.out;
    for (int u = C.tid; u < 128 / 4; u += 512) ((LAS unsigned*)(C.lds + MISC_OFF))[u] = 0u;
    __syncthreads();
    (void)xcd_barrier_post((unsigned*)(ws + WS_CTL), (volatile LAS unsigned*)(C.lds + MISC_OFF) + 8);
    const ArgsP ap0 = (ArgsP)__builtin_amdgcn_kernarg_segment_ptr();
    unsigned char* const ws0 = ws; float* const H0 = H;
    for (int e = a.ph_lo; e < a.ph_hi; ++e) {
        ws = ws0; H = H0; ArgsP ap = ap0; asm volatile("" : "+s"(ap));
        { int t_ = threadIdx.x; asm volatile("" : "+v"(t_)); int g_ = gridDim.x, bx_ = blockIdx.x; asm volatile("" : "+s"(g_), "+s"(bx_));
          C.tid = t_; C.lane = t_ & 63; C.wave = __builtin_amdgcn_readfirstlane(t_ >> 6); C.G = g_; C.gw = bx_ * 8 + C.wave; C.ngw = g_ * 8; C.gtid = bx_ * 512 + t_; C.nthr = g_ * 512; }
        { GAS1 unsigned char* wg = (GAS1 unsigned char*)ws; GAS1 float* hg = (GAS1 float*)H; asm volatile("" : "+s"(wg), "+s"(hg)); ws = (unsigned char*)wg; H = (float*)hg; }
        const int op = PH_DEV[e].op, L = PH_DEV[e].L;
        if (op == OP_GSTORE) {
            const PD& d = PH_DEV[e];
            pg8::Gemm g{(const bf16*)(ws + d.a), (const bf16*)(ws + d.b), d.M, d.N, d.K}; pg8::StaticOrder S; S.init(g.M, g.N, C.G, (int)((blockIdx.x + C.G - d.rot) % C.G));
            pg8::EpiSeg E{(bf16*)(ws + d.p0), (bf16*)(ws + d.p1), (bf16*)(ws + d.p2), d.ld0, d.ld1, d.ld2, d.t1, d.t2, d.gelu0, d.ss >= 0 ? (const float*)(ws + d.ss) : (const float*)nullptr};
            __syncthreads();
            pg8::gemm_phase<pg8::EpiSeg, pg8::StaticOrder, true, true>((PG8_LAS unsigned char*)C.lds, g, S, E, C.tid);
            __syncthreads();
        } else if (op == OP_GCONV) {
            const PD& d = PH_DEV[e];
            pg8::Gemm g{(const bf16*)(ws + d.a), (const bf16*)(ws + d.b), d.M, d.N, d.K, 2, 34, SEQ}; pg8::StaticOrder S; S.init(g.M, g.N, C.G, (int)((blockIdx.x + C.G - d.rot) % C.G));
            pg8::EpiConv E{(bf16*)(ws + d.p0), (const float*)(ws + d.ss), INP(ap, I_FCONV) + (size_t)L * 3 * DFF2, 34, SEQ, DFF};
            __syncthreads();
            pg8::gemm_phase<pg8::EpiConv, pg8::StaticOrder, true, true>((PG8_LAS unsigned char*)C.lds, g, S, E, C.tid);
            __syncthreads();
        } else if (op == OP_GRESID) {
            const PD& d = PH_DEV[e];
            pg8::Gemm g{(const bf16*)(ws + d.a), (const bf16*)(ws + d.b), d.M, d.N, d.K}; pg8::StaticOrder S; S.init(g.M, g.N, C.G, (int)((blockIdx.x + C.G - d.rot) % C.G));
            pg8::EpiResid E{d.basex ? INP(ap, I_X) : (const float*)nullptr, (d.hb & 1) ? (const bf16*)H : (const bf16*)(ws + WS_HB), (d.hb & 2) ? (bf16*)H : (bf16*)(ws + WS_HB), d.ss >= 0 ? (float*)(ws + d.ss) : (float*)nullptr, DM};
            __syncthreads();
            pg8::gemm_phase<pg8::EpiResid, pg8::StaticOrder, true, true>((PG8_LAS unsigned char*)C.lds, g, S, E, C.tid);
            __syncthreads();
        } else if (op == OP_PRO0) {
            convert_weights(C, ap, 0, 0, C.gw, C.ngw);
            rms_all_rows(C, INP(ap, I_X), INP(ap, I_NMIX), (bf16*)(ws + WS_XN), NT, (bf16*)(ws + WS_XNP));
            rms_all_rows(C, INP(ap, I_MEM), INP(ap, I_MEMNORM), (bf16*)(ws + WS_MEMN), 2 * NMEM, (bf16*)(ws + WS_MEMNP));
        } else if (op == OP_KMEAN) {
            kmean_pooled(C, (const bf16*)(ws + WS_PROJ0), (float*)(ws + WS_KMEAN));
            if (C.G > 80) { if ((int)blockIdx.x >= 80) convert_weights(C, ap, 0, 1, C.gw - 80 * 8, C.ngw - 80 * 8); } else convert_weights(C, ap, 0, 1, C.gw, C.ngw);
        }
        else if (op == OP_MOBA) { moba_wg(C, (const bf16*)(ws + WS_PROJ0), (const bf16*)(ws + WS_VT), (const float*)(ws + WS_KMEAN), (bf16*)(ws + WS_MIX));
                                  pool_mfma(C, (const bf16*)(ws + WS_PROJ0), (const bf16*)(ws + WS_PWT), INP(ap, I_POOLS), (bf16*)(ws + WS_MIX)); }
        else if (op == OP_PRO1) { convert_weights(C, ap, 1, 0, C.gw, C.ngw); sgu_w_convert(C, INP(ap, I_SGUW), (bf16*)(ws + WS_WB)); rms_rows_bg(C, ap, (const bf16*)H, (bf16*)(ws + WS_XN), (float*)(ws + WS_BG)); }
        else if (op == OP_L1PREP) { l1_prep(C, ap, (const bf16*)(ws + WS_Z), (const bf16*)(ws + WS_QKV), (bf16*)(ws + WS_VNT), (bf16*)(ws + WS_QN), (bf16*)(ws + WS_KN), (bf16*)(ws + WS_VV)); }
        else if (op == OP_DNPREP) {
            dn_chunk_prep(C, (const bf16*)(ws + WS_QN), (const bf16*)(ws + WS_KN), (const bf16*)(ws + WS_VV), (const float*)(ws + WS_BG), (bf16*)(ws + WS_U), (bf16*)(ws + WS_W), (bf16*)(ws + WS_QD), (bf16*)(ws + WS_KDT), (bf16*)(ws + WS_QKM), (float*)(ws + WS_GL));
        }
        else if (op == OP_DNSCAN) {
            const int nscan = C.G > 64 ? 64 : 0;
            if ((int)blockIdx.x < nscan || nscan == 0) for (int it = blockIdx.x; it < 64; it += C.G) dn_scan(C, (const bf16*)(ws + WS_U), (const bf16*)(ws + WS_W), (const bf16*)(ws + WS_QD), (const bf16*)(ws + WS_KDT), (const bf16*)(ws + WS_QKM), (const float*)(ws + WS_GL), (float*)(ws + WS_O), it);
            if ((int)blockIdx.x >= nscan) { const int gw0 = C.gw - nscan * 8, ngw0 = C.ngw - nscan * 8;
                sgu_mfma(C, (const bf16*)(ws + WS_Z), (const bf16*)(ws + WS_VNT), (const bf16*)(ws + WS_WB), INP(ap, I_SGUBS), (bf16*)(ws + WS_MIX), gw0, ngw0);
                convert_weights(C, ap, 1, 1, gw0, ngw0); }
        }
        else if (op == OP_DNGATE) { dn_out_gate(C, ap, (const float*)(ws + WS_O), (const bf16*)(ws + WS_GATE), (bf16*)(ws + WS_MIX)); }
        else if (op == OP_RMSX) { rms_all_rows(C, H, INP(ap, I_NXATTN) + L * DM, (bf16*)(ws + WS_XN), NT); }
        else if (op == OP_XATTN) { xattn_wg(C, (const bf16*)(ws + WS_QX), (const bf16*)(ws + WS_KVX), (const bf16*)(ws + WS_VXT), (bf16*)(ws + WS_MIX)); }
        else if (op == OP_RMSF) { rms_all_rows(C, H, INP(ap, I_NFFN) + L * DM, (bf16*)(ws + WS_XN), NT); }
        else if (op == OP_ACT) { ffn_act(C, (const bf16*)(ws + WS_HUP), INP(ap, I_FCONV) + (size_t)L * 3 * DFF2, (bf16*)(ws + WS_ACT), PH_DEV[e].hb); }
        else if (op == OP_FINAL) { final_norm(C, (const bf16*)(ws + WS_HB), H, INP(ap, I_FNORM)); }
        if (PH_DEV[e].sync && e + 1 < a.ph_hi) { if (e < 0) grid.sync();   else { XcdBarrier bar; bar.bar = (unsigned*)(ws + WS_CTL); bar.x = xb_xcc_id(); bar.st = (volatile LAS unsigned*)(C.lds + MISC_OFF) + 8; xcd_barrier(bar); } }
    }
}

extern "C" void kernel_launch(void* const* d_in, const int* in_sizes, int n_in, void* d_out, int out_size, void* d_ws, size_t ws_size, hipStream_t stream) {
    static int grid = 0;
    if (grid == 0) {
        if (n_in != 27 || out_size != NT * DM || ws_size < WS_END) { fprintf(stderr, "kernel_launch: unexpected sizes n_in %d out %d ws %zu\n", n_in, out_size, ws_size); grid = -1; return; }
        int dev = 0, cus = 0, per_cu = 0;
        (void)hipGetDevice(&dev); (void)hipDeviceGetAttribute(&cus, hipDeviceAttributeMultiprocessorCount, dev);
        if (hipFuncSetAttribute((const void*)mega_fwd, hipFuncAttributeMaxDynamicSharedMemorySize, LDS_BYTES) != hipSuccess) { fprintf(stderr, "kernel_launch: hipFuncSetAttribute failed\n"); }
        if (hipOccupancyMaxActiveBlocksPerMultiprocessor(&per_cu, (const void*)mega_fwd, 512, LDS_BYTES) != hipSuccess || per_cu < 1) { fprintf(stderr, "kernel_launch: occupancy query says %d\n", per_cu); per_cu = 1; }
        (void)hipGetLastError();
        grid = cus * 1;
        if (grid <= 0) grid = 256;
    }
    if (grid < 0) return;
    if (hipMemsetAsync((char*)d_ws + WS_CTL, 0, CTL_BYTES, stream) != hipSuccess) { fprintf(stderr, "kernel_launch: hipMemsetAsync failed\n"); return; }
    Args a{};
    for (int i = 0; i < 27; ++i) a.in[i] = (const float*)d_in[i];
    a.out = (float*)d_out; a.ws = (unsigned char*)d_ws;
#if MK_MULTI
    for (int e0 = 0; e0 < NENT;) { int e1 = e0; while (e1 < NENT - 1 && !PH_HOST[e1].sync) ++e1; ++e1;
        a.ph_lo = e0; a.ph_hi = e1; void* args[] = {&a};
        hipError_t er = hipLaunchCooperativeKernel((const void*)mega_fwd, dim3(grid), dim3(512), args, LDS_BYTES, stream);
        if (er != hipSuccess) { fprintf(stderr, "launch %d failed: %s\n", e0, hipGetErrorString(er)); break; }
        e0 = e1; }
#else
    a.ph_lo = 0; a.ph_hi = NENT; void* args[] = {&a};
    hipError_t er = hipLaunchCooperativeKernel((const void*)mega_fwd, dim3(grid), dim3(512), args, LDS_BYTES, stream);
    if (er != hipSuccess) fprintf(stderr, "cooperative launch failed: %s (grid %d)\n", hipGetErrorString(er), grid);
#endif
}
```

```cpp
#include <hip/hip_runtime.h>
#include <hip/hip_cooperative_groups.h>
#include <cstdio>
#include <cstdint>
namespace cg = cooperative_groups;
namespace pg8 {
#define PG8_LAS __attribute__((address_space(3)))
typedef unsigned short bf16_t;
typedef short bf16x8 __attribute__((ext_vector_type(8)));
typedef float f32x4 __attribute__((ext_vector_type(4)));
typedef unsigned u32x4 __attribute__((ext_vector_type(4)));
constexpr int BM = 256, BK = 64, HALF = 128, HTB = HALF * BK * 2  , STAGE_BYTES = 8 * HTB, NXCD = 8, WGM = 8;

__host__ __device__ __forceinline__ int lds_byte(int r, int c) { const int st = (r >> 4) * 2 + (c >> 5), rr = r & 15, cc = c & 31, ob = rr * 64 + cc * 2; return st * 1024 + (ob ^ (((ob >> 9) & 1) << 5)); }
__host__ __device__ __forceinline__ void stage_rc(int b, int& R, int& C) { const int st = b / 1024, sb = b % 1024, swz = sb ^ (((sb >> 9) & 1) << 5); R = (st >> 1) * 16 + swz / 64; C = (st & 1) * 32 + (swz % 64) / 2; }
__host__ __device__ __forceinline__ int perm32(int rho) { const int n = rho >> 4, i = rho & 15; return 8 * (i >> 2) + 4 * n + (i & 3); }

struct Unit { int pm, pn; };
struct Gemm { const bf16_t* A; const bf16_t* Bt; int M, N, K; int ov, tpb, seq; };

struct StaticOrder {
    int nM, nN, nwg, G, c;
    __host__ __device__ void init(int M, int N, int G_, int c_) { nM = M / BM; nN = N / BM; nwg = nM * nN; G = G_; c = c_; }
    __host__ __device__ bool next(int i, Unit& u) const {
        const long L = (long)i * G + c; if (L >= nwg) return false;
        int wgid = (int)L; { const int q = nwg / NXCD, r = nwg % NXCD, xcd = wgid % NXCD, off = wgid / NXCD; wgid = (xcd < r ? xcd * (q + 1) : r * (q + 1) + (xcd - r) * q) + off; }
        const int nig = WGM * nN, gid = wgid / nig, fm = gid * WGM, gsz = (nM - fm) < WGM ? (nM - fm) : WGM;
        u.pm = fm + ((wgid % nig) % gsz); u.pn = (wgid % nig) / gsz; return true;
    }
    __device__ __forceinline__ void a_ready(const Unit&) const {}
    __device__ __forceinline__ void done(const Unit&) const {}
};

__device__ __forceinline__ unsigned cvt_pk_bf16(float lo, float hi) { unsigned r; asm volatile("v_cvt_pk_bf16_f32 %0, %1, %2" : "=v"(r) : "v"(lo), "v"(hi)); return r; }
__device__ __forceinline__ float gelu_tanh(float x) { const float u2 = 1.5957691216057308f * (x + 0.044715f * x * x * x); return x * __builtin_amdgcn_rcpf(1.0f + __expf(-u2)); }

struct EpiSeg {
    static constexpr bool PERM = true, AFTER_DRAIN = false;
    bf16_t* p0; bf16_t* p1; bf16_t* p2; int ld0, ld1, ld2, t1, t2, gelu0; const float* ss;
    __device__ __forceinline__ void operator()(const f32x4 (&acc)[2][2][4][2], const Unit& u, int wr, int wc, int fr, int fq) const {
        bf16_t* base; int ld, colt; bool act = false;
        if (u.pn < t1) { base = p0; ld = ld0; colt = u.pn * BM; act = gelu0 != 0; }
        else if (u.pn < t2) { base = p1; ld = ld1; colt = (u.pn - t1) * BM; }
        else { base = p2; ld = ld2; colt = (u.pn - t2) * BM; }
        const int row0 = u.pm * BM + wr * 64 + fr, col0 = colt + wc * 32 + 8 * fq;
#pragma unroll
        for (int ai = 0; ai < 2; ++ai)
#pragma unroll
            for (int m = 0; m < 4; ++m) { bf16_t* rowp = base + (size_t)(row0 + ai * HALF + m * 16) * ld + col0;
                float rs = 1.0f;
                if (ss) { const f32x4* sp = (const f32x4*)(ss + (size_t)(row0 + ai * HALF + m * 16) * 16); const f32x4 s0 = sp[0], s1 = sp[1], s2 = sp[2], s3 = sp[3];
                    const float tot = ((s0[0] + s0[1]) + (s0[2] + s0[3])) + ((s1[0] + s1[1]) + (s1[2] + s1[3])) + ((s2[0] + s2[1]) + (s2[2] + s2[3])) + ((s3[0] + s3[1]) + (s3[2] + s3[3]));
                    rs = 1.0f / sqrtf(tot * (1.0f / 1024.0f) + 1e-6f); }
#pragma unroll
                for (int bj = 0; bj < 2; ++bj) { f32x4 v0 = acc[ai][bj][m][0] * rs, v1 = acc[ai][bj][m][1] * rs;
                    if (act) { v0 = (f32x4){gelu_tanh(v0[0]), gelu_tanh(v0[1]), gelu_tanh(v0[2]), gelu_tanh(v0[3])}; v1 = (f32x4){gelu_tanh(v1[0]), gelu_tanh(v1[1]), gelu_tanh(v1[2]), gelu_tanh(v1[3])}; }
                    u32x4 w; w.x = cvt_pk_bf16(v0[0], v0[1]); w.y = cvt_pk_bf16(v0[2], v0[3]); w.z = cvt_pk_bf16(v1[0], v1[1]); w.w = cvt_pk_bf16(v1[2], v1[3]);
                    *(u32x4*)(rowp + bj * HALF) = w; } }
    }
};
struct EpiResid {
    static constexpr bool PERM = true, AFTER_DRAIN = false;
    const float* basef; const bf16_t* baseh; bf16_t* hb; float* ss; int ld;
    __device__ __forceinline__ void operator()(const f32x4 (&acc)[2][2][4][2], const Unit& u, int wr, int wc, int fr, int fq) const {
        const int col0 = u.pn * BM + wc * 32 + 8 * fq;
#pragma unroll
        for (int ai = 0; ai < 2; ++ai)
#pragma unroll
            for (int m = 0; m < 4; ++m) { const size_t off = (size_t)(u.pm * BM + ai * HALF + wr * 64 + m * 16 + fr) * ld + col0; float sq = 0.f;
#pragma unroll
                for (int bj = 0; bj < 2; ++bj) { f32x4 b0, b1;
                    if (basef) { b0 = *(const f32x4*)(basef + off + bj * HALF); b1 = *(const f32x4*)(basef + off + bj * HALF + 4); }
                    else { const u32x4 w = *(const u32x4*)(baseh + off + bj * HALF);
                        b0[0] = __uint_as_float(w.x << 16); b0[1] = __uint_as_float(w.x & 0xffff0000u); b0[2] = __uint_as_float(w.y << 16); b0[3] = __uint_as_float(w.y & 0xffff0000u);
                        b1[0] = __uint_as_float(w.z << 16); b1[1] = __uint_as_float(w.z & 0xffff0000u); b1[2] = __uint_as_float(w.w << 16); b1[3] = __uint_as_float(w.w & 0xffff0000u); }
                    const f32x4 o0 = b0 + acc[ai][bj][m][0], o1 = b1 + acc[ai][bj][m][1];
                    sq += ((o0[0] * o0[0] + o0[1] * o0[1]) + (o0[2] * o0[2] + o0[3] * o0[3])) + ((o1[0] * o1[0] + o1[1] * o1[1]) + (o1[2] * o1[2] + o1[3] * o1[3]));
                    u32x4 w2; w2.x = cvt_pk_bf16(o0[0], o0[1]); w2.y = cvt_pk_bf16(o0[2], o0[3]); w2.z = cvt_pk_bf16(o1[0], o1[1]); w2.w = cvt_pk_bf16(o1[2], o1[3]); *(u32x4*)(hb + off + bj * HALF) = w2; }
                if (ss) { sq += __shfl_xor(sq, 16); sq += __shfl_xor(sq, 32); if (fq == 0) ss[(size_t)(u.pm * BM + ai * HALF + wr * 64 + m * 16 + fr) * 16 + u.pn * 4 + wc] = sq; } }
    }
};
struct EpiConv {
    static constexpr bool PERM = true, AFTER_DRAIN = false;
    static __device__ __forceinline__ float shr16(float oldv, float v, int d) { const int o = __builtin_bit_cast(int, oldv), x = __builtin_bit_cast(int, v); const int y = d == 1 ? __builtin_amdgcn_update_dpp(o, x, 0x111, 0xf, 0xf, false) : __builtin_amdgcn_update_dpp(o, x, 0x112, 0xf, 0xf, false); return __builtin_bit_cast(float, y); }
    static __device__ __forceinline__ float ror16(float v, int d) { const int x = __builtin_bit_cast(int, v); const int y = d == 1 ? __builtin_amdgcn_mov_dpp(x, 0x121, 0xf, 0xf, false) : __builtin_amdgcn_mov_dpp(x, 0x122, 0xf, 0xf, false); return __builtin_bit_cast(float, y); }
    bf16_t* O; const float* ss; const float* cw; int tpb, seq, dff;
    __device__ __forceinline__ void operator()(const f32x4 (&acc)[2][2][4][2], const Unit& u, int wr, int wc, int fr, int fq) const {
        const int lane = fq * 16 + fr, b = u.pm / tpb, pmm = u.pm % tpb, ch0 = u.pn * 128 + wc * 32 + 8 * fq;
#pragma unroll
        for (int ai = 0; ai < 2; ++ai) {
            const int tl0 = pmm * 248 + (2 * ai + wr) * 62 - 2;
            float rs[4];
#pragma unroll
            for (int m = 0; m < 4; ++m) { const int tl = tl0 + 16 * m + fr; float r_ = 0.f;
                if (tl >= 0 && tl < seq) { const f32x4* sp = (const f32x4*)(ss + ((size_t)b * seq + tl) * 16); const f32x4 s0 = sp[0], s1 = sp[1], s2 = sp[2], s3 = sp[3];
                    const float tot = ((s0[0] + s0[1]) + (s0[2] + s0[3])) + ((s1[0] + s1[1]) + (s1[2] + s1[3])) + ((s2[0] + s2[1]) + (s2[2] + s2[3])) + ((s3[0] + s3[1]) + (s3[2] + s3[3]));
                    r_ = 1.0f / sqrtf(tot * (1.0f / 1024.0f) + 1e-6f); }
                rs[m] = r_; }
#pragma unroll
            for (int n = 0; n < 2; ++n) {
                f32x4 wg[3], wu[3];
#pragma unroll
                for (int k = 0; k < 3; ++k) { wg[k] = *(const f32x4*)(cw + (size_t)k * 2 * dff + ch0 + 4 * n); wu[k] = *(const f32x4*)(cw + (size_t)k * 2 * dff + dff + ch0 + 4 * n); }
                float pv[2][4];
#pragma unroll
                for (int bj = 0; bj < 2; ++bj)
#pragma unroll
                    for (int i = 0; i < 4; ++i) pv[bj][i] = 0.f;
#pragma unroll
                for (int m = 0; m < 4; ++m) {
                    const int tl = tl0 + 16 * m + fr; const bool ok = (16 * m + fr >= 2) && tl < seq;
                    float o[4];
#pragma unroll
                    for (int i = 0; i < 4; ++i) { float cv[2];
#pragma unroll
                        for (int bj = 0; bj < 2; ++bj) {
                            const float cur = rs[m] > 0.f ? acc[ai][bj][m][n][i] * rs[m] : 0.f;
                            const float p1 = shr16(ror16(pv[bj][i], 1), cur, 1), p2 = shr16(ror16(pv[bj][i], 2), cur, 2);
                            pv[bj][i] = cur;
                            cv[bj] = bj == 0 ? (wg[0][i] * p2 + wg[1][i] * p1 + wg[2][i] * cur) : (wu[0][i] * p2 + wu[1][i] * p1 + wu[2][i] * cur); }
                        o[i] = cv[0] * __builtin_amdgcn_rcpf(1.0f + __expf(-cv[0])) * cv[1]; }
                    if (ok) { typedef unsigned u32x2e __attribute__((ext_vector_type(2))); u32x2e w; w.x = cvt_pk_bf16(o[0], o[1]); w.y = cvt_pk_bf16(o[2], o[3]);
                        *(u32x2e*)(O + ((size_t)b * seq + tl) * dff + ch0 + 4 * n) = w; }
                }
            }
        }
    }
};
template <class Epi, class Sched, bool ALIGN_EPI = false, bool SP2 = false>
__device__ __forceinline__ void gemm_phase(PG8_LAS unsigned char* lds, const Gemm g, const Sched& S, const Epi& E, const int tid_in) {
    const int tid = tid_in, wid = __builtin_amdgcn_readfirstlane(tid >> 6), lane = tid & 63, wr = wid >> 2, wc = wid & 3, fr = lane & 15, fq = lane >> 4;
    const int K = g.K, nt = K / BK;
    unsigned voffA[2], voffB[2];
#pragma unroll
    for (int i = 0; i < 2; ++i) { int R, C; stage_rc(tid * 16 + i * 8192, R, C); const int Rb = Epi::PERM ? ((R & ~31) + perm32(R & 31)) : R;
        voffA[i] = (unsigned)((R - (R >> 6) * g.ov) * K + C) * 2u; voffB[i] = (unsigned)(Rb * K + C) * 2u; }
    const size_t kstep = (size_t)(BK * 2);
    const size_t hstep = (size_t)HALF * K * 2;
    const size_t tstep = 2 * hstep;
    const size_t hstepA = (size_t)(HALF - 2 * g.ov) * K * 2;
#define PG8_ABASE(pm_) ((const char*)g.A + (g.ov ? ((size_t)((pm_) / g.tpb) * g.seq + (size_t)((pm_) % g.tpb) * (BM - 4 * g.ov)) * K * 2 - (size_t)g.ov * K * 2 : (size_t)(pm_) * tstep))
    const unsigned ldsw = (unsigned)wid * 1024u;
    const int aoff = lds_byte(wr * 64 + fr, fq * 8), boff = lds_byte(wc * 32 + fr, fq * 8);
#define PG8_SA(b, h) (((b) * 2 + (h)) * HTB)
#define PG8_SB(b, h) ((4 + (b) * 2 + (h)) * HTB)
#define PG8_STAGE(bufoff, gbase, voff) do { _Pragma("unroll") for (int _i = 0; _i < 2; ++_i) \
        __builtin_amdgcn_global_load_lds((const unsigned*)((const char*)(gbase) + (voff)[_i]), (PG8_LAS unsigned*)(lds + (bufoff) + ldsw + _i * 8192), 16, 0, 0); } while (0)
#define PG8_LDA(dst, b, h) do { _Pragma("unroll") for (int m = 0; m < 4; ++m) _Pragma("unroll") for (int k = 0; k < 2; ++k) dst[m][k] = *(const PG8_LAS bf16x8*)(lds + PG8_SA(b, h) + aoff + m * 2048 + k * 1024); } while (0)
#define PG8_LDB(dst, b, h) do { _Pragma("unroll") for (int n = 0; n < 2; ++n) _Pragma("unroll") for (int k = 0; k < 2; ++k) dst[n][k] = *(const PG8_LAS bf16x8*)(lds + PG8_SB(b, h) + boff + n * 2048 + k * 1024); } while (0)
#define PG8_MMA(ai, bj, At, Bt) do { __builtin_amdgcn_s_setprio(1); _Pragma("unroll") for (int m = 0; m < 4; ++m) _Pragma("unroll") for (int n = 0; n < 2; ++n) _Pragma("unroll") for (int k = 0; k < 2; ++k) \
        acc[ai][bj][m][n] = __builtin_amdgcn_mfma_f32_16x16x32_bf16(Bt[n][k], At[m][k], acc[ai][bj][m][n], 0, 0, 0); __builtin_amdgcn_s_setprio(0); } while (0)
#define PG8_WAIT_V(n) asm volatile("s_waitcnt vmcnt(" #n ")" ::: "memory")
#define PG8_WAIT_L(n) asm volatile("s_waitcnt lgkmcnt(" #n ")" ::: "memory")
#define PG8_BAR __builtin_amdgcn_s_barrier()
#define PG8_SCHED __builtin_amdgcn_sched_barrier(0)
    Unit cur, nxt; int ui = 0;
    if (!S.next(0, cur)) return;
    f32x4 acc[2][2][4][2];
#pragma unroll
    for (int a = 0; a < 2; ++a)
#pragma unroll
        for (int b = 0; b < 2; ++b)
#pragma unroll
            for (int m = 0; m < 4; ++m)
#pragma unroll
                for (int n = 0; n < 2; ++n) acc[a][b][m][n] = (f32x4){0.f, 0.f, 0.f, 0.f};
    bf16x8 At[4][2], B0[2][2], B1[2][2];
    const char* cA = PG8_ABASE(cur.pm); const char* cB = (const char*)g.Bt + (size_t)cur.pn * tstep;
    S.a_ready(cur);
    if constexpr (SP2) {
        PG8_STAGE(PG8_SB(0, 0), cB, voffB); PG8_STAGE(PG8_SB(0, 1), cB + hstep, voffB); PG8_STAGE(PG8_SA(0, 0), cA, voffA); PG8_STAGE(PG8_SA(0, 1), cA + hstepA, voffA);
        if (wr == 1) PG8_BAR;
        PG8_WAIT_V(2); PG8_BAR;
        PG8_STAGE(PG8_SB(1, 0), cB + kstep, voffB); PG8_STAGE(PG8_SA(1, 0), cA + kstep, voffA); PG8_STAGE(PG8_SB(1, 1), cB + hstep + kstep, voffB);
        PG8_WAIT_V(6); PG8_BAR;
    } else {
        PG8_STAGE(PG8_SB(0, 0), cB, voffB); PG8_STAGE(PG8_SA(0, 0), cA, voffA); PG8_STAGE(PG8_SB(0, 1), cB + hstep, voffB); PG8_STAGE(PG8_SA(0, 1), cA + hstepA, voffA);
        if (wr == 1) PG8_BAR;
        PG8_WAIT_V(4); PG8_BAR;
        PG8_STAGE(PG8_SB(1, 0), cB + kstep, voffB); PG8_STAGE(PG8_SA(1, 0), cA + kstep, voffA); PG8_STAGE(PG8_SB(1, 1), cB + hstep + kstep, voffB);
        PG8_WAIT_V(6); PG8_BAR;
    }
    for (;;) {
        const bool has_next = S.next(ui + 1, nxt);
        const char* nA = has_next ? PG8_ABASE(nxt.pm) : cA; const char* nB = has_next ? (const char*)g.Bt + (size_t)nxt.pn * tstep : cB;
        for (int t = 0; t < nt; t += 2) {
            const bool last = (t == nt - 2);
            const char* a1 = cA + (size_t)(t + 1) * kstep;
            const char* a2 = last ? nA : cA + (size_t)(t + 2) * kstep; const char* b2 = last ? nB : cB + (size_t)(t + 2) * kstep;
            const char* a3 = a2 + kstep; const char* b3 = b2 + kstep;
            if (last && has_next) S.a_ready(nxt);
            if constexpr (SP2) {
            PG8_LDB(B0, 0, 0); PG8_LDB(B1, 0, 1); PG8_SCHED; PG8_LDA(At, 0, 0); PG8_STAGE(PG8_SA(1, 1), a1 + hstepA, voffA);
            PG8_WAIT_V(8); PG8_WAIT_L(0); PG8_BAR; PG8_MMA(0, 0, At, B0); PG8_MMA(0, 1, At, B1); PG8_BAR; PG8_SCHED;
            PG8_LDA(At, 0, 1); PG8_STAGE(PG8_SB(0, 0), b2, voffB); PG8_STAGE(PG8_SB(0, 1), b2 + hstep, voffB); PG8_STAGE(PG8_SA(0, 0), a2, voffA);
            PG8_WAIT_V(8); PG8_WAIT_L(0); PG8_BAR; PG8_MMA(1, 0, At, B0); PG8_MMA(1, 1, At, B1); PG8_BAR; PG8_SCHED;
            PG8_LDB(B0, 1, 0); PG8_LDB(B1, 1, 1); PG8_SCHED; PG8_LDA(At, 1, 0); PG8_STAGE(PG8_SA(0, 1), a2 + hstepA, voffA);
            PG8_WAIT_V(8); PG8_WAIT_L(0); PG8_BAR; PG8_MMA(0, 0, At, B0); PG8_MMA(0, 1, At, B1); PG8_BAR; PG8_SCHED;
            PG8_LDA(At, 1, 1); PG8_STAGE(PG8_SB(1, 0), b3, voffB); PG8_STAGE(PG8_SB(1, 1), b3 + hstep, voffB); PG8_STAGE(PG8_SA(1, 0), a3, voffA);
            PG8_WAIT_V(8); PG8_WAIT_L(0); PG8_BAR; PG8_MMA(1, 0, At, B0); PG8_MMA(1, 1, At, B1); PG8_BAR; PG8_SCHED;
            } else {
            PG8_LDB(B0, 0, 0); PG8_SCHED; PG8_LDA(At, 0, 0); PG8_STAGE(PG8_SA(1, 1), a1 + hstepA, voffA);
            PG8_WAIT_L(8); PG8_BAR; PG8_WAIT_L(0); PG8_MMA(0, 0, At, B0); PG8_BAR; PG8_SCHED;
            PG8_LDB(B1, 0, 1); PG8_STAGE(PG8_SB(0, 0), b2, voffB);
            PG8_BAR; PG8_WAIT_L(0); PG8_MMA(0, 1, At, B1); PG8_BAR;
            PG8_LDA(At, 0, 1); PG8_STAGE(PG8_SA(0, 0), a2, voffA);
            PG8_BAR; PG8_WAIT_L(0); PG8_MMA(1, 0, At, B0); PG8_BAR; PG8_SCHED;
            PG8_STAGE(PG8_SB(0, 1), b2 + hstep, voffB);
            PG8_WAIT_V(6); PG8_BAR; PG8_MMA(1, 1, At, B1); PG8_BAR;
            PG8_LDB(B0, 1, 0); PG8_SCHED; PG8_LDA(At, 1, 0); PG8_STAGE(PG8_SA(0, 1), a2 + hstepA, voffA);
            PG8_WAIT_L(8); PG8_BAR; PG8_WAIT_L(0); PG8_MMA(0, 0, At, B0); PG8_BAR; PG8_SCHED;
            PG8_LDB(B1, 1, 1); PG8_STAGE(PG8_SB(1, 0), b3, voffB);
            PG8_BAR; PG8_WAIT_L(0); PG8_MMA(0, 1, At, B1); PG8_BAR;
            PG8_LDA(At, 1, 1); PG8_STAGE(PG8_SA(1, 0), a3, voffA);
            PG8_BAR; PG8_WAIT_L(0); PG8_MMA(1, 0, At, B0); PG8_BAR; PG8_SCHED;
            PG8_STAGE(PG8_SB(1, 1), b3 + hstep, voffB);
            PG8_WAIT_V(6); PG8_BAR; PG8_MMA(1, 1, At, B1); PG8_BAR;
            }
        }
        if constexpr (ALIGN_EPI) { if (wr == 0) PG8_BAR; }
        if constexpr (!Epi::AFTER_DRAIN) { E(acc, cur, wr, wc, fr, fq); S.done(cur); }
        if (!has_next) break;
#pragma unroll
        for (int a = 0; a < 2; ++a)
#pragma unroll
            for (int b = 0; b < 2; ++b)
#pragma unroll
                for (int m = 0; m < 4; ++m)
#pragma unroll
                    for (int n = 0; n < 2; ++n) acc[a][b][m][n] = (f32x4){0.f, 0.f, 0.f, 0.f};
        cur = nxt; cA = nA; cB = nB; ++ui;
        if constexpr (ALIGN_EPI) { if (wr == 1) PG8_BAR; }
    }
    PG8_WAIT_V(0);
    if constexpr (!ALIGN_EPI) { if (wr == 0) PG8_BAR; }
    PG8_BAR;
    if constexpr (Epi::AFTER_DRAIN) { E.fused(acc, cur, wr, wc, fr, fq, lds, wid, lane); S.done(cur); }
#undef PG8_ABASE
#undef PG8_SA
#undef PG8_SB
#undef PG8_STAGE
#undef PG8_LDA
#undef PG8_LDB
#undef PG8_MMA
#undef PG8_WAIT_V
#undef PG8_WAIT_L
#undef PG8_BAR
#undef PG8_SCHED
}
}

constexpr int NT = 16384, SEQ = 8192, DM = 1024, NMEM = 256, DFF = 2816, DFF2 = 5632;
constexpr float EPS = 1e-6f;
#define LAS __attribute__((address_space(3)))
typedef unsigned short bf16;
typedef float f32x4 __attribute__((ext_vector_type(4)));
typedef unsigned u32x4 __attribute__((ext_vector_type(4)));
typedef unsigned u32x2 __attribute__((ext_vector_type(2)));
constexpr size_t MiB = 1u << 20;
constexpr size_t WS_MEMN = 0, WS_BG = 1 * MiB, WS_KMEAN = 1 * MiB + 512 * 1024;
constexpr size_t WS_WTS = 4 * MiB;
constexpr size_t W_IN = WS_WTS, W_OUT = WS_WTS + 6 * MiB, W_Q = WS_WTS + 8 * MiB, W_KV = WS_WTS + 10 * MiB, W_O = WS_WTS + 14 * MiB, W_UP = WS_WTS + 16 * MiB, W_DN = WS_WTS + 27 * MiB;
constexpr size_t WS_XN = 37 * MiB, WS_KVX = 69 * MiB, WS_MIX = 71 * MiB, WS_QX = 103 * MiB, WS_F = 135 * MiB;
constexpr size_t WS_PROJ0 = WS_F, WS_Z = WS_F, WS_QKV = WS_F + 32 * MiB, WS_GATE = WS_F + 80 * MiB, WS_O = WS_QX;
constexpr size_t WS_U = WS_F + 32 * MiB, WS_W = WS_F + 48 * MiB, WS_KDT = WS_F + 64 * MiB, WS_QD = WS_F + 96 * MiB, WS_QKM = WS_F + 112 * MiB, WS_GL = 1 * MiB + 768 * 1024;
constexpr size_t WS_VT = WS_F + 48 * MiB, WS_XNP = WS_F + 64 * MiB, WS_MEMNP = 2 * MiB, WS_VXT = WS_KVX + 1 * MiB;
constexpr size_t WS_PWT = 3 * MiB + 64 * 1024, WS_WB = 3 * MiB + 256 * 1024;
constexpr size_t WS_VNT = WS_XN, WS_HB = WS_XN, WS_SS = 248 * MiB;
constexpr size_t WS_POOLED = WS_QX, WS_VN = WS_XN, WS_VV = WS_XN + 16 * MiB, WS_QN = WS_QX, WS_KN = WS_QX + 16 * MiB;
constexpr size_t WS_ACT = WS_MIX, WS_HUP = WS_MIX + 88 * MiB, WS_END = 256 * MiB;
static_assert(WS_HUP + 88 * MiB <= WS_END && WS_GATE + 16 * MiB <= WS_QD && WS_QKM + 8 * MiB <= WS_END, "ws map");
constexpr int LDS_BYTES = 147456;

__device__ __forceinline__ float bf2f(unsigned v) { return __uint_as_float(v << 16); }
__device__ __forceinline__ unsigned f2bf(float f) { unsigned u = __float_as_uint(f); return (u + 0x7fffu + ((u >> 16) & 1u)) >> 16; }
__device__ __forceinline__ unsigned pk2(float lo, float hi) { return f2bf(lo) | (f2bf(hi) << 16); }
__device__ __forceinline__ float lo16(unsigned w) { return __uint_as_float(w << 16); }
__device__ __forceinline__ float hi16(unsigned w) { return __uint_as_float(w & 0xffff0000u); }
__device__ __forceinline__ float wave_sum(float v) {
#pragma unroll
    for (int o = 1; o < 64; o <<= 1) v += __shfl_xor(v, o);
    return v;
}
__device__ __forceinline__ float wave_max(float v) {
#pragma unroll
    for (int o = 1; o < 64; o <<= 1) v = fmaxf(v, __shfl_xor(v, o));
    return v;
}
__device__ __forceinline__ float silu_f(float x) { return x * __builtin_amdgcn_rcpf(1.0f + __expf(-x)); }
#define LDS_WAIT() asm volatile("s_waitcnt lgkmcnt(0)" ::: "memory")

struct Args { const float* in[27]; float* out; unsigned char* ws; int ph_lo, ph_hi; };
typedef const __attribute__((address_space(4))) Args* ArgsP;
#define GAS1 __attribute__((address_space(1)))
__device__ __forceinline__ const float* inp_ptr(ArgsP ap, int i) { GAS1 const float* g = (GAS1 const float*)ap->in[i]; asm volatile("" : "+s"(g)); return (const float*)g; }
__device__ __forceinline__ unsigned char* ws_ptr(ArgsP ap) { GAS1 unsigned char* g = (GAS1 unsigned char*)ap->ws; asm volatile("" : "+s"(g)); return (unsigned char*)g; }
#define INP(ap, i) inp_ptr((ap), (i))
enum { I_X = 0, I_MEM, I_MEMNORM, I_NMIX, I_NXATTN, I_NFFN, I_EVIN, I_POOLW, I_POOLS, I_EVOUT, I_ODIN, I_SGUG, I_SGUB, I_SGUW, I_SGUBS, I_DNCONV, I_DNALOG, I_DNDT, I_DNNG, I_ODOUT,
       I_WQ, I_WKV, I_WO, I_FUP, I_FCONV, I_FDN, I_FNORM };

struct Ctx { LAS unsigned char* lds; int tid, lane, wave, G, gw, ngw, gtid, nthr; };

__device__ __forceinline__ void transpose_item(const float* W, int ldw, int K, int ncols, bf16* WT, LAS float* scr, int item, int lane, const float* gain = nullptr, int guperm = 0) {
    const int nblk = ncols / 32, kb = item / nblk, nb = item % nblk, k0 = 64 * kb, n0 = 32 * nb;
#pragma unroll
    for (int i = 0; i < 8; ++i) { const int kk = 8 * i + (lane >> 3), c4 = lane & 7;
        const f32x4 v = *(const f32x4*)(W + (size_t)(k0 + kk) * ldw + n0 + 4 * c4); const float gk = gain ? gain[k0 + kk] : 1.0f;
        LAS float* d = scr + kk * 33 + 4 * c4; d[0] = v.x * gk; d[1] = v.y * gk; d[2] = v.z * gk; d[3] = v.w * gk; }
    LDS_WAIT();
    const int c = lane & 7;
    int drow = n0; if (guperm) { const int isu = n0 >= guperm ? 1 : 0, nn = n0 - isu * guperm; drow = 256 * (nn >> 7) + 128 * isu + (nn & 127); }
#pragma unroll
    for (int j = 0; j < 4; ++j) { const int n = (lane >> 3) + 8 * j; const LAS float* s = scr + (8 * c) * 33 + n;
        u32x4 o; o.x = pk2(s[0 * 33], s[1 * 33]); o.y = pk2(s[2 * 33], s[3 * 33]); o.z = pk2(s[4 * 33], s[5 * 33]); o.w = pk2(s[6 * 33], s[7 * 33]);
        *(u32x4*)(WT + (size_t)(drow + n) * K + k0 + 8 * c) = o; }
    LDS_WAIT();
}
__device__ __forceinline__ void convert_weights(const Ctx& C, ArgsP a, int L, int part, int gw0, int ngw0) {
    LAS float* scr = (LAS float*)(C.lds + C.wave * 16384);
    unsigned char* ws = ws_ptr(a);
    const float* w_in = L == 0 ? INP(a, I_EVIN) : INP(a, I_ODIN); const int n_in = L == 0 ? 2048 : 3072, ld_in = L == 0 ? 2048 : 3080;
    const float* w_out = L == 0 ? INP(a, I_EVOUT) : INP(a, I_ODOUT);
    const float* wq = INP(a, I_WQ) + (size_t)L * DM * DM; const float* wkv = INP(a, I_WKV) + (size_t)L * DM * 2 * DM; const float* wo = INP(a, I_WO) + (size_t)L * DM * DM;
    const float* wup = INP(a, I_FUP) + (size_t)L * DM * DFF2; const float* wdn = INP(a, I_FDN) + (size_t)L * DFF * DM;
    const int i0 = (DM / 64) * (n_in / 32), i1 = (DM / 64) * (DM / 32), i2 = i1, i3 = (DM / 64) * (2 * DM / 32), i4 = i1, i5 = (DM / 64) * (DFF2 / 32), i6 = (DFF / 64) * (DM / 32);
    const int total = i0 + i1 + i2 + i3 + i4 + i5 + i6;
    for (int it = gw0; it < total; it += ngw0) {
        int r = it;
        { const bool first = (r < i0 + i1) || (r >= i0 + i1 + i2 && r < i0 + i1 + i2 + i3); if ((part == 0 && !first) || (part == 1 && first)) continue; }
        if (r < i0) {
            if (L == 0) {
                const int ia = (DM / 64) * (1024 / 32), ib = (DM / 64) * (512 / 32);
                if (r < ia) transpose_item(w_in, ld_in, DM, 1024, (bf16*)(ws + W_IN), scr, r, C.lane);
                else if (r < ia + ib) transpose_item(w_in + 1536, ld_in, DM, 512, (bf16*)(ws + W_IN) + (size_t)1024 * DM, scr, r - ia, C.lane);
                else transpose_item(w_in + 1024, ld_in, DM, 512, (bf16*)(ws + W_IN) + (size_t)1536 * DM, scr, r - ia - ib, C.lane);
            } else transpose_item(w_in, ld_in, DM, n_in, (bf16*)(ws + W_IN), scr, r, C.lane);
            continue; } r -= i0;
        if (r < i1) { transpose_item(w_out, DM, DM, DM, (bf16*)(ws + W_OUT), scr, r, C.lane); continue; } r -= i1;
        if (r < i2) { transpose_item(wq, DM, DM, DM, (bf16*)(ws + W_Q), scr, r, C.lane, INP(a, I_NXATTN) + L * DM); continue; } r -= i2;
        if (r < i3) { transpose_item(wkv, 2 * DM, DM, 2 * DM, (bf16*)(ws + W_KV), scr, r, C.lane); continue; } r -= i3;
        if (r < i4) { transpose_item(wo, DM, DM, DM, (bf16*)(ws + W_O), scr, r, C.lane); continue; } r -= i4;
        if (r < i5) { transpose_item(wup, DFF2, DM, DFF2, (bf16*)(ws + W_UP), scr, r, C.lane, INP(a, I_NFFN) + L * DM, DFF); continue; } r -= i5;
        transpose_item(wdn, DM, DFF, DM, (bf16*)(ws + W_DN), scr, r, C.lane);
    }
    if (L == 0) for (int it = gw0; it < 32; it += ngw0) { const int g = it >> 3; transpose_item(INP(a, I_POOLW) + (size_t)g * 128 * 128, 128, 128, 128, (bf16*)(ws + WS_PWT) + (size_t)g * 128 * 128, scr, it & 7, C.lane); }
}
__device__ __forceinline__ void rms_row_bf16(const float* xrow, const float* gain, bf16* orow, int lane, bf16* orow2 = nullptr) {
    const f32x4* xr = (const f32x4*)xrow + lane; const f32x4* gr = (const f32x4*)gain + lane;
    f32x4 v[4]; float s = 0.f;
#pragma unroll
    for (int j = 0; j < 4; ++j) { v[j] = xr[64 * j]; s += (v[j].x * v[j].x + v[j].y * v[j].y) + (v[j].z * v[j].z + v[j].w * v[j].w); }
    const float r = 1.0f / sqrtf(wave_sum(s) * (1.0f / DM) + EPS);
    u32x2* o8 = (u32x2*)orow + lane;
#pragma unroll
    for (int j = 0; j < 4; ++j) { const f32x4 g = gr[64 * j]; u32x2 w; w.x = pk2(v[j].x * r * g.x, v[j].y * r * g.y); w.y = pk2(v[j].z * r * g.z, v[j].w * r * g.w); o8[64 * j] = w; if (orow2) ((u32x2*)orow2 + lane)[64 * j] = w; }
}
__device__ __forceinline__ int perm32k_pos(int s) { return (s < 16) ? (8 * (s >> 2) + (s & 3)) : (8 * ((s - 16) >> 2) + 4 + (s & 3)); }
__device__ __forceinline__ void rms_all_rows(const Ctx& C, const float* src, const float* gain, bf16* dst, int nrows, bf16* dstp = nullptr) {
    for (int m = C.gw; m < nrows; m += C.ngw) rms_row_bf16(src + (size_t)m * DM, gain, dst + (size_t)m * DM, C.lane, dstp ? dstp + (size_t)((m & ~31) + perm32k_pos(m & 31)) * DM : nullptr);
}
__device__ __forceinline__ void rms_rows_bg(const Ctx& C, ArgsP a, const bf16* HBin, bf16* XN, float* BG) {
    const float* gain = INP(a, I_NMIX) + DM; const float* W = INP(a, I_ODIN);
    const int lane = C.lane;
    for (int m = C.gw; m < NT; m += C.ngw) {
        const u32x2* xr = (const u32x2*)(HBin + (size_t)m * DM) + lane; const f32x4* gr = (const f32x4*)gain + lane;
        f32x4 v[4]; float s = 0.f;
#pragma unroll
        for (int j = 0; j < 4; ++j) { const u32x2 w_ = xr[64 * j]; v[j].x = lo16(w_.x); v[j].y = hi16(w_.x); v[j].z = lo16(w_.y); v[j].w = hi16(w_.y); s += (v[j].x * v[j].x + v[j].y * v[j].y) + (v[j].z * v[j].z + v[j].w * v[j].w); }
        const float r = 1.0f / sqrtf(wave_sum(s) * (1.0f / DM) + EPS);
        u32x2* o8 = (u32x2*)(XN + (size_t)m * DM) + lane;
        float d[8];
#pragma unroll
        for (int c = 0; c < 8; ++c) d[c] = 0.f;
#pragma unroll
        for (int j = 0; j < 4; ++j) { const f32x4 g = gr[64 * j]; f32x4 y; y.x = v[j].x * r * g.x; y.y = v[j].y * r * g.y; y.z = v[j].z * r * g.z; y.w = v[j].w * r * g.w;
            u32x2 w; w.x = pk2(y.x, y.y); w.y = pk2(y.z, y.w); o8[64 * j] = w;
#pragma unroll
            for (int e = 0; e < 4; ++e) { const int k = 4 * lane + 256 * j + e; const f32x4 w0 = *(const f32x4*)(W + (size_t)k * 3080 + 3072), w1 = *(const f32x4*)(W + (size_t)k * 3080 + 3076);
                const float ye = y[e]; d[0] += ye * w0.x; d[1] += ye * w0.y; d[2] += ye * w0.z; d[3] += ye * w0.w; d[4] += ye * w1.x; d[5] += ye * w1.y; d[6] += ye * w1.z; d[7] += ye * w1.w; } }
#pragma unroll
        for (int c = 0; c < 8; ++c) d[c] = wave_sum(d[c]);
        if (lane < 4) {
            const float braw = lane == 0 ? d[0] : lane == 1 ? d[1] : lane == 2 ? d[2] : d[3];
            const float araw = lane == 0 ? d[4] : lane == 1 ? d[5] : lane == 2 ? d[6] : d[7];
            const float beta = 1.0f / (1.0f + expf(-braw));
            const float xx = araw + INP(a, I_DNDT)[lane];
            const float sp = xx > 20.f ? xx : log1pf(expf(xx));
            BG[(size_t)m * 8 + lane] = beta; BG[(size_t)m * 8 + 4 + lane] = -expf(INP(a, I_DNALOG)[lane]) * sp;
        }
    }
}
__device__ __forceinline__ void final_norm(const Ctx& C, const bf16* HBin, float* out, const float* gain) {
    for (int m = C.gw; m < NT; m += C.ngw) {
        const u32x2* xr = (const u32x2*)(HBin + (size_t)m * DM) + C.lane; const f32x4* gr = (const f32x4*)gain + C.lane; f32x4* orow = (f32x4*)(out + (size_t)m * DM) + C.lane;
        f32x4 v[4]; float s = 0.f;
#pragma unroll
        for (int j = 0; j < 4; ++j) { const u32x2 w_ = xr[64 * j]; v[j].x = lo16(w_.x); v[j].y = hi16(w_.x); v[j].z = lo16(w_.y); v[j].w = hi16(w_.y); s += (v[j].x * v[j].x + v[j].y * v[j].y) + (v[j].z * v[j].z + v[j].w * v[j].w); }
        const float r = 1.0f / sqrtf(wave_sum(s) * (1.0f / DM) + EPS);
#pragma unroll
        for (int j = 0; j < 4; ++j) { const f32x4 g = gr[64 * j]; f32x4 y; y.x = v[j].x * r * g.x; y.y = v[j].y * r * g.y; y.z = v[j].z * r * g.z; y.w = v[j].w * r * g.w; orow[64 * j] = y; }
    }
}
__device__ __forceinline__ void kmean_pooled(const Ctx& C, const bf16* PROJ, float* KMEAN) {
    const int lane = C.lane, d4 = lane & 15, rq = lane >> 4;
    for (int it = C.gw; it < 2 * 8 * 32; it += C.ngw) {
        const int blk = it & 31, h = (it >> 5) & 7, b = it >> 8;
        const bf16* p = PROJ + (size_t)(b * SEQ + blk * 256 + rq * 64) * 1536 + 512 + h * 64 + 4 * d4; float s0 = 0.f, s1 = 0.f, s2 = 0.f, s3 = 0.f;
#pragma unroll 8
        for (int r = 0; r < 64; ++r) { const u32x2 w = *(const u32x2*)(p + (size_t)r * 1536); s0 += lo16(w.x); s1 += hi16(w.x); s2 += lo16(w.y); s3 += hi16(w.y); }
        s0 += __shfl_xor(s0, 16); s1 += __shfl_xor(s1, 16); s2 += __shfl_xor(s2, 16); s3 += __shfl_xor(s3, 16);
        s0 += __shfl_xor(s0, 32); s1 += __shfl_xor(s1, 32); s2 += __shfl_xor(s2, 32); s3 += __shfl_xor(s3, 32);
        if (rq == 0) { f32x4 o; o.x = s0 * (1.0f / 256.0f); o.y = s1 * (1.0f / 256.0f); o.z = s2 * (1.0f / 256.0f); o.w = s3 * (1.0f / 256.0f); *(f32x4*)(KMEAN + (size_t)it * 64 + 4 * d4) = o; }
    }
}
__device__ __forceinline__ void unpack8(const u32x4 w, float* f) { f[0] = lo16(w.x); f[1] = hi16(w.x); f[2] = lo16(w.y); f[3] = hi16(w.y); f[4] = lo16(w.z); f[5] = hi16(w.z); f[6] = lo16(w.w); f[7] = hi16(w.w); }
__device__ __forceinline__ void moba_naive(const Ctx& C, const bf16* PROJ, const float* KMEAN, bf16* MIX) {
    for (int idx = C.gtid; idx < 2 * 8 * SEQ; idx += C.nthr) {
        const int t = idx & (SEQ - 1), bh = idx >> 13, h = bh & 7, b = bh >> 3, row = b * SEQ + t, qb = t >> 8;
        float q[64];
        { const u32x4* qp = (const u32x4*)(PROJ + (size_t)row * 2048 + h * 64);
#pragma unroll
          for (int i = 0; i < 8; ++i) unpack8(qp[i], q + 8 * i); }
        float b0 = -INFINITY, b1 = -INFINITY, b2 = -INFINITY; int i0 = -1, i1 = -1, i2 = -1;
        const float* km = KMEAN + (size_t)bh * 32 * 64;
        for (int j = 0; j < qb; ++j) { float s = 0.f;
#pragma unroll
            for (int d = 0; d < 64; ++d) s += q[d] * km[j * 64 + d];
            if (s > b0) { b2 = b1; i2 = i1; b1 = b0; i1 = i0; b0 = s; i0 = j; } else if (s > b1) { b2 = b1; i2 = i1; b1 = s; i1 = j; } else if (s > b2) { b2 = s; i2 = j; } }
        float m = -INFINITY, l = 0.f, o[64];
#pragma unroll
        for (int d = 0; d < 64; ++d) o[d] = 0.f;
        for (int si = 0; si < 4; ++si) {
            const int blk = si == 0 ? i0 : si == 1 ? i1 : si == 2 ? i2 : qb;
            if (blk < 0) continue;
            const int nk = (si == 3) ? (t - qb * 256 + 1) : 256;
            const bf16* kp = PROJ + (size_t)(b * SEQ + blk * 256) * 2048 + 512 + h * 64;
            for (int kk = 0; kk < nk; ++kk) {
                const u32x4* kr = (const u32x4*)(kp + (size_t)kk * 2048); const u32x4* vr = (const u32x4*)(kp + (size_t)kk * 2048 + 512);
                float s = 0.f;
#pragma unroll
                for (int i = 0; i < 8; ++i) { float f[8]; unpack8(kr[i], f);
#pragma unroll
                    for (int e = 0; e < 8; ++e) s += q[8 * i + e] * f[e]; }
                s *= 0.125f;
                const float mn = fmaxf(m, s), corr = __expf(m - mn), p = __expf(s - mn);
                l = l * corr + p; m = mn;
#pragma unroll
                for (int i = 0; i < 8; ++i) { float f[8]; unpack8(vr[i], f);
#pragma unroll
                    for (int e = 0; e < 8; ++e) o[8 * i + e] = o[8 * i + e] * corr + p * f[e]; }
            }
        }
        const float il = 1.0f / l; u32x4* op = (u32x4*)(MIX + (size_t)row * 1024 + h * 64);
#pragma unroll
        for (int i = 0; i < 8; ++i) { u32x4 w; w.x = pk2(o[8 * i] * il, o[8 * i + 1] * il); w.y = pk2(o[8 * i + 2] * il, o[8 * i + 3] * il); w.z = pk2(o[8 * i + 4] * il, o[8 * i + 5] * il); w.w = pk2(o[8 * i + 6] * il, o[8 * i + 7] * il); op[i] = w; }
    }
}
__device__ __forceinline__ void pool_linear_naive(const Ctx& C, const bf16* POOLED, const float* pool_w, const float* pool_scale, bf16* MIX) {
    for (size_t idx = C.gtid; idx < (size_t)NT * 512; idx += C.nthr) {
        const int co = (int)(idx & 511), row = (int)(idx >> 9), g = co >> 7, d = co & 127;
        const bf16* pp = POOLED + (size_t)row * 512 + g * 128; const float* w = pool_w + (size_t)g * 128 * 128 + d; float s = 0.f;
        for (int c = 0; c < 128; ++c) s += bf2f(pp[c]) * w[(size_t)c * 128];
        MIX[(size_t)row * 1024 + 512 + co] = (bf16)f2bf(s * pool_scale[co]);
    }
}
__device__ __forceinline__ void xattn_naive(const Ctx& C, const bf16* QX, const bf16* KVX, bf16* OX) {
    LAS float* qs = (LAS float*)(C.lds + C.wave * 2048); LAS float* ps = qs + 256; const int lane = C.lane;
    for (int it = C.gw; it < NT * 4; it += C.ngw) {
        const int row = it >> 2, hd = it & 3, b = row >> 13;
        { const u32x2 w = *((const u32x2*)(QX + (size_t)row * 1024 + hd * 256) + lane); qs[4 * lane] = lo16(w.x); qs[4 * lane + 1] = hi16(w.x); qs[4 * lane + 2] = lo16(w.y); qs[4 * lane + 3] = hi16(w.y); }
        LDS_WAIT();
        float s[4];
#pragma unroll
        for (int i = 0; i < 4; ++i) { const int j = lane + 64 * i; const u32x4* kr = (const u32x4*)(KVX + (size_t)(b * NMEM + j) * 2048 + hd * 256); float acc = 0.f;
            for (int d8 = 0; d8 < 32; ++d8) { float f[8]; unpack8(kr[d8], f); const f32x4 qa = *(const LAS f32x4*)(qs + 8 * d8), qb = *(const LAS f32x4*)(qs + 8 * d8 + 4);
                acc += f[0] * qa.x + f[1] * qa.y + f[2] * qa.z + f[3] * qa.w + f[4] * qb.x + f[5] * qb.y + f[6] * qb.z + f[7] * qb.w; }
            s[i] = acc * 0.0625f; }
        const float mx = wave_max(fmaxf(fmaxf(s[0], s[1]), fmaxf(s[2], s[3])));
        float p[4], sum = 0.f;
#pragma unroll
        for (int i = 0; i < 4; ++i) { p[i] = __expf(s[i] - mx); sum += p[i]; }
        sum = wave_sum(sum); const float inv = 1.0f / sum;
#pragma unroll
        for (int i = 0; i < 4; ++i) ps[lane + 64 * i] = p[i] * inv;
        LDS_WAIT();
        float o0 = 0.f, o1 = 0.f, o2 = 0.f, o3 = 0.f; const bf16* vb = KVX + (size_t)(b * NMEM) * 2048 + 1024 + hd * 256 + 4 * lane;
        for (int j = 0; j < 256; ++j) { const float pj = ps[j]; const u32x2 w = *(const u32x2*)(vb + (size_t)j * 2048); o0 += pj * lo16(w.x); o1 += pj * hi16(w.x); o2 += pj * lo16(w.y); o3 += pj * hi16(w.y); }
        u32x2 w; w.x = pk2(o0, o1); w.y = pk2(o2, o3); *((u32x2*)(OX + (size_t)row * 1024 + hd * 256) + lane) = w;
        LDS_WAIT();
    }
}
__device__ __forceinline__ void ffn_act(const Ctx& C, const bf16* HUP, const float* cw, bf16* ACT, int hb) {
    for (int idx = C.gtid; idx < (SEQ / 8) * 352; idx += C.nthr) {
        const int c8 = idx % 352, rb = idx / 352, c = c8 * 8, t0 = rb * 8;
        float wg[3][8], wu[3][8];
#pragma unroll
        for (int k = 0; k < 3; ++k) { const f32x4 a0 = *(const f32x4*)(cw + (size_t)k * DFF2 + c), a1 = *(const f32x4*)(cw + (size_t)k * DFF2 + c + 4), b0 = *(const f32x4*)(cw + (size_t)k * DFF2 + DFF + c), b1 = *(const f32x4*)(cw + (size_t)k * DFF2 + DFF + c + 4);
            wg[k][0] = a0.x; wg[k][1] = a0.y; wg[k][2] = a0.z; wg[k][3] = a0.w; wg[k][4] = a1.x; wg[k][5] = a1.y; wg[k][6] = a1.z; wg[k][7] = a1.w;
            wu[k][0] = b0.x; wu[k][1] = b0.y; wu[k][2] = b0.z; wu[k][3] = b0.w; wu[k][4] = b1.x; wu[k][5] = b1.y; wu[k][6] = b1.z; wu[k][7] = b1.w; }
        float g0[8], g1[8], u0[8], u1[8];
        if (t0 >= 2) { unpack8(*(const u32x4*)(HUP + (size_t)(t0 - 2) * DFF2 + c), g0); unpack8(*(const u32x4*)(HUP + (size_t)(t0 - 2) * DFF2 + DFF + c), u0);
                       unpack8(*(const u32x4*)(HUP + (size_t)(t0 - 1) * DFF2 + c), g1); unpack8(*(const u32x4*)(HUP + (size_t)(t0 - 1) * DFF2 + DFF + c), u1); }
        else {
#pragma unroll
            for (int e = 0; e < 8; ++e) { g0[e] = 0.f; g1[e] = 0.f; u0[e] = 0.f; u1[e] = 0.f; } }
#pragma unroll
        for (int r = 0; r < 8; ++r) {
            float g2[8], u2[8]; unpack8(*(const u32x4*)(HUP + (size_t)(t0 + r) * DFF2 + c), g2); unpack8(*(const u32x4*)(HUP + (size_t)(t0 + r) * DFF2 + DFF + c), u2);
            float o[8];
#pragma unroll
            for (int e = 0; e < 8; ++e) { const float gv = wg[0][e] * g0[e] + wg[1][e] * g1[e] + wg[2][e] * g2[e], uv = wu[0][e] * u0[e] + wu[1][e] * u1[e] + wu[2][e] * u2[e]; o[e] = silu_f(gv) * uv; }
            u32x4 w; w.x = pk2(o[0], o[1]); w.y = pk2(o[2], o[3]); w.z = pk2(o[4], o[5]); w.w = pk2(o[6], o[7]);
            *(u32x4*)(ACT + (size_t)(hb * SEQ + t0 + r) * DFF + c) = w;
#pragma unroll
            for (int e = 0; e < 8; ++e) { g0[e] = g1[e]; g1[e] = g2[e]; u0[e] = u1[e]; u1[e] = u2[e]; }
        }
    }
}
__device__ __forceinline__ void l1_prep_naive(const Ctx& C, ArgsP a, const bf16* Z, const bf16* QKV, bf16* VN, bf16* QN, bf16* KN, bf16* VV) {
    const int lane = C.lane;
    const float* lng = INP(a, I_SGUG); const float* lnb = INP(a, I_SGUB); const float* cw = INP(a, I_DNCONV);
    for (int row = C.gw; row < NT; row += C.ngw) {
        float f[8]; unpack8(*((const u32x4*)(Z + (size_t)row * 1024 + 512) + lane), f);
        float s = 0.f;
#pragma unroll
        for (int e = 0; e < 8; ++e) s += f[e];
        const float mu = wave_sum(s) * (1.0f / 512.0f); float q = 0.f;
#pragma unroll
        for (int e = 0; e < 8; ++e) { f[e] -= mu; q += f[e] * f[e]; }
        const float rstd = 1.0f / sqrtf(wave_sum(q) * (1.0f / 512.0f) + EPS);
        const f32x4 g0 = *((const f32x4*)lng + 2 * lane), g1 = *((const f32x4*)lng + 2 * lane + 1), c0 = *((const f32x4*)lnb + 2 * lane), c1 = *((const f32x4*)lnb + 2 * lane + 1);
        u32x4 w; w.x = pk2(f[0] * rstd * g0.x + c0.x, f[1] * rstd * g0.y + c0.y); w.y = pk2(f[2] * rstd * g0.z + c0.z, f[3] * rstd * g0.w + c0.w);
        w.z = pk2(f[4] * rstd * g1.x + c1.x, f[5] * rstd * g1.y + c1.y); w.w = pk2(f[6] * rstd * g1.z + c1.z, f[7] * rstd * g1.w + c1.w);
        { bf16* vt = VN + ((size_t)(row >> 7) * 512 + 8 * lane) * 128 + (row & 127);
          vt[0] = (bf16)(w.x & 0xffffu); vt[128] = (bf16)(w.x >> 16); vt[256] = (bf16)(w.y & 0xffffu); vt[384] = (bf16)(w.y >> 16);
          vt[512] = (bf16)(w.z & 0xffffu); vt[640] = (bf16)(w.z >> 16); vt[768] = (bf16)(w.w & 0xffffu); vt[896] = (bf16)(w.w >> 16); }
    }
    for (int it = C.gw; it < NT * 4; it += C.ngw) {
        const int row = it >> 2, hh = it & 3, tl = row & (SEQ - 1), c = hh * 128 + 2 * lane;
        float y[3][2];
#pragma unroll
        for (int s3 = 0; s3 < 3; ++s3) { const int cs = s3 * 512 + c; float a0 = 0.f, a1 = 0.f;
#pragma unroll
            for (int j = 0; j < 4; ++j) { const int ts = tl - 3 + j; if (ts < 0) continue;
                const unsigned w = *(const unsigned*)(QKV + (size_t)(row - 3 + j) * 1536 + cs); a0 += cw[j * 1536 + cs] * lo16(w); a1 += cw[j * 1536 + cs + 1] * hi16(w); }
            y[s3][0] = silu_f(a0); y[s3][1] = silu_f(a1); }
        const float rq = 1.0f / sqrtf(wave_sum(y[0][0] * y[0][0] + y[0][1] * y[0][1]) + EPS) * 0.08838834764831845f;
        const float rk = 1.0f / sqrtf(wave_sum(y[1][0] * y[1][0] + y[1][1] * y[1][1]) + EPS);
        *(unsigned*)(QN + (size_t)row * 512 + c) = pk2(y[0][0] * rq, y[0][1] * rq);
        *(unsigned*)(KN + (size_t)row * 512 + c) = pk2(y[1][0] * rk, y[1][1] * rk);
        *(unsigned*)(VV + (size_t)row * 512 + c) = pk2(y[2][0], y[2][1]);
    }
}
__device__ __forceinline__ void sgu_naive(const Ctx& C, ArgsP a, const bf16* Z, const bf16* VN, bf16* MIX, int blk0, int nblk) {
    const float* sw = INP(a, I_SGUW); const float* sb = INP(a, I_SGUBS);
    const size_t start = (size_t)(blockIdx.x - blk0) * 512 + C.tid, stride = (size_t)nblk * 512;
    for (size_t idx = start; idx < (size_t)NT * 512; idx += stride) {
        const int ch = (int)(idx & 511), row = (int)(idx >> 9), g = ch >> 7, tl = row & 127, r0 = row & ~127;
        const float* w = sw + (size_t)(g * 128 + tl) * 128; const bf16* vp = VN + (size_t)r0 * 512 + ch; float s = 0.f;
        for (int k = 0; k <= tl; ++k) s += w[k] * bf2f(vp[(size_t)k * 512]);
        s += sb[g * 128 + tl];
        MIX[(size_t)row * 1024 + ch] = (bf16)f2bf(bf2f(Z[(size_t)row * 1024 + ch]) * s);
    }
}
__device__ __forceinline__ void dn_recurrent(const Ctx& C, const bf16* QN, const bf16* KN, const bf16* VV, const float* BG, float* O, int bh) {
    const int b = bh >> 2, hh = bh & 3, dv = C.tid & 127, g4 = C.tid >> 7;
    LAS float* red1 = (LAS float*)C.lds; LAS float* red2 = red1 + 512;
    float S[32];
#pragma unroll
    for (int i = 0; i < 32; ++i) S[i] = 0.f;
    for (int t = 0; t < SEQ; ++t) {
        const size_t row = (size_t)b * SEQ + t;
        const u32x4* kp = (const u32x4*)(KN + row * 512 + hh * 128 + 32 * g4); const u32x4* qp = (const u32x4*)(QN + row * 512 + hh * 128 + 32 * g4);
        float kk[32], qq[32];
#pragma unroll
        for (int i = 0; i < 4; ++i) { unpack8(kp[i], kk + 8 * i); unpack8(qp[i], qq + 8 * i); }
        const float vv = bf2f(VV[row * 512 + hh * 128 + dv]), beta = BG[row * 8 + hh], av = __expf(BG[row * 8 + 4 + hh]);
        float part = 0.f;
#pragma unroll
        for (int i = 0; i < 32; ++i) part += kk[i] * S[i];
        red1[g4 * 128 + dv] = part; __syncthreads();
        const float kS = (red1[dv] + red1[128 + dv]) + (red1[256 + dv] + red1[384 + dv]);
        const float vnew = beta * (vv - av * kS);
        float op = 0.f;
#pragma unroll
        for (int i = 0; i < 32; ++i) { S[i] = av * S[i] + kk[i] * vnew; op += qq[i] * S[i]; }
        red2[g4 * 128 + dv] = op; __syncthreads();
        if (g4 == 0) O[row * 512 + hh * 128 + dv] = (red2[dv] + red2[128 + dv]) + (red2[256 + dv] + red2[384 + dv]);
    }
    __syncthreads();
}
__device__ __forceinline__ void dn_out_gate(const Ctx& C, ArgsP a, const float* O, const bf16* GATE, bf16* MIX) {
    const float* ng = INP(a, I_DNNG); const int lane = C.lane;
    const f32x4 n0 = *(const f32x4*)(ng + ((8 * lane) & 127)), n1 = *(const f32x4*)(ng + ((8 * lane) & 127) + 4);
    for (int row = C.gw; row < NT; row += C.ngw) {
        const f32x4 o0 = *((const f32x4*)(O + (size_t)row * 512) + 2 * lane), o1 = *((const f32x4*)(O + (size_t)row * 512) + 2 * lane + 1);
        float ss = ((o0.x * o0.x + o0.y * o0.y) + (o0.z * o0.z + o0.w * o0.w)) + ((o1.x * o1.x + o1.y * o1.y) + (o1.z * o1.z + o1.w * o1.w));
        ss += __shfl_xor(ss, 1); ss += __shfl_xor(ss, 2); ss += __shfl_xor(ss, 4); ss += __shfl_xor(ss, 8);
        const float r = 1.0f / sqrtf(ss * (1.0f / 128.0f) + EPS);
        float g[8]; unpack8(*((const u32x4*)(GATE + (size_t)row * 512) + lane), g);
        u32x4 w; w.x = pk2(o0.x * r * n0.x * silu_f(g[0]), o0.y * r * n0.y * silu_f(g[1])); w.y = pk2(o0.z * r * n0.z * silu_f(g[2]), o0.w * r * n0.w * silu_f(g[3]));
        w.z = pk2(o1.x * r * n1.x * silu_f(g[4]), o1.y * r * n1.y * silu_f(g[5])); w.w = pk2(o1.z * r * n1.z * silu_f(g[6]), o1.w * r * n1.w * silu_f(g[7]));
        *((u32x4*)(MIX + (size_t)row * 1024 + 512) + lane) = w;
    }
}
typedef short bf16x8 __attribute__((ext_vector_type(8)));
#define MFMA16(a, b, c) __builtin_amdgcn_mfma_f32_16x16x32_bf16((a), (b), (c), 0, 0, 0)
__device__ __forceinline__ float rdlane(float v, int i) { return __uint_as_float(__builtin_amdgcn_readlane(__float_as_uint(v), i)); }
#define WG_BAR() do { asm volatile("s_waitcnt vmcnt(0) lgkmcnt(0)" ::: "memory"); __builtin_amdgcn_s_barrier(); asm volatile("" ::: "memory"); } while (0)
#define LDS_BAR() do { asm volatile("s_waitcnt lgkmcnt(0)" ::: "memory"); __builtin_amdgcn_s_barrier(); asm volatile("" ::: "memory"); } while (0)

#define FRAG_W(i, k)  (((((i) >> 4) * 4 + ((k) >> 5)) * 64 + (((k) >> 3) & 3) * 16 + ((i) & 15)) * 8 + ((k) & 7))
#define FRAG_QK(i, j) (((((i) >> 4) * 2 + ((j) >> 5)) * 64 + (((j) >> 3) & 3) * 16 + ((i) & 15)) * 8 + ((j) & 7))
#define FRAG_KD(d, t) ((((((d) >> 5) * 2 + (((d) >> 4) & 1)) * 2 + ((t) >> 5)) * 64 + (((t) >> 3) & 3) * 16 + ((d) & 15)) * 8 + ((t) & 7))
#define FRAG_U(i, v)  (((((v) >> 4) * 4 + ((i) >> 4)) * 64 + (((i) >> 2) & 3) * 16 + ((v) & 15)) * 4 + ((i) & 3))
__device__ __forceinline__ void dn_chunk_prep(const Ctx& C, const bf16* QN, const bf16* KN, const bf16* VV, const float* BG, bf16* U, bf16* Wm, bf16* QD, bf16* KDT, bf16* QKm, float* GL) {
    LAS float* Am = (LAS float*)(C.lds + C.wave * 16384);
    const int lane = C.lane, fr = lane & 15, fq = lane >> 4;
    for (int it4 = C.gw; it4 < 4096; it4 += C.ngw) {
        const int it = it4 >> 2, ps = it4 & 3;
        const int n = it & 127, hh = (it >> 7) & 3, b = it >> 9;
        const size_t row0 = (size_t)b * SEQ + (size_t)n * 64;
        const float beta = BG[(row0 + lane) * 8 + hh], gg = BG[(row0 + lane) * 8 + 4 + hh];
        float gc = gg;
#pragma unroll
        for (int o = 1; o < 64; o <<= 1) { const float t = __shfl_up(gc, o); if (lane >= o) gc += t; }
        const float gcl = rdlane(gc, 63);
        const bf16* Kb = KN + row0 * 512 + hh * 128; const bf16* Qb = QN + row0 * 512 + hh * 128; const bf16* Vb = VV + row0 * 512 + hh * 128;
        bf16* qkm = QKm + (size_t)it * 4096;
#pragma unroll 1
        for (int mt = 0; mt < 4; ++mt) {
            bf16x8 ak[4], aq[4];
#pragma unroll
            for (int ks = 0; ks < 4; ++ks) { ak[ks] = *(const bf16x8*)(Kb + (size_t)(16 * mt + fr) * 512 + 32 * ks + 8 * fq); aq[ks] = *(const bf16x8*)(Qb + (size_t)(16 * mt + fr) * 512 + 32 * ks + 8 * fq); }
#pragma unroll 1
            for (int nt = 0; nt < 4; ++nt) {
                const int j = 16 * nt + fr;
                if (nt > mt) {
                    if (ps == 0) {
#pragma unroll
                        for (int r = 0; r < 4; ++r) qkm[FRAG_QK(16 * mt + 4 * fq + r, j)] = 0; }
                    continue;
                }
                f32x4 ckk = {0.f, 0.f, 0.f, 0.f}, cqk = {0.f, 0.f, 0.f, 0.f};
#pragma unroll
                for (int ks = 0; ks < 4; ++ks) { const bf16x8 bk = *(const bf16x8*)(Kb + (size_t)(16 * nt + fr) * 512 + 32 * ks + 8 * fq); ckk = MFMA16(ak[ks], bk, ckk); cqk = MFMA16(aq[ks], bk, cqk); }
                const float gj = __shfl(gc, j);
#pragma unroll
                for (int r = 0; r < 4; ++r) { const int i = 16 * mt + 4 * fq + r; const float gi = __shfl(gc, i), bi = __shfl(beta, i);
                    const float dec = (i >= j) ? __expf(gi - gj) : 0.f;
                    Am[i * 64 + j] = (i > j) ? bi * ckk[r] * dec : 0.f;
                    if (ps == 0) qkm[FRAG_QK(i, j)] = (bf16)f2bf((i >= j) ? cqk[r] * dec : 0.f); }
            }
        }
        LDS_WAIT();
        { const int p = ps;
            const int c = lane + 64 * (p & 1); const bf16* src = (p < 2 ? Vb : Kb) + c; bf16* dstb = (p < 2 ? U : Wm) + (size_t)it * 8192;
            float x[64];
#pragma unroll
            for (int i = 0; i < 64; ++i) { const float bi = rdlane(beta, i), gi = rdlane(gc, i); x[i] = bf2f(src[(size_t)i * 512]) * (p < 2 ? bi : bi * __expf(gi)); if ((i & 7) == 7) __builtin_amdgcn_sched_barrier(0); }
            float Ar[64];
#pragma unroll
            for (int i = 1; i < 64; ++i) Ar[i] = Am[i * 64 + lane];
            LDS_WAIT();
#pragma unroll
            for (int i = 1; i < 64; ++i) {
                float acc = x[i];
#pragma unroll
                for (int j = 0; j < i; ++j) acc -= rdlane(Ar[i], j) * x[j];
                x[i] = acc;
            }
#pragma unroll
            for (int i = 0; i < 64; ++i) dstb[p < 2 ? FRAG_U(i, c) : FRAG_W(i, c)] = (bf16)f2bf(x[i]);
        }
        bf16* qd = QD + (size_t)it * 8192;
        if (ps == 1)
#pragma unroll 4
        for (int i = 0; i < 64; ++i) { const float e = __expf(__shfl(gc, i)); const unsigned w = *(const unsigned*)(Qb + (size_t)i * 512 + 2 * lane); *(unsigned*)(qd + FRAG_W(i, 2 * lane)) = pk2(lo16(w) * e, hi16(w) * e); }
        bf16* kdt = KDT + (size_t)it * 8192; const float ek = __expf(gcl - gc);
        if (ps == 2)
#pragma unroll 2
        for (int d8 = 0; d8 < 16; ++d8) { float f[8]; unpack8(*(const u32x4*)(Kb + (size_t)lane * 512 + 8 * d8), f);
#pragma unroll
            for (int e = 0; e < 8; ++e) kdt[FRAG_KD(8 * d8 + e, lane)] = (bf16)f2bf(f[e] * ek); }
        if (ps == 3 && lane == 0) GL[it] = __expf(gcl);
        LDS_WAIT();
    }
}
constexpr int SB_LD = 136, VN_LD = 72;
__device__ __forceinline__ void dn_scan(const Ctx& C, const bf16* U, const bf16* Wm, const bf16* QD, const bf16* KDT, const bf16* QKm, const float* GL, float* O, int it) {
    const int bh = it & 7, sl = it >> 3, hh = bh & 3, b = bh >> 2, dv0 = sl * 16;
    LAS bf16* SbT = (LAS bf16*)C.lds;
    LAS bf16* VnT = (LAS bf16*)(C.lds + 16384);
    LAS float* glb = (LAS float*)(C.lds + 24576);
    for (int i = C.tid; i < 2 * 16 * SB_LD / 2; i += 512) ((LAS unsigned*)SbT)[i] = 0u;
    if (C.tid < 128) glb[C.tid] = GL[(size_t)(it & 7) * 128 + C.tid];
    __syncthreads();
    const int w = C.wave, lane = C.lane, fr = lane & 15, fq = lane >> 4;
    f32x4 S0 = {0.f, 0.f, 0.f, 0.f}, S1 = S0;
    const size_t item0 = (size_t)bh * 128;
    if (w < 4) {
        bf16x8 cw[4][4], ck[4][4]; float cu[4][4];
#define DN_LOAD_A(set, st) do { const size_t it_ = item0 + (st); \
            const bf16* wp_ = Wm + it_ * 8192 + (size_t)(w * 4 * 64 + lane) * 8; const bf16* up_ = U + it_ * 8192 + (size_t)((sl * 4 + w) * 64 + lane) * 4; const bf16* kp_ = KDT + it_ * 8192 + (size_t)(w * 4 * 64 + lane) * 8; \
            _Pragma("unroll") for (int ks = 0; ks < 4; ++ks) cw[set][ks] = *(const bf16x8*)(wp_ + 512 * ks); \
            { const u32x2 uw_ = *(const u32x2*)up_; cu[set][0] = lo16(uw_.x); cu[set][1] = hi16(uw_.x); cu[set][2] = lo16(uw_.y); cu[set][3] = hi16(uw_.y); } \
            ck[set][0] = *(const bf16x8*)(kp_); ck[set][1] = *(const bf16x8*)(kp_ + 512); ck[set][2] = *(const bf16x8*)(kp_ + 1024); ck[set][3] = *(const bf16x8*)(kp_ + 1536); } while (0)
        DN_LOAD_A(0, 0); DN_LOAD_A(1, 1); DN_LOAD_A(2, 2);
        for (int n0 = 0; n0 < 128; n0 += 4) {
#pragma unroll
            for (int k = 0; k < 4; ++k) {
                const int n = n0 + k, ns = (n + 3 < 128) ? n + 3 : 127;
                DN_LOAD_A((k + 3) & 3, ns);
                LAS bf16* Sc = SbT + (k & 1) * 16 * SB_LD; LAS bf16* Sn = SbT + ((k & 1) ^ 1) * 16 * SB_LD;
                f32x4 t1 = {0.f, 0.f, 0.f, 0.f};
                { bf16x8 sb[4];
#pragma unroll
                  for (int ks = 0; ks < 4; ++ks) sb[ks] = *(const LAS bf16x8*)(Sc + fr * SB_LD + 32 * ks + 8 * fq);
                  __builtin_amdgcn_sched_barrier(0);
#pragma unroll
                  for (int ks = 0; ks < 4; ++ks) t1 = MFMA16(cw[k][ks], sb[ks], t1); }
                u32x2 pw; pw.x = pk2(cu[k][0] - t1[0], cu[k][1] - t1[1]); pw.y = pk2(cu[k][2] - t1[2], cu[k][3] - t1[3]);
                *(LAS u32x2*)(VnT + fr * VN_LD + 16 * w + 4 * fq) = pw;
                LDS_BAR();
                bf16x8 vb[2];
                { const float gl = glb[n]; S0 = S0 * gl; S1 = S1 * gl; }
#pragma unroll
                for (int ks = 0; ks < 2; ++ks) vb[ks] = *(const LAS bf16x8*)(VnT + fr * VN_LD + 32 * ks + 8 * fq);
                __builtin_amdgcn_sched_barrier(0);
#pragma unroll
                for (int ks = 0; ks < 2; ++ks) { S0 = MFMA16(ck[k][ks], vb[ks], S0); S1 = MFMA16(ck[k][2 + ks], vb[ks], S1); }
                u32x2 s0; s0.x = pk2(S0[0], S0[1]); s0.y = pk2(S0[2], S0[3]); u32x2 s1; s1.x = pk2(S1[0], S1[1]); s1.y = pk2(S1[2], S1[3]);
                *(LAS u32x2*)(Sn + fr * SB_LD + 32 * w + 4 * fq) = s0; *(LAS u32x2*)(Sn + fr * SB_LD + 32 * w + 16 + 4 * fq) = s1;
                LDS_BAR();
            }
        }
#undef DN_LOAD_A
    } else {
        const int w2 = w - 4;
        bf16x8 cq[4][4], cm[4][2];
#define DN_LOAD_B(set, st) do { const size_t it_ = item0 + (st); const bf16* qp_ = QD + it_ * 8192 + (size_t)(w2 * 4 * 64 + lane) * 8; const bf16* mp_ = QKm + it_ * 4096 + (size_t)(w2 * 2 * 64 + lane) * 8; \
            _Pragma("unroll") for (int ks = 0; ks < 4; ++ks) cq[set][ks] = *(const bf16x8*)(qp_ + 512 * ks); \
            cm[set][0] = *(const bf16x8*)(mp_); cm[set][1] = *(const bf16x8*)(mp_ + 512); } while (0)
        DN_LOAD_B(0, 0); DN_LOAD_B(1, 1); DN_LOAD_B(2, 2);
        for (int n0 = 0; n0 < 128; n0 += 4) {
#pragma unroll
            for (int k = 0; k < 4; ++k) {
                const int n = n0 + k, ns = (n + 3 < 128) ? n + 3 : 127;
                DN_LOAD_B((k + 3) & 3, ns);
                LAS bf16* Sc = SbT + (k & 1) * 16 * SB_LD;
                f32x4 o = {0.f, 0.f, 0.f, 0.f};
                { bf16x8 sb[4];
#pragma unroll
                  for (int ks = 0; ks < 4; ++ks) sb[ks] = *(const LAS bf16x8*)(Sc + fr * SB_LD + 32 * ks + 8 * fq);
                  __builtin_amdgcn_sched_barrier(0);
#pragma unroll
                  for (int ks = 0; ks < 4; ++ks) o = MFMA16(cq[k][ks], sb[ks], o); }
                LDS_BAR();
                o = MFMA16(cm[k][0], *(const LAS bf16x8*)(VnT + fr * VN_LD + 8 * fq), o);
                o = MFMA16(cm[k][1], *(const LAS bf16x8*)(VnT + fr * VN_LD + 32 + 8 * fq), o);
                float* op = O + ((size_t)b * SEQ + (size_t)n * 64 + 16 * w2 + 4 * fq) * 512 + hh * 128 + dv0 + fr;
                op[0] = o[0]; op[512] = o[1]; op[1024] = o[2]; op[1536] = o[3];
                LDS_BAR();
            }
        }
#undef DN_LOAD_B
    }
    __syncthreads();
}
__device__ __forceinline__ int perm32k_inv(int s) { return (s < 16) ? (8 * (s >> 2) + (s & 3)) : (8 * ((s - 16) >> 2) + 4 + (s & 3)); }
__device__ __forceinline__ bf16x8 pack_p(const f32x4 a, const f32x4 b) { u32x4 w; w.x = pk2(a[0], a[1]); w.y = pk2(a[2], a[3]); w.z = pk2(b[0], b[1]); w.w = pk2(b[2], b[3]); return __builtin_bit_cast(bf16x8, w); }

__device__ __forceinline__ void xattn_mfma(const Ctx& C, const bf16* QX, const bf16* KX, const bf16* VXT, bf16* OX) {
    const int lane = C.lane, fr = lane & 15, fq = lane >> 4;
    for (int it = C.gw; it < (NT / 16) * 4; it += C.ngw) {
        const int hd = it & 3, qt = it >> 2, row0 = qt * 16, b = row0 >> 13;
        bf16x8 qf[8];
        const bf16* qp = QX + (size_t)(row0 + fr) * 1024 + hd * 256 + 8 * fq;
#pragma unroll
        for (int ks = 0; ks < 8; ++ks) qf[ks] = *(const bf16x8*)(qp + 32 * ks);
        f32x4 st[16];
        const bf16* kp = KX + (size_t)(b * NMEM + fr) * 1024 + hd * 256 + 8 * fq;
#pragma unroll
        for (int kt = 0; kt < 16; ++kt) { f32x4 acc = {0.f, 0.f, 0.f, 0.f};
#pragma unroll
            for (int ks = 0; ks < 8; ++ks) acc = MFMA16(*(const bf16x8*)(kp + (size_t)kt * 16 * 1024 + 32 * ks), qf[ks], acc);
            st[kt] = acc; }
        float mx = -INFINITY;
#pragma unroll
        for (int kt = 0; kt < 16; ++kt) mx = fmaxf(mx, fmaxf(fmaxf(st[kt][0], st[kt][1]), fmaxf(st[kt][2], st[kt][3])));
        mx = fmaxf(mx, __shfl_xor(mx, 16)); mx = fmaxf(mx, __shfl_xor(mx, 32));
        float sum = 0.f; const float mxs = mx * 0.0625f;
#pragma unroll
        for (int kt = 0; kt < 16; ++kt) {
#pragma unroll
            for (int r = 0; r < 4; ++r) { const float p = __expf(st[kt][r] * 0.0625f - mxs); st[kt][r] = p; sum += p; } }
        sum += __shfl_xor(sum, 16); sum += __shfl_xor(sum, 32);
        const float inv = 1.0f / sum;
        bf16x8 pf[8];
#pragma unroll
        for (int kk = 0; kk < 8; ++kk) pf[kk] = pack_p(st[2 * kk], st[2 * kk + 1]);
        const bf16* vp = VXT + (size_t)(hd * 256 + fr) * 512 + b * NMEM + 8 * fq;
        bf16* op = OX + (size_t)(row0 + fr) * 1024 + hd * 256 + 4 * fq;
#pragma unroll 4
        for (int dt = 0; dt < 16; ++dt) { f32x4 acc = {0.f, 0.f, 0.f, 0.f};
#pragma unroll
            for (int kk = 0; kk < 8; ++kk) acc = MFMA16(*(const bf16x8*)(vp + (size_t)dt * 16 * 512 + 32 * kk), pf[kk], acc);
            u32x2 w; w.x = pk2(acc[0] * inv, acc[1] * inv); w.y = pk2(acc[2] * inv, acc[3] * inv);
            *(u32x2*)(op + 16 * dt) = w; }
    }
}

__device__ __forceinline__ void moba_item(const bf16* PQ, const bf16* VT, const float* KMEAN, bf16* MIX, int bh, int tile, int lane) {
    const int fr = lane & 15, fq = lane >> 4, h = bh & 7, b = bh >> 3, qb = tile >> 3;
    const int row0 = b * SEQ + tile * 32;
    unsigned mask = 0u;
    if (qb > 0) {
        float q[64];
        { const u32x4* qp = (const u32x4*)(PQ + (size_t)(row0 + (lane & 31)) * 1536 + h * 64);
#pragma unroll
          for (int i = 0; i < 8; ++i) unpack8(qp[i], q + 8 * i); }
        float b0 = -INFINITY, b1 = -INFINITY, b2 = -INFINITY; int i0 = -1, i1 = -1, i2 = -1;
        const float* km = KMEAN + (size_t)bh * 32 * 64;
        for (int j = 0; j < qb; ++j) { float s = 0.f;
#pragma unroll
            for (int d = 0; d < 64; ++d) s += q[d] * km[j * 64 + d];
            if (s > b0) { b2 = b1; i2 = i1; b1 = b0; i1 = i0; b0 = s; i0 = j; } else if (s > b1) { b2 = b1; i2 = i1; b1 = s; i1 = j; } else if (s > b2) { b2 = s; i2 = j; } }
        if (i0 >= 0) mask |= 1u << i0; if (i1 >= 0) mask |= 1u << i1; if (i2 >= 0) mask |= 1u << i2;
    }
    const unsigned m0 = (unsigned)__shfl((int)mask, fr), m1 = (unsigned)__shfl((int)mask, 16 + fr);
    bf16x8 qf[2][2];
#pragma unroll
    for (int qt = 0; qt < 2; ++qt)
#pragma unroll
        for (int ks = 0; ks < 2; ++ks) qf[qt][ks] = *(const bf16x8*)(PQ + (size_t)(row0 + 16 * qt + fr) * 1536 + h * 64 + 32 * ks + 8 * fq);
    f32x4 oacc[2][4];
#pragma unroll
    for (int qt = 0; qt < 2; ++qt)
#pragma unroll
        for (int dt = 0; dt < 4; ++dt) oacc[qt][dt] = (f32x4){0.f, 0.f, 0.f, 0.f};
    float mrow[2] = {-INFINITY, -INFINITY}, lrow[2] = {0.f, 0.f};
    const int qoff0 = (tile & 7) * 32;
    for (int bi = 0; bi <= qb; ++bi) {
        const int blk = (bi == 0) ? qb : bi - 1; const bool own = (bi == 0);
        if (!own && !__any((int)(((m0 | m1) >> blk) & 1u))) continue;
        const bool s0 = own || ((m0 >> blk) & 1u), s1 = own || ((m1 >> blk) & 1u);
        for (int hf = 0; hf < 2; ++hf) {
            if (own && hf * 128 > qoff0 + 31) continue;
            const int key0 = b * SEQ + blk * 256 + hf * 128;
            f32x4 st[2][8];
            const bf16* kp = PQ + (size_t)(key0 + fr) * 1536 + 512 + h * 64 + 8 * fq;
#pragma unroll
            for (int kt = 0; kt < 8; ++kt) { const bf16x8 k0 = *(const bf16x8*)(kp + (size_t)kt * 16 * 1536), k1 = *(const bf16x8*)(kp + (size_t)kt * 16 * 1536 + 32);
#pragma unroll
                for (int qt = 0; qt < 2; ++qt) { f32x4 acc = {0.f, 0.f, 0.f, 0.f}; acc = MFMA16(k0, qf[qt][0], acc); acc = MFMA16(k1, qf[qt][1], acc); st[qt][kt] = acc; } }
            bf16x8 pf[2][4];
#pragma unroll
            for (int qt = 0; qt < 2; ++qt) {
                const bool sel = qt == 0 ? s0 : s1; const int qoff = qoff0 + 16 * qt + fr;
                float mx = -INFINITY;
#pragma unroll
                for (int kt = 0; kt < 8; ++kt)
#pragma unroll
                    for (int r = 0; r < 4; ++r) { float s = st[qt][kt][r] * 0.125f; const int kin = hf * 128 + 16 * kt + 4 * fq + r;
                        if (!sel || (own && kin > qoff)) s = -INFINITY; st[qt][kt][r] = s; mx = fmaxf(mx, s); }
                mx = fmaxf(mx, __shfl_xor(mx, 16)); mx = fmaxf(mx, __shfl_xor(mx, 32));
                const float mn = fmaxf(mrow[qt], mx);
                const float corr = __expf(mrow[qt] - mn); mrow[qt] = mn;
                float ps = 0.f;
#pragma unroll
                for (int kt = 0; kt < 8; ++kt)
#pragma unroll
                    for (int r = 0; r < 4; ++r) { const float p = __expf(st[qt][kt][r] - mn); st[qt][kt][r] = p; ps += p; }
                lrow[qt] = lrow[qt] * corr + ps;
#pragma unroll
                for (int dt = 0; dt < 4; ++dt) oacc[qt][dt] = oacc[qt][dt] * corr;
#pragma unroll
                for (int kk = 0; kk < 4; ++kk) pf[qt][kk] = pack_p(st[qt][2 * kk], st[qt][2 * kk + 1]);
            }
            const bf16* vp = VT + (size_t)(h * 64 + fr) * NT + key0 + 8 * fq;
#pragma unroll
            for (int dt = 0; dt < 4; ++dt)
#pragma unroll
                for (int kk = 0; kk < 4; ++kk) { const bf16x8 vf = *(const bf16x8*)(vp + (size_t)dt * 16 * NT + 32 * kk);
                    oacc[0][dt] = MFMA16(vf, pf[0][kk], oacc[0][dt]); oacc[1][dt] = MFMA16(vf, pf[1][kk], oacc[1][dt]); }
        }
    }
#pragma unroll
    for (int qt = 0; qt < 2; ++qt) {
        float l = lrow[qt]; l += __shfl_xor(l, 16); l += __shfl_xor(l, 32); const float inv = 1.0f / l;
        bf16* op = MIX + (size_t)(row0 + 16 * qt + fr) * 1024 + h * 64 + 4 * fq;
#pragma unroll
        for (int dt = 0; dt < 4; ++dt) { u32x2 w; w.x = pk2(oacc[qt][dt][0] * inv, oacc[qt][dt][1] * inv); w.y = pk2(oacc[qt][dt][2] * inv, oacc[qt][dt][3] * inv); *(u32x2*)(op + 16 * dt) = w; }
    }
}
__device__ __forceinline__ void moba_mfma(const Ctx& C, const bf16* PQ, const bf16* VT, const float* KMEAN, bf16* MIX) {
    for (int pi = C.gw; pi < 2048; pi += C.ngw) {
        const int bh = pi >> 7, pp = pi & 127;
        moba_item(PQ, VT, KMEAN, MIX, bh, pp, C.lane);
        moba_item(PQ, VT, KMEAN, MIX, bh, 255 - pp, C.lane);
    }
}
__device__ __forceinline__ void pool_mfma(const Ctx& C, const bf16* PQ, const bf16* PWT, const float* pool_scale, bf16* MIX) {
    const int lane = C.lane, fr = lane & 15, fq = lane >> 4;
    for (int it = C.gw; it < (NT / 16) * 4; it += C.ngw) {
        const int g = it & 3, tt = it >> 2, row = tt * 16 + fr, tl = row & (SEQ - 1), w = 2 << g;
        const int cnt = (tl + 1 < w) ? tl + 1 : w; const float icnt = 1.0f / (float)cnt;
        bf16x8 bfr[4];
#pragma unroll
        for (int ks = 0; ks < 4; ++ks) {
            const bf16* p = PQ + (size_t)row * 1536 + 1024 + g * 128 + 32 * ks + 8 * fq;
            float cur[8], s[8]; unpack8(*(const u32x4*)p, cur);
#pragma unroll
            for (int e = 0; e < 8; ++e) s[e] = cur[e];
            for (int i = 1; i < cnt; ++i) { float f[8]; unpack8(*(const u32x4*)(p - (size_t)i * 1536), f);
#pragma unroll
                for (int e = 0; e < 8; ++e) s[e] += f[e]; }
            u32x4 wv; wv.x = pk2(s[0] * icnt - cur[0], s[1] * icnt - cur[1]); wv.y = pk2(s[2] * icnt - cur[2], s[3] * icnt - cur[3]);
            wv.z = pk2(s[4] * icnt - cur[4], s[5] * icnt - cur[5]); wv.w = pk2(s[6] * icnt - cur[6], s[7] * icnt - cur[7]);
            bfr[ks] = __builtin_bit_cast(bf16x8, wv);
        }
        const bf16* ap = PWT + (size_t)g * 128 * 128 + (size_t)fr * 128 + 8 * fq;
        bf16* op = MIX + (size_t)row * 1024 + 512 + g * 128 + 4 * fq; const float* sp = pool_scale + g * 128 + 4 * fq;
#pragma unroll 2
        for (int dt = 0; dt < 8; ++dt) { f32x4 acc = {0.f, 0.f, 0.f, 0.f};
#pragma unroll
            for (int ks = 0; ks < 4; ++ks) acc = MFMA16(*(const bf16x8*)(ap + (size_t)dt * 16 * 128 + 32 * ks), bfr[ks], acc);
            const f32x4 sc = *(const f32x4*)(sp + 16 * dt);
            u32x2 wv; wv.x = pk2(acc[0] * sc.x, acc[1] * sc.y); wv.y = pk2(acc[2] * sc.z, acc[3] * sc.w); *(u32x2*)(op + 16 * dt) = wv; }
    }
}
__device__ __forceinline__ void sgu_mfma(const Ctx& C, const bf16* Z, const bf16* VNT, const bf16* Wb, const float* sgu_b, bf16* MIX, int gw0, int ngw0) {
    const int lane = C.lane, fr = lane & 15, fq = lane >> 4;
    for (int it = gw0; it < 128 * 4 * 8; it += ngw0) {
        const int tt = it & 7, g = (it >> 3) & 3, n = it >> 5, nks = (tt >> 1) + 1;
        const int row = n * 128 + tt * 16 + fr;
        bf16x8 bfr[4];
#pragma unroll
        for (int ks = 0; ks < 4; ++ks) bfr[ks] = (ks < nks) ? *(const bf16x8*)(Wb + (size_t)(g * 128 + tt * 16 + fr) * 128 + 32 * ks + 8 * fq) : (bf16x8){0, 0, 0, 0, 0, 0, 0, 0};
        const float bias = sgu_b[g * 128 + tt * 16 + fr];
        const bf16* ap = VNT + ((size_t)n * 512 + g * 128 + fr) * 128 + 8 * fq;
        const bf16* up = Z + (size_t)row * 1024 + g * 128 + 4 * fq; bf16* op = MIX + (size_t)row * 1024 + g * 128 + 4 * fq;
#pragma unroll 2
        for (int ct = 0; ct < 8; ++ct) { f32x4 acc = {0.f, 0.f, 0.f, 0.f};
#pragma unroll
            for (int ks = 0; ks < 4; ++ks) if (ks < nks) acc = MFMA16(*(const bf16x8*)(ap + (size_t)ct * 16 * 128 + 32 * ks), bfr[ks], acc);
            const u32x2 uw = *(const u32x2*)(up + 16 * ct);
            u32x2 wv; wv.x = pk2(lo16(uw.x) * (acc[0] + bias), hi16(uw.x) * (acc[1] + bias)); wv.y = pk2(lo16(uw.y) * (acc[2] + bias), hi16(uw.y) * (acc[3] + bias)); *(u32x2*)(op + 16 * ct) = wv; }
    }
}
__device__ __forceinline__ void sgu_w_convert(const Ctx& C, const float* sw, bf16* Wb) {
    for (int idx = C.gtid; idx < 4 * 128 * 128; idx += C.nthr) { const int s = idx & 127, t = (idx >> 7) & 127; Wb[idx] = (bf16)((s <= t) ? f2bf(sw[idx]) : 0u); }
}
constexpr int MK_LD = 72, MV_LD = 136;
constexpr int MK_BYTES = 128 * MK_LD * 2, MV_BYTES = 64 * MV_LD * 2;
__device__ __forceinline__ void moba_wg_block(const Ctx& C, const bf16* PQ, const bf16* VT, const float* KMEAN, bf16* MIX, int bh, int qb) {
    const int lane = C.lane, fr = lane & 15, fq = lane >> 4, h = bh & 7, b = bh >> 3, w = C.wave, tid = C.tid;
    const int tile = qb * 8 + w, row0 = b * SEQ + tile * 32;
    LAS bf16* Kb0 = (LAS bf16*)C.lds; LAS bf16* Vb0 = (LAS bf16*)(C.lds + 2 * MK_BYTES);
    unsigned mask = 0u;
    if (qb > 0) {
        float q[64];
        { const u32x4* qp = (const u32x4*)(PQ + (size_t)(row0 + (lane & 31)) * 1536 + h * 64);
#pragma unroll
          for (int i = 0; i < 8; ++i) unpack8(qp[i], q + 8 * i); }
        float b0 = -INFINITY, b1 = -INFINITY, b2 = -INFINITY; int i0 = -1, i1 = -1, i2 = -1;
        const float* km = KMEAN + (size_t)bh * 32 * 64;
        for (int j = 0; j < qb; ++j) { float s = 0.f;
#pragma unroll
            for (int d = 0; d < 64; ++d) s += q[d] * km[j * 64 + d];
            if (s > b0) { b2 = b1; i2 = i1; b1 = b0; i1 = i0; b0 = s; i0 = j; } else if (s > b1) { b2 = b1; i2 = i1; b1 = s; i1 = j; } else if (s > b2) { b2 = s; i2 = j; } }
        if (i0 >= 0) mask |= 1u << i0; if (i1 >= 0) mask |= 1u << i1; if (i2 >= 0) mask |= 1u << i2;
    }
    const unsigned m0 = (unsigned)__shfl((int)mask, fr), m1 = (unsigned)__shfl((int)mask, 16 + fr);
    bf16x8 qf[2][2];
#pragma unroll
    for (int qt = 0; qt < 2; ++qt)
#pragma unroll
        for (int ks = 0; ks < 2; ++ks) qf[qt][ks] = *(const bf16x8*)(PQ + (size_t)(row0 + 16 * qt + fr) * 1536 + h * 64 + 32 * ks + 8 * fq);
    f32x4 oacc[2][4];
#pragma unroll
    for (int qt = 0; qt < 2; ++qt)
#pragma unroll
        for (int dt = 0; dt < 4; ++dt) oacc[qt][dt] = (f32x4){0.f, 0.f, 0.f, 0.f};
    float mrow[2] = {-INFINITY, -INFINITY}, lrow[2] = {0.f, 0.f};
    const int qoff0 = w * 32;
    const int kr = tid >> 3, kc = tid & 7, vr = tid >> 4, vc = tid & 15;
    const int nh = 2 * (qb + 1);
    u32x4 kq0, kq1, vq0, vq1;
#define MOBA_KEY0(i) (b * SEQ + (((i) < 2) ? qb : (((i) - 2) >> 1)) * 256 + ((i) & 1) * 128)
#define MOBA_GLOAD(i) do { const int k0_ = MOBA_KEY0(i); \
        kq0 = *(const u32x4*)(PQ + (size_t)(k0_ + kr) * 1536 + 512 + h * 64 + 8 * kc); kq1 = *(const u32x4*)(PQ + (size_t)(k0_ + kr + 64) * 1536 + 512 + h * 64 + 8 * kc); \
        vq0 = *(const u32x4*)(VT + (size_t)(h * 64 + vr) * NT + k0_ + 8 * vc); vq1 = *(const u32x4*)(VT + (size_t)(h * 64 + vr + 32) * NT + k0_ + 8 * vc); } while (0)
#define MOBA_LSTORE(buf) do { LAS bf16* kb_ = Kb0 + (buf) * (MK_BYTES / 2); LAS bf16* vb_ = Vb0 + (buf) * (MV_BYTES / 2); \
        *(LAS u32x4*)(kb_ + kr * MK_LD + 8 * kc) = kq0; *(LAS u32x4*)(kb_ + (kr + 64) * MK_LD + 8 * kc) = kq1; \
        *(LAS u32x4*)(vb_ + vr * MV_LD + 8 * vc) = vq0; *(LAS u32x4*)(vb_ + (vr + 32) * MV_LD + 8 * vc) = vq1; } while (0)
    MOBA_GLOAD(0); MOBA_LSTORE(0);
    WG_BAR();
    for (int i = 0; i < nh; ++i) {
        if (i + 1 < nh) MOBA_GLOAD(i + 1);
        const bool own = i < 2; const int blk = own ? qb : ((i - 2) >> 1), hf = i & 1;
        const bool s0 = own || ((m0 >> blk) & 1u), s1 = own || ((m1 >> blk) & 1u);
        const bool need = own ? !(hf * 128 > qoff0 + 31) : (__any((int)(((m0 | m1) >> blk) & 1u)) != 0);
        if (need) {
            const LAS bf16* Kb = Kb0 + (i & 1) * (MK_BYTES / 2); const LAS bf16* Vb = Vb0 + (i & 1) * (MV_BYTES / 2);
            f32x4 st[2][8];
#pragma unroll
            for (int kt = 0; kt < 8; ++kt) { const bf16x8 k0 = *(const LAS bf16x8*)(Kb + (16 * kt + fr) * MK_LD + 8 * fq), k1 = *(const LAS bf16x8*)(Kb + (16 * kt + fr) * MK_LD + 32 + 8 * fq);
#pragma unroll
                for (int qt = 0; qt < 2; ++qt) { f32x4 acc = {0.f, 0.f, 0.f, 0.f}; acc = MFMA16(k0, qf[qt][0], acc); acc = MFMA16(k1, qf[qt][1], acc); st[qt][kt] = acc; } }
            bf16x8 pf[2][4];
            constexpr float SC2 = 0.125f * 1.4426950408889634f;
#pragma unroll
            for (int qt = 0; qt < 2; ++qt) {
                const bool sel = qt == 0 ? s0 : s1; const int qoff = qoff0 + 16 * qt + fr;
                float mx = -INFINITY;
                if (own) {
#pragma unroll
                    for (int kt = 0; kt < 8; ++kt)
#pragma unroll
                        for (int r = 0; r < 4; ++r) { const int kin = hf * 128 + 16 * kt + 4 * fq + r; if (kin > qoff) st[qt][kt][r] = -INFINITY; }
                }
#pragma unroll
                for (int kt = 0; kt < 8; ++kt) mx = fmaxf(mx, fmaxf(fmaxf(st[qt][kt][0], st[qt][kt][1]), fmaxf(st[qt][kt][2], st[qt][kt][3])));
                mx *= SC2;
                if (!sel) mx = -INFINITY;
                mx = fmaxf(mx, __shfl_xor(mx, 16)); mx = fmaxf(mx, __shfl_xor(mx, 32));
                const float mn = fmaxf(mrow[qt], mx);
                const float corr = __builtin_amdgcn_exp2f(mrow[qt] - mn); mrow[qt] = mn;
                float ps = 0.f;
#pragma unroll
                for (int kt = 0; kt < 8; ++kt)
#pragma unroll
                    for (int r = 0; r < 4; ++r) { const float p = __builtin_amdgcn_exp2f(__builtin_fmaf(st[qt][kt][r], SC2, -mn)); st[qt][kt][r] = p; ps += p; }
                if (!sel) ps = 0.f;
                lrow[qt] = lrow[qt] * corr + ps;
#pragma unroll
                for (int dt = 0; dt < 4; ++dt) oacc[qt][dt] = oacc[qt][dt] * corr;
#pragma unroll
                for (int kk = 0; kk < 4; ++kk) { bf16x8 pv = pack_p(st[qt][2 * kk], st[qt][2 * kk + 1]); if (!sel) pv = (bf16x8){0, 0, 0, 0, 0, 0, 0, 0}; pf[qt][kk] = pv; }
            }
#pragma unroll
            for (int dt = 0; dt < 4; ++dt)
#pragma unroll
                for (int kk = 0; kk < 4; ++kk) { const bf16x8 vf = *(const LAS bf16x8*)(Vb + (16 * dt + fr) * MV_LD + 32 * kk + 8 * fq);
                    oacc[0][dt] = MFMA16(vf, pf[0][kk], oacc[0][dt]); oacc[1][dt] = MFMA16(vf, pf[1][kk], oacc[1][dt]); }
        }
        if (i + 1 < nh) MOBA_LSTORE((i + 1) & 1);
        WG_BAR();
    }
#undef MOBA_KEY0
#undef MOBA_GLOAD
#undef MOBA_LSTORE
#pragma unroll
    for (int qt = 0; qt < 2; ++qt) {
        float l = lrow[qt]; l += __shfl_xor(l, 16); l += __shfl_xor(l, 32); const float inv = 1.0f / l;
        bf16* op = MIX + (size_t)(row0 + 16 * qt + fr) * 1024 + h * 64 + 4 * fq;
#pragma unroll
        for (int dt = 0; dt < 4; ++dt) { u32x2 wv; wv.x = pk2(oacc[qt][dt][0] * inv, oacc[qt][dt][1] * inv); wv.y = pk2(oacc[qt][dt][2] * inv, oacc[qt][dt][3] * inv); *(u32x2*)(op + 16 * dt) = wv; }
    }
}
__device__ __forceinline__ void moba_wg(const Ctx& C, const bf16* PQ, const bf16* VT, const float* KMEAN, bf16* MIX) {
    for (int it = blockIdx.x; it < 256; it += C.G) {
        const int bh = it & 15, pp = it >> 4;
        moba_wg_block(C, PQ, VT, KMEAN, MIX, bh, 31 - pp);
        moba_wg_block(C, PQ, VT, KMEAN, MIX, bh, pp);
    }
}
constexpr int XK_LD = 264, XV_LD = 136;
constexpr int XK_BYTES = 128 * XK_LD * 2, XV_BYTES = 256 * XV_LD * 2;
static_assert(XK_BYTES + XV_BYTES <= LDS_BYTES - 256, "xattn LDS");
__device__ __forceinline__ void xattn_wg(const Ctx& C, const bf16* QX, const bf16* KX, const bf16* VXT, bf16* OX) {
    const int lane = C.lane, fr = lane & 15, fq = lane >> 4, w = C.wave, tid = C.tid;
    LAS bf16* Kb = (LAS bf16*)C.lds; LAS bf16* Vb = (LAS bf16*)(C.lds + XK_BYTES);
    constexpr float SC2 = 0.0625f * 1.4426950408889634f;
    for (int it = blockIdx.x; it < 512; it += C.G) {
        const int hd = it & 3, bq = it >> 2, row0 = bq * 128 + w * 16, b = bq >> 6;
        bf16x8 qf[8];
        { const bf16* qp = QX + (size_t)(row0 + fr) * 1024 + hd * 256 + 8 * fq;
#pragma unroll
          for (int ks = 0; ks < 8; ++ks) qf[ks] = *(const bf16x8*)(qp + 32 * ks); }
        f32x4 oacc[16];
#pragma unroll
        for (int dt = 0; dt < 16; ++dt) oacc[dt] = (f32x4){0.f, 0.f, 0.f, 0.f};
        float mrow = -INFINITY, lrow = 0.f;
        for (int hf = 0; hf < 2; ++hf) {
            WG_BAR();
#pragma unroll
            for (int i = 0; i < 8; ++i) { const int id = tid + 512 * i;
                { const int r = id >> 5, c = id & 31; *(LAS u32x4*)(Kb + r * XK_LD + 8 * c) = *(const u32x4*)(KX + (size_t)(b * NMEM + 128 * hf + r) * 1024 + hd * 256 + 8 * c); }
                { const int r = id >> 4, c = id & 15; *(LAS u32x4*)(Vb + r * XV_LD + 8 * c) = *(const u32x4*)(VXT + (size_t)(hd * 256 + r) * 512 + b * NMEM + 128 * hf + 8 * c); } }
            WG_BAR();
            f32x4 st[8];
#pragma unroll
            for (int kt = 0; kt < 8; ++kt) { f32x4 acc = {0.f, 0.f, 0.f, 0.f};
#pragma unroll
                for (int ks = 0; ks < 8; ++ks) acc = MFMA16(*(const LAS bf16x8*)(Kb + (16 * kt + fr) * XK_LD + 32 * ks + 8 * fq), qf[ks], acc);
                st[kt] = acc; }
            float mx = -INFINITY;
#pragma unroll
            for (int kt = 0; kt < 8; ++kt)
#pragma unroll
                for (int r = 0; r < 4; ++r) { const float sv = st[kt][r] * SC2; st[kt][r] = sv; mx = fmaxf(mx, sv); }
            mx = fmaxf(mx, __shfl_xor(mx, 16)); mx = fmaxf(mx, __shfl_xor(mx, 32));
            const float mn = fmaxf(mrow, mx), corr = __builtin_amdgcn_exp2f(mrow - mn); mrow = mn;
            float ps = 0.f;
#pragma unroll
            for (int kt = 0; kt < 8; ++kt)
#pragma unroll
                for (int r = 0; r < 4; ++r) { const float p = __builtin_amdgcn_exp2f(st[kt][r] - mn); st[kt][r] = p; ps += p; }
            lrow = lrow * corr + ps;
            bf16x8 pf[4];
#pragma unroll
            for (int kk = 0; kk < 4; ++kk) pf[kk] = pack_p(st[2 * kk], st[2 * kk + 1]);
#pragma unroll
            for (int dt = 0; dt < 16; ++dt) { f32x4 acc = oacc[dt] * corr;
#pragma unroll
                for (int kk = 0; kk < 4; ++kk) acc = MFMA16(*(const LAS bf16x8*)(Vb + (16 * dt + fr) * XV_LD + 32 * kk + 8 * fq), pf[kk], acc);
                oacc[dt] = acc; }
        }
        lrow += __shfl_xor(lrow, 16); lrow += __shfl_xor(lrow, 32);
        const float inv = 1.0f / lrow;
        bf16* op = OX + (size_t)(row0 + fr) * 1024 + hd * 256 + 4 * fq;
#pragma unroll
        for (int dt = 0; dt < 16; ++dt) { u32x2 wv; wv.x = pk2(oacc[dt][0] * inv, oacc[dt][1] * inv); wv.y = pk2(oacc[dt][2] * inv, oacc[dt][3] * inv); *(u32x2*)(op + 16 * dt) = wv; }
    }
    WG_BAR();
}
__device__ __forceinline__ void l1_prep(const Ctx& C, ArgsP a, const bf16* Z, const bf16* QKV, bf16* VNT, bf16* QN, bf16* KN, bf16* VV) {
    const int lane = C.lane;
    const float* lng = INP(a, I_SGUG); const float* lnb = INP(a, I_SGUB); const float* cw = INP(a, I_DNCONV);
    for (int blk = C.gw; blk < NT / 8; blk += C.ngw) {
        const int row0 = blk * 8;
        {
            const f32x4 g0 = *((const f32x4*)lng + 2 * lane), g1 = *((const f32x4*)lng + 2 * lane + 1), c0 = *((const f32x4*)lnb + 2 * lane), c1 = *((const f32x4*)lnb + 2 * lane + 1);
            unsigned vt[8][4];
#pragma unroll
            for (int e = 0; e < 8; ++e)
#pragma unroll
                for (int q = 0; q < 4; ++q) vt[e][q] = 0u;
#pragma unroll
            for (int r = 0; r < 8; ++r) {
                float f[8]; unpack8(*((const u32x4*)(Z + (size_t)(row0 + r) * 1024 + 512) + lane), f);
                float s = 0.f;
#pragma unroll
                for (int e = 0; e < 8; ++e) s += f[e];
                const float mu = wave_sum(s) * (1.0f / 512.0f); float q = 0.f;
#pragma unroll
                for (int e = 0; e < 8; ++e) { f[e] -= mu; q += f[e] * f[e]; }
                const float rstd = 1.0f / sqrtf(wave_sum(q) * (1.0f / 512.0f) + EPS);
                const float y[8] = {f[0] * rstd * g0.x + c0.x, f[1] * rstd * g0.y + c0.y, f[2] * rstd * g0.z + c0.z, f[3] * rstd * g0.w + c0.w,
                                    f[4] * rstd * g1.x + c1.x, f[5] * rstd * g1.y + c1.y, f[6] * rstd * g1.z + c1.z, f[7] * rstd * g1.w + c1.w};
#pragma unroll
                for (int e = 0; e < 8; ++e) vt[e][r >> 1] |= f2bf(y[e]) << (16 * (r & 1));
            }
            bf16* vp = VNT + ((size_t)(row0 >> 7) * 512 + 8 * lane) * 128 + (row0 & 127);
#pragma unroll
            for (int e = 0; e < 8; ++e) { u32x4 w; w.x = vt[e][0]; w.y = vt[e][1]; w.z = vt[e][2]; w.w = vt[e][3]; *(u32x4*)(vp + (size_t)e * 128) = w; }
        }
        const bool hist = (row0 & (SEQ - 1)) != 0;
#pragma unroll 1
        for (int s3 = 0; s3 < 3; ++s3) {
            const int cs = s3 * 512 + 8 * lane;
            float w[4][8];
#pragma unroll
            for (int j = 0; j < 4; ++j) { const f32x4 a0 = *(const f32x4*)(cw + j * 1536 + cs), a1 = *(const f32x4*)(cw + j * 1536 + cs + 4);
                w[j][0] = a0.x; w[j][1] = a0.y; w[j][2] = a0.z; w[j][3] = a0.w; w[j][4] = a1.x; w[j][5] = a1.y; w[j][6] = a1.z; w[j][7] = a1.w; }
            float x0[8], x1[8], x2[8];
            if (hist) { unpack8(*(const u32x4*)(QKV + (size_t)(row0 - 3) * 1536 + cs), x0); unpack8(*(const u32x4*)(QKV + (size_t)(row0 - 2) * 1536 + cs), x1); unpack8(*(const u32x4*)(QKV + (size_t)(row0 - 1) * 1536 + cs), x2); }
            else {
#pragma unroll
                for (int e = 0; e < 8; ++e) { x0[e] = 0.f; x1[e] = 0.f; x2[e] = 0.f; } }
            bf16* dst = (s3 == 0 ? QN : s3 == 1 ? KN : VV) + (size_t)row0 * 512 + 8 * lane;
#pragma unroll
            for (int r = 0; r < 8; ++r) {
                float x3[8]; unpack8(*(const u32x4*)(QKV + (size_t)(row0 + r) * 1536 + cs), x3);
                float y[8], ss = 0.f;
#pragma unroll
                for (int e = 0; e < 8; ++e) { y[e] = silu_f(w[0][e] * x0[e] + w[1][e] * x1[e] + w[2][e] * x2[e] + w[3][e] * x3[e]); ss += y[e] * y[e]; }
                float sc = 1.0f;
                if (s3 < 2) { ss += __shfl_xor(ss, 1); ss += __shfl_xor(ss, 2); ss += __shfl_xor(ss, 4); ss += __shfl_xor(ss, 8);
                    sc = 1.0f / sqrtf(ss + EPS); if (s3 == 0) sc *= 0.08838834764831845f; }
                u32x4 o; o.x = pk2(y[0] * sc, y[1] * sc); o.y = pk2(y[2] * sc, y[3] * sc); o.z = pk2(y[4] * sc, y[5] * sc); o.w = pk2(y[6] * sc, y[7] * sc);
                *(u32x4*)(dst + (size_t)r * 512) = o;
#pragma unroll
                for (int e = 0; e < 8; ++e) { x0[e] = x1[e]; x1[e] = x2[e]; x2[e] = x3[e]; }
            }
        }
    }
}

#ifndef MK_MULTI
#define MK_MULTI 0
#endif
enum { OP_PRO0 = 0, OP_KMEAN, OP_MOBA, OP_RMSX, OP_XATTN, OP_RMSF, OP_ACT, OP_PRO1, OP_L1PREP, OP_DNPREP, OP_DNSCAN, OP_DNGATE, OP_FINAL, OP_GSTORE, OP_GRESID, OP_GCONV };
struct PD { int op, sync, L, hb, M, N, K; unsigned long long a, b, p0, p1, p2; int ld0, ld1, ld2, t1, t2, gelu0, basex, rot; long long ss; };
#define PH_TABLE \
  {OP_PRO0, 1, 0, 0, 0, 0, 0, 0ull, 0ull, 0ull, 0ull, 0ull, 0, 0, 0, 0, 0, 0, 0, 0, -1ll}, \
  {OP_GSTORE, 0, 0, 0, 16384, 1536, 1024, 38797312ull, 4194304ull, 141557760ull, 0ull, 0ull, 1536, 0, 0, 1000, 1000, 0, 0, 0, -1ll}, \
  {OP_GSTORE, 1, 0, 0, 512, 16384, 1024, 7340032ull, 208666624ull, 191889408ull, 0ull, 0ull, 16384, 0, 0, 1000, 1000, 0, 0, 128, -1ll}, \
  {OP_KMEAN, 0, 0, 0, 0, 0, 0, 0ull, 0ull, 0ull, 0ull, 0ull, 0, 0, 0, 0, 0, 0, 0, 0, -1ll}, \
  {OP_GSTORE, 0, 0, 0, 512, 1024, 1024, 0ull, 14680064ull, 72351744ull, 0ull, 0ull, 1024, 0, 0, 1000, 1000, 0, 0, 64, -1ll}, \
  {OP_GSTORE, 1, 0, 0, 1024, 512, 1024, 16777216ull, 2097152ull, 73400320ull, 0ull, 0ull, 512, 0, 0, 1000, 1000, 0, 0, 72, -1ll}, \
  {OP_MOBA, 1, 0, 0, 0, 0, 0, 0ull, 0ull, 0ull, 0ull, 0ull, 0, 0, 0, 0, 0, 0, 0, 0, -1ll}, \
  {OP_GRESID, 1, 0, 0, 16384, 1024, 1024, 74448896ull, 10485760ull, 0ull, 0ull, 0ull, 0, 0, 0, 0, 0, 0, 1, 0, 260046848ll}, \
  {OP_GSTORE, 1, 0, 0, 16384, 1024, 1024, 38797312ull, 12582912ull, 108003328ull, 0ull, 0ull, 1024, 0, 0, 1000, 1000, 0, 0, 0, 260046848ll}, \
  {OP_XATTN, 1, 0, 0, 0, 0, 0, 0ull, 0ull, 0ull, 0ull, 0ull, 0, 0, 0, 0, 0, 0, 0, 0, -1ll}, \
  {OP_GRESID, 1, 0, 0, 16384, 1024, 1024, 74448896ull, 18874368ull, 0ull, 0ull, 0ull, 0, 0, 0, 0, 0, 0, 0, 0, 260046848ll}, \
  {OP_GCONV, 1, 0, 0, 17408, 5632, 1024, 38797312ull, 20971520ull, 74448896ull, 0ull, 0ull, 0, 0, 0, 0, 0, 0, 0, 0, 260046848ll}, \
  {OP_GRESID, 1, 0, 2, 16384, 1024, 2816, 74448896ull, 32505856ull, 0ull, 0ull, 0ull, 0, 0, 0, 0, 0, 0, 0, 0, -1ll}, \
  {OP_PRO1, 1, 0, 0, 0, 0, 0, 0ull, 0ull, 0ull, 0ull, 0ull, 0, 0, 0, 0, 0, 0, 0, 0, -1ll}, \
  {OP_GSTORE, 1, 0, 0, 16384, 3072, 1024, 38797312ull, 4194304ull, 141557760ull, 175112192ull, 225443840ull, 1024, 1536, 512, 4, 10, 1, 0, 0, -1ll}, \
  {OP_L1PREP, 1, 0, 0, 0, 0, 0, 0ull, 0ull, 0ull, 0ull, 0ull, 0, 0, 0, 0, 0, 0, 0, 0, -1ll}, \
  {OP_DNPREP, 0, 0, 0, 0, 0, 0, 0ull, 0ull, 0ull, 0ull, 0ull, 0, 0, 0, 0, 0, 0, 0, 0, -1ll}, \
  {OP_GSTORE, 0, 0, 0, 512, 1024, 1024, 0ull, 14680064ull, 72351744ull, 0ull, 0ull, 1024, 0, 0, 1000, 1000, 0, 0, 128, -1ll}, \
  {OP_GSTORE, 1, 0, 0, 1024, 512, 1024, 16777216ull, 2097152ull, 73400320ull, 0ull, 0ull, 512, 0, 0, 1000, 1000, 0, 0, 136, -1ll}, \
  {OP_DNSCAN, 1, 0, 0, 0, 0, 0, 0ull, 0ull, 0ull, 0ull, 0ull, 0, 0, 0, 0, 0, 0, 0, 0, -1ll}, \
  {OP_DNGATE, 1, 0, 0, 0, 0, 0, 0ull, 0ull, 0ull, 0ull, 0ull, 0, 0, 0, 0, 0, 0, 0, 0, -1ll}, \
  {OP_GRESID, 1, 0, 1, 16384, 1024, 1024, 74448896ull, 10485760ull, 0ull, 0ull, 0ull, 0, 0, 0, 0, 0, 0, 0, 0, 260046848ll}, \
  {OP_GSTORE, 1, 0, 0, 16384, 1024, 1024, 38797312ull, 12582912ull, 108003328ull, 0ull, 0ull, 1024, 0, 0, 1000, 1000, 0, 0, 0, 260046848ll}, \
  {OP_XATTN, 1, 1, 0, 0, 0, 0, 0ull, 0ull, 0ull, 0ull, 0ull, 0, 0, 0, 0, 0, 0, 0, 0, -1ll}, \
  {OP_GRESID, 1, 0, 0, 16384, 1024, 1024, 74448896ull, 18874368ull, 0ull, 0ull, 0ull, 0, 0, 0, 0, 0, 0, 0, 0, 260046848ll}, \
  {OP_GCONV, 1, 1, 0, 17408, 5632, 1024, 38797312ull, 20971520ull, 74448896ull, 0ull, 0ull, 0, 0, 0, 0, 0, 0, 0, 0, 260046848ll}, \
  {OP_GRESID, 1, 0, 0, 16384, 1024, 2816, 74448896ull, 32505856ull, 0ull, 0ull, 0ull, 0, 0, 0, 0, 0, 0, 0, 0, -1ll}, \
  {OP_FINAL, 0, 0, 0, 0, 0, 0, 0ull, 0ull, 0ull, 0ull, 0ull, 0, 0, 0, 0, 0, 0, 0, 0, -1ll},
constexpr int NENT = 28;
__constant__ PD PH_DEV[NENT] = { PH_TABLE };
#define XB_TMO      128
#define XB_XCNT(j)  (256  + 64 * (j))
#define XB_XSUB(j)  (1280 + 64 * (j))
#define XB_XGEN(j)  (2304 + 64 * (j))
#define XB_TOP      3328
#define XB_TOPGEN   3392
#define XCD_BAR_WORDS 3456
#define XB_SPIN_CAP (1u << 18)

__device__ __forceinline__ unsigned xb_ld(unsigned* p)              { return __hip_atomic_load(p, __ATOMIC_RELAXED, __HIP_MEMORY_SCOPE_AGENT); }
__device__ __forceinline__ unsigned xb_add(unsigned* p, unsigned v) { return __hip_atomic_fetch_add(p, v, __ATOMIC_RELAXED, __HIP_MEMORY_SCOPE_AGENT); }
__device__ __forceinline__ unsigned xb_xcc_id() { return (unsigned)__builtin_amdgcn_s_getreg((3 << 11) | 20) & 0xFu; }
#define XB_SPIN(cond, bar) do { unsigned _sp = 0; while (cond) { __builtin_amdgcn_s_sleep(1); \
    if ((++_sp & 255u) == 0u) { if (xb_ld(&(bar)[XB_TMO])) break; if (_sp > XB_SPIN_CAP) { atomicAdd(&(bar)[XB_TMO], 1u); break; } } } } while (0)

struct XcdBarrier {
    unsigned* bar; unsigned x;
    volatile LAS unsigned* st;
};

__device__ __forceinline__ XcdBarrier xcd_barrier_post(unsigned* bar, volatile LAS unsigned* st) {
    XcdBarrier b; b.bar = bar; b.x = xb_xcc_id(); b.st = st;
    if (threadIdx.x == 0) (void)xb_add(&bar[XB_XCNT(b.x)], 1u);
    return b;
}
__device__ __forceinline__ void xcd_barrier_complete(unsigned* bar, unsigned x, unsigned& nloc, unsigned& nx) {
    const unsigned G = gridDim.x * gridDim.y * gridDim.z;
    unsigned sum, cnt, mine, sp = 0u;
    for (;;) {
        sum = 0u; cnt = 0u; mine = 0u;
#pragma unroll
        for (unsigned j = 0; j < 16; ++j) { const unsigned c = xb_ld(&bar[XB_XCNT(j)]); sum += c; cnt += (c > 0u) ? 1u : 0u; mine = (j == x) ? c : mine; }
        if (sum == G) break;
        __builtin_amdgcn_s_sleep(1);
        if ((++sp & 255u) == 0u) { if (xb_ld(&bar[XB_TMO])) break; if (sp > XB_SPIN_CAP) { atomicAdd(&bar[XB_TMO], 1u); break; } }
    }
    nloc = mine > 0u ? mine : 1u; nx = cnt > 0u ? cnt : 1u;
}

__device__ __forceinline__ void xcd_barrier(const XcdBarrier& b) {
    asm volatile("s_waitcnt vmcnt(0)" ::: "memory");
    __syncthreads();
    if (threadIdx.x == 0) {
        unsigned* bar = b.bar;
        __builtin_amdgcn_s_waitcnt(0);
        unsigned nloc = b.st[0], nx = b.st[1];
        if (nloc == 0u) { xcd_barrier_complete(bar, b.x, nloc, nx); b.st[0] = nloc; b.st[1] = nx; }
        const unsigned old = xb_add(&bar[XB_XSUB(b.x)], 1u);
        const unsigned gen = old / nloc;
        if (old + 1u == (gen + 1u) * nloc) {
            __builtin_amdgcn_fence(__ATOMIC_RELEASE, "agent");
            asm volatile("s_waitcnt vmcnt(0)" ::: "memory");
            const unsigned og = xb_add(&bar[XB_TOP], 1u);
            const unsigned tg = og / nx;
            if (og + 1u == (tg + 1u) * nx) xb_add(&bar[XB_TOPGEN], 1u);
            else XB_SPIN(xb_ld(&bar[XB_TOPGEN]) == tg, bar);
            __builtin_amdgcn_fence(__ATOMIC_ACQUIRE, "agent");
            xb_add(&bar[XB_XGEN(b.x)], 1u);
            asm volatile("s_waitcnt vmcnt(0)" ::: "memory");
        } else {
            XB_SPIN(xb_ld(&bar[XB_XGEN(b.x)]) == gen, bar);
            __builtin_amdgcn_fence(__ATOMIC_ACQUIRE, "agent");
            asm volatile("s_waitcnt vmcnt(0)" ::: "memory");
        }
    }
    __syncthreads();
}

constexpr size_t WS_CTL = 3 * MiB, CTL_BYTES = 64 * 1024;
constexpr int MISC_OFF = LDS_BYTES - 128;

static const PD PH_HOST[NENT] = { PH_TABLE };

__global__ void __launch_bounds__(512, 2) mega_fwd(Args a) {
    extern __shared__ __attribute__((aligned(16))) unsigned char lds_raw[];
    cg::grid_group grid = cg::this_grid();
    Ctx C; C.lds = (LAS unsigned char*)lds_raw; C.tid = threadIdx.x; C.lane = C.tid & 63; C.wave = __builtin_amdgcn_readfirstlane(C.tid >> 6);
    C.G = gridDim.x; C.gw = blockIdx.x * 8 + C.wave; C.ngw = C.G * 8; C.gtid = blockIdx.x * 512 + C.tid; C.nthr = C.G * 512;
    unsigned char* ws = a.ws;
    float* H = a.out;
    for (int u = C.tid; u < 128 / 4; u += 512) ((LAS unsigned*)(C.lds + MISC_OFF))[u] = 0u;
    __syncthreads();
    (void)xcd_barrier_post((unsigned*)(ws + WS_CTL), (volatile LAS unsigned*)(C.lds + MISC_OFF) + 8);
    const ArgsP ap0 = (ArgsP)__builtin_amdgcn_kernarg_segment_ptr();
    unsigned char* const ws0 = ws; float* const H0 = H;
    for (int e = a.ph_lo; e < a.ph_hi; ++e) {
        ws = ws0; H = H0; ArgsP ap = ap0; asm volatile("" : "+s"(ap));
        { int t_ = threadIdx.x; asm volatile("" : "+v"(t_)); int g_ = gridDim.x, bx_ = blockIdx.x; asm volatile("" : "+s"(g_), "+s"(bx_));
          C.tid = t_; C.lane = t_ & 63; C.wave = __builtin_amdgcn_readfirstlane(t_ >> 6); C.G = g_; C.gw = bx_ * 8 + C.wave; C.ngw = g_ * 8; C.gtid = bx_ * 512 + t_; C.nthr = g_ * 512; }
        { GAS1 unsigned char* wg = (GAS1 unsigned char*)ws; GAS1 float* hg = (GAS1 float*)H; asm volatile("" : "+s"(wg), "+s"(hg)); ws = (unsigned char*)wg; H = (float*)hg; }
        const int op = PH_DEV[e].op, L = PH_DEV[e].L;
        if (op == OP_GSTORE) {
            const PD& d = PH_DEV[e];
            pg8::Gemm g{(const bf16*)(ws + d.a), (const bf16*)(ws + d.b), d.M, d.N, d.K}; pg8::StaticOrder S; S.init(g.M, g.N, C.G, (int)((blockIdx.x + C.G - d.rot) % C.G));
            pg8::EpiSeg E{(bf16*)(ws + d.p0), (bf16*)(ws + d.p1), (bf16*)(ws + d.p2), d.ld0, d.ld1, d.ld2, d.t1, d.t2, d.gelu0, d.ss >= 0 ? (const float*)(ws + d.ss) : (const float*)nullptr};
            __syncthreads();
            pg8::gemm_phase<pg8::EpiSeg, pg8::StaticOrder, true, true>((PG8_LAS unsigned char*)C.lds, g, S, E, C.tid);
            __syncthreads();
        } else if (op == OP_GCONV) {
            const PD& d = PH_DEV[e];
            pg8::Gemm g{(const bf16*)(ws + d.a), (const bf16*)(ws + d.b), d.M, d.N, d.K, 2, 34, SEQ}; pg8::StaticOrder S; S.init(g.M, g.N, C.G, (int)((blockIdx.x + C.G - d.rot) % C.G));
            pg8::EpiConv E{(bf16*)(ws + d.p0), (const float*)(ws + d.ss), INP(ap, I_FCONV) + (size_t)L * 3 * DFF2, 34, SEQ, DFF};
            __syncthreads();
            pg8::gemm_phase<pg8::EpiConv, pg8::StaticOrder, true, true>((PG8_LAS unsigned char*)C.lds, g, S, E, C.tid);
            __syncthreads();
        } else if (op == OP_GRESID) {
            const PD& d = PH_DEV[e];
            pg8::Gemm g{(const bf16*)(ws + d.a), (const bf16*)(ws + d.b), d.M, d.N, d.K}; pg8::StaticOrder S; S.init(g.M, g.N, C.G, (int)((blockIdx.x + C.G - d.rot) % C.G));
            pg8::EpiResid E{d.basex ? INP(ap, I_X) : (const float*)nullptr, (d.hb & 1) ? (const bf16*)H : (const bf16*)(ws + WS_HB), (d.hb & 2) ? (bf16*)H : (bf16*)(ws + WS_HB), d.ss >= 0 ? (float*)(ws + d.ss) : (float*)nullptr, DM};
            __syncthreads();
            pg8::gemm_phase<pg8::EpiResid, pg8::StaticOrder, true, true>((PG8_LAS unsigned char*)C.lds, g, S, E, C.tid);
            __syncthreads();
        } else if (op == OP_PRO0) {
            convert_weights(C, ap, 0, 0, C.gw, C.ngw);
            rms_all_rows(C, INP(ap, I_X), INP(ap, I_NMIX), (bf16*)(ws + WS_XN), NT, (bf16*)(ws + WS_XNP));
            rms_all_rows(C, INP(ap, I_MEM), INP(ap, I_MEMNORM), (bf16*)(ws + WS_MEMN), 2 * NMEM, (bf16*)(ws + WS_MEMNP));
        } else if (op == OP_KMEAN) {
            kmean_pooled(C, (const bf16*)(ws + WS_PROJ0), (float*)(ws + WS_KMEAN));
            if (C.G > 80) { if ((int)blockIdx.x >= 80) convert_weights(C, ap, 0, 1, C.gw - 80 * 8, C.ngw - 80 * 8); } else convert_weights(C, ap, 0, 1, C.gw, C.ngw);
        }
        else if (op == OP_MOBA) { moba_wg(C, (const bf16*)(ws + WS_PROJ0), (const bf16*)(ws + WS_VT), (const float*)(ws + WS_KMEAN), (bf16*)(ws + WS_MIX));
                                  pool_mfma(C, (const bf16*)(ws + WS_PROJ0), (const bf16*)(ws + WS_PWT), INP(ap, I_POOLS), (bf16*)(ws + WS_MIX)); }
        else if (op == OP_PRO1) { convert_weights(C, ap, 1, 0, C.gw, C.ngw); sgu_w_convert(C, INP(ap, I_SGUW), (bf16*)(ws + WS_WB)); rms_rows_bg(C, ap, (const bf16*)H, (bf16*)(ws + WS_XN), (float*)(ws + WS_BG)); }
        else if (op == OP_L1PREP) { l1_prep(C, ap, (const bf16*)(ws + WS_Z), (const bf16*)(ws + WS_QKV), (bf16*)(ws + WS_VNT), (bf16*)(ws + WS_QN), (bf16*)(ws + WS_KN), (bf16*)(ws + WS_VV)); }
        else if (op == OP_DNPREP) {
            dn_chunk_prep(C, (const bf16*)(ws + WS_QN), (const bf16*)(ws + WS_KN), (const bf16*)(ws + WS_VV), (const float*)(ws + WS_BG), (bf16*)(ws + WS_U), (bf16*)(ws + WS_W), (bf16*)(ws + WS_QD), (bf16*)(ws + WS_KDT), (bf16*)(ws + WS_QKM), (float*)(ws + WS_GL));
        }
        else if (op == OP_DNSCAN) {
            const int nscan = C.G > 64 ? 64 : 0;
            if ((int)blockIdx.x < nscan || nscan == 0) for (int it = blockIdx.x; it < 64; it += C.G) dn_scan(C, (const bf16*)(ws + WS_U), (const bf16*)(ws + WS_W), (const bf16*)(ws + WS_QD), (const bf16*)(ws + WS_KDT), (const bf16*)(ws + WS_QKM), (const float*)(ws + WS_GL), (float*)(ws + WS_O), it);
            if ((int)blockIdx.x >= nscan) { const int gw0 = C.gw - nscan * 8, ngw0 = C.ngw - nscan * 8;
                sgu_mfma(C, (const bf16*)(ws + WS_Z), (const bf16*)(ws + WS_VNT), (const bf16*)(ws + WS_WB), INP(ap, I_SGUBS), (bf16*)(ws + WS_MIX), gw0, ngw0);
                convert_weights(C, ap, 1, 1, gw0, ngw0); }
        }
        else if (op == OP_DNGATE) { dn_out_gate(C, ap, (const float*)(ws + WS_O), (const bf16*)(ws + WS_GATE), (bf16*)(ws + WS_MIX)); }
        else if (op == OP_RMSX) { rms_all_rows(C, H, INP(ap, I_NXATTN) + L * DM, (bf16*)(ws + WS_XN), NT); }
        else if (op == OP_XATTN) { xattn_wg(C, (const bf16*)(ws + WS_QX), (const bf16*)(ws + WS_KVX), (const bf16*)(ws + WS_VXT), (bf16*)(ws + WS_MIX)); }
        else if (op == OP_RMSF) { rms_all_rows(C, H, INP(ap, I_NFFN) + L * DM, (bf16*)(ws + WS_XN), NT); }
        else if (op == OP_ACT) { ffn_act(C, (const bf16*)(ws + WS_HUP), INP(ap, I_FCONV) + (size_t)L * 3 * DFF2, (bf16*)(ws + WS_ACT), PH_DEV[e].hb); }
        else if (op == OP_FINAL) { final_norm(C, (const bf16*)(ws + WS_HB), H, INP(ap, I_FNORM)); }
        if (PH_DEV[e].sync && e + 1 < a.ph_hi) { if (e < 0) grid.sync();   else { XcdBarrier bar; bar.bar = (unsigned*)(ws + WS_CTL); bar.x = xb_xcc_id(); bar.st = (volatile LAS unsigned*)(C.lds + MISC_OFF) + 8; xcd_barrier(bar); } }
    }
}

extern "C" void kernel_launch(void* const* d_in, const int* in_sizes, int n_in, void* d_out, int out_size, void* d_ws, size_t ws_size, hipStream_t stream) {
    static int grid = 0;
    if (grid == 0) {
        if (n_in != 27 || out_size != NT * DM || ws_size < WS_END) { fprintf(stderr, "kernel_launch: unexpected sizes n_in %d out %d ws %zu\n", n_in, out_size, ws_size); grid = -1; return; }
        int dev = 0, cus = 0, per_cu = 0;
        (void)hipGetDevice(&dev); (void)hipDeviceGetAttribute(&cus, hipDeviceAttributeMultiprocessorCount, dev);
        if (hipFuncSetAttribute((const void*)mega_fwd, hipFuncAttributeMaxDynamicSharedMemorySize, LDS_BYTES) != hipSuccess) { fprintf(stderr, "kernel_launch: hipFuncSetAttribute failed\n"); }
        if (hipOccupancyMaxActiveBlocksPerMultiprocessor(&per_cu, (const void*)mega_fwd, 512, LDS_BYTES) != hipSuccess || per_cu < 1) { fprintf(stderr, "kernel_launch: occupancy query says %d\n", per_cu); per_cu = 1; }
        (void)hipGetLastError();
        grid = cus * 1;
        if (grid <= 0) grid = 256;
    }
    if (grid < 0) return;
    if (hipMemsetAsync((char*)d_ws + WS_CTL, 0, CTL_BYTES, stream) != hipSuccess) { fprintf(stderr, "kernel_launch: hipMemsetAsync failed\n"); return; }
    Args a{};
    for (int i = 0; i < 27; ++i) a.in[i] = (const float*)d_in[i];
    a.out = (float*)d_out; a.ws = (unsigned char*)d_ws;
#if MK_MULTI
    for (int e0 = 0; e0 < NENT;) { int e1 = e0; while (e1 < NENT - 1 && !PH_HOST[e1].sync) ++e1; ++e1;
        a.ph_lo = e0; a.ph_hi = e1; void* args[] = {&a};
        hipError_t er = hipLaunchCooperativeKernel((const void*)mega_fwd, dim3(grid), dim3(512), args, LDS_BYTES, stream);
        if (er != hipSuccess) { fprintf(stderr, "launch %d failed: %s\n", e0, hipGetErrorString(er)); break; }
        e0 = e1; }
#else
    a.ph_lo = 0; a.ph_hi = NENT; void* args[] = {&a};
    hipError_t er = hipLaunchCooperativeKernel((const void*)mega_fwd, dim3(grid), dim3(512), args, LDS_BYTES, stream);
    if (er != hipSuccess) fprintf(stderr, "cooperative launch failed: %s (grid %d)\n", hipGetErrorString(er), grid);
#endif
}
```

```cpp
#include <hip/hip_runtime.h>
#include <hip/hip_cooperative_groups.h>
#include <cstdio>
#include <cstdint>
namespace cg = cooperative_groups;
namespace pg8 {
#define PG8_LAS __attribute__((address_space(3)))
typedef unsigned short bf16_t;
typedef short bf16x8 __attribute__((ext_vector_type(8)));
typedef float f32x4 __attribute__((ext_vector_type(4)));
typedef unsigned u32x4 __attribute__((ext_vector_type(4)));
constexpr int BM = 256, BK = 64, HALF = 128, HTB = HALF * BK * 2  , STAGE_BYTES = 8 * HTB, NXCD = 8, WGM = 8;

__host__ __device__ __forceinline__ int lds_byte(int r, int c) { const int st = (r >> 4) * 2 + (c >> 5), rr = r & 15, cc = c & 31, ob = rr * 64 + cc * 2; return st * 1024 + (ob ^ (((ob >> 9) & 1) << 5)); }
__host__ __device__ __forceinline__ void stage_rc(int b, int& R, int& C) { const int st = b / 1024, sb = b % 1024, swz = sb ^ (((sb >> 9) & 1) << 5); R = (st >> 1) * 16 + swz / 64; C = (st & 1) * 32 + (swz % 64) / 2; }
__host__ __device__ __forceinline__ int perm32(int rho) { const int n = rho >> 4, i = rho & 15; return 8 * (i >> 2) + 4 * n + (i & 3); }

struct Unit { int pm, pn; };
struct Gemm { const bf16_t* A; const bf16_t* Bt; int M, N, K; int ov, tpb, seq; };

struct StaticOrder {
    int nM, nN, nwg, G, c;
    __host__ __device__ void init(int M, int N, int G_, int c_) { nM = M / BM; nN = N / BM; nwg = nM * nN; G = G_; c = c_; }
    __host__ __device__ bool next(int i, Unit& u) const {
        const long L = (long)i * G + c; if (L >= nwg) return false;
        int wgid = (int)L; { const int q = nwg / NXCD, r = nwg % NXCD, xcd = wgid % NXCD, off = wgid / NXCD; wgid = (xcd < r ? xcd * (q + 1) : r * (q + 1) + (xcd - r) * q) + off; }
        const int nig = WGM * nN, gid = wgid / nig, fm = gid * WGM, gsz = (nM - fm) < WGM ? (nM - fm) : WGM;
        u.pm = fm + ((wgid % nig) % gsz); u.pn = (wgid % nig) / gsz; return true;
    }
    __device__ __forceinline__ void a_ready(const Unit&) const {}
    __device__ __forceinline__ void done(const Unit&) const {}
};

__device__ __forceinline__ unsigned cvt_pk_bf16(float lo, float hi) { unsigned r; asm volatile("v_cvt_pk_bf16_f32 %0, %1, %2" : "=v"(r) : "v"(lo), "v"(hi)); return r; }
__device__ __forceinline__ float gelu_tanh(float x) { const float u2 = 1.5957691216057308f * (x + 0.044715f * x * x * x); return x * __builtin_amdgcn_rcpf(1.0f + __expf(-u2)); }

struct EpiSeg {
    static constexpr bool PERM = true, AFTER_DRAIN = false;
    bf16_t* p0; bf16_t* p1; bf16_t* p2; int ld0, ld1, ld2, t1, t2, gelu0; const float* ss;
    __device__ __forceinline__ void operator()(const f32x4 (&acc)[2][2][4][2], const Unit& u, int wr, int wc, int fr, int fq) const {
        bf16_t* base; int ld, colt; bool act = false;
        if (u.pn < t1) { base = p0; ld = ld0; colt = u.pn * BM; act = gelu0 != 0; }
        else if (u.pn < t2) { base = p1; ld = ld1; colt = (u.pn - t1) * BM; }
        else { base = p2; ld = ld2; colt = (u.pn - t2) * BM; }
        const int row0 = u.pm * BM + wr * 64 + fr, col0 = colt + wc * 32 + 8 * fq;
#pragma unroll
        for (int ai = 0; ai < 2; ++ai)
#pragma unroll
            for (int m = 0; m < 4; ++m) { bf16_t* rowp = base + (size_t)(row0 + ai * HALF + m * 16) * ld + col0;
                float rs = 1.0f;
                if (ss) { const f32x4* sp = (const f32x4*)(ss + (size_t)(row0 + ai * HALF + m * 16) * 16); const f32x4 s0 = sp[0], s1 = sp[1], s2 = sp[2], s3 = sp[3];
                    const float tot = ((s0[0] + s0[1]) + (s0[2] + s0[3])) + ((s1[0] + s1[1]) + (s1[2] + s1[3])) + ((s2[0] + s2[1]) + (s2[2] + s2[3])) + ((s3[0] + s3[1]) + (s3[2] + s3[3]));
                    rs = 1.0f / sqrtf(tot * (1.0f / 1024.0f) + 1e-6f); }
#pragma unroll
                for (int bj = 0; bj < 2; ++bj) { f32x4 v0 = acc[ai][bj][m][0] * rs, v1 = acc[ai][bj][m][1] * rs;
                    if (act) { v0 = (f32x4){gelu_tanh(v0[0]), gelu_tanh(v0[1]), gelu_tanh(v0[2]), gelu_tanh(v0[3])}; v1 = (f32x4){gelu_tanh(v1[0]), gelu_tanh(v1[1]), gelu_tanh(v1[2]), gelu_tanh(v1[3])}; }
                    u32x4 w; w.x = cvt_pk_bf16(v0[0], v0[1]); w.y = cvt_pk_bf16(v0[2], v0[3]); w.z = cvt_pk_bf16(v1[0], v1[1]); w.w = cvt_pk_bf16(v1[2], v1[3]);
                    *(u32x4*)(rowp + bj * HALF) = w; } }
    }
};
struct EpiResid {
    static constexpr bool PERM = true, AFTER_DRAIN = false;
    const float* basef; const bf16_t* baseh; bf16_t* hb; float* ss; int ld;
    __device__ __forceinline__ void operator()(const f32x4 (&acc)[2][2][4][2], const Unit& u, int wr, int wc, int fr, int fq) const {
        const int col0 = u.pn * BM + wc * 32 + 8 * fq;
#pragma unroll
        for (int ai = 0; ai < 2; ++ai)
#pragma unroll
            for (int m = 0; m < 4; ++m) { const size_t off = (size_t)(u.pm * BM + ai * HALF + wr * 64 + m * 16 + fr) * ld + col0; float sq = 0.f;
#pragma unroll
                for (int bj = 0; bj < 2; ++bj) { f32x4 b0, b1;
                    if (basef) { b0 = *(const f32x4*)(basef + off + bj * HALF); b1 = *(const f32x4*)(basef + off + bj * HALF + 4); }
                    else { const u32x4 w = *(const u32x4*)(baseh + off + bj * HALF);
                        b0[0] = __uint_as_float(w.x << 16); b0[1] = __uint_as_float(w.x & 0xffff0000u); b0[2] = __uint_as_float(w.y << 16); b0[3] = __uint_as_float(w.y & 0xffff0000u);
                        b1[0] = __uint_as_float(w.z << 16); b1[1] = __uint_as_float(w.z & 0xffff0000u); b1[2] = __uint_as_float(w.w << 16); b1[3] = __uint_as_float(w.w & 0xffff0000u); }
                    const f32x4 o0 = b0 + acc[ai][bj][m][0], o1 = b1 + acc[ai][bj][m][1];
                    sq += ((o0[0] * o0[0] + o0[1] * o0[1]) + (o0[2] * o0[2] + o0[3] * o0[3])) + ((o1[0] * o1[0] + o1[1] * o1[1]) + (o1[2] * o1[2] + o1[3] * o1[3]));
                    u32x4 w2; w2.x = cvt_pk_bf16(o0[0], o0[1]); w2.y = cvt_pk_bf16(o0[2], o0[3]); w2.z = cvt_pk_bf16(o1[0], o1[1]); w2.w = cvt_pk_bf16(o1[2], o1[3]); *(u32x4*)(hb + off + bj * HALF) = w2; }
                if (ss) { sq += __shfl_xor(sq, 16); sq += __shfl_xor(sq, 32); if (fq == 0) ss[(size_t)(u.pm * BM + ai * HALF + wr * 64 + m * 16 + fr) * 16 + u.pn * 4 + wc] = sq; } }
    }
};
struct EpiConv {
    static constexpr bool PERM = true, AFTER_DRAIN = false;
    static __device__ __forceinline__ float shr16(float oldv, float v, int d) { const int o = __builtin_bit_cast(int, oldv), x = __builtin_bit_cast(int, v); const int y = d == 1 ? __builtin_amdgcn_update_dpp(o, x, 0x111, 0xf, 0xf, false) : __builtin_amdgcn_update_dpp(o, x, 0x112, 0xf, 0xf, false); return __builtin_bit_cast(float, y); }
    static __device__ __forceinline__ float ror16(float v, int d) { const int x = __builtin_bit_cast(int, v); const int y = d == 1 ? __builtin_amdgcn_mov_dpp(x, 0x121, 0xf, 0xf, false) : __builtin_amdgcn_mov_dpp(x, 0x122, 0xf, 0xf, false); return __builtin_bit_cast(float, y); }
    bf16_t* O; const float* ss; const float* cw; int tpb, seq, dff;
    __device__ __forceinline__ void operator()(const f32x4 (&acc)[2][2][4][2], const Unit& u, int wr, int wc, int fr, int fq) const {
        const int lane = fq * 16 + fr, b = u.pm / tpb, pmm = u.pm % tpb, ch0 = u.pn * 128 + wc * 32 + 8 * fq;
#pragma unroll
        for (int ai = 0; ai < 2; ++ai) {
            const int tl0 = pmm * 248 + (2 * ai + wr) * 62 - 2;
            float rs[4];
#pragma unroll
            for (int m = 0; m < 4; ++m) { const int tl = tl0 + 16 * m + fr; float r_ = 0.f;
                if (tl >= 0 && tl < seq) { const f32x4* sp = (const f32x4*)(ss + ((size_t)b * seq + tl) * 16); const f32x4 s0 = sp[0], s1 = sp[1], s2 = sp[2], s3 = sp[3];
                    const float tot = ((s0[0] + s0[1]) + (s0[2] + s0[3])) + ((s1[0] + s1[1]) + (s1[2] + s1[3])) + ((s2[0] + s2[1]) + (s2[2] + s2[3])) + ((s3[0] + s3[1]) + (s3[2] + s3[3]));
                    r_ = 1.0f / sqrtf(tot * (1.0f / 1024.0f) + 1e-6f); }
                rs[m] = r_; }
#pragma unroll
            for (int n = 0; n < 2; ++n) {
                f32x4 wg[3], wu[3];
#pragma unroll
                for (int k = 0; k < 3; ++k) { wg[k] = *(const f32x4*)(cw + (size_t)k * 2 * dff + ch0 + 4 * n); wu[k] = *(const f32x4*)(cw + (size_t)k * 2 * dff + dff + ch0 + 4 * n); }
                float pv[2][4];
#pragma unroll
                for (int bj = 0; bj < 2; ++bj)
#pragma unroll
                    for (int i = 0; i < 4; ++i) pv[bj][i] = 0.f;
#pragma unroll
                for (int m = 0; m < 4; ++m) {
                    const int tl = tl0 + 16 * m + fr; const bool ok = (16 * m + fr >= 2) && tl < seq;
                    float o[4];
#pragma unroll
                    for (int i = 0; i < 4; ++i) { float cv[2];
#pragma unroll
                        for (int bj = 0; bj < 2; ++bj) {
                            const float cur = rs[m] > 0.f ? acc[ai][bj][m][n][i] * rs[m] : 0.f;
                            const float p1 = shr16(ror16(pv[bj][i], 1), cur, 1), p2 = shr16(ror16(pv[bj][i], 2), cur, 2);
                            pv[bj][i] = cur;
                            cv[bj] = bj == 0 ? (wg[0][i] * p2 + wg[1][i] * p1 + wg[2][i] * cur) : (wu[0][i] * p2 + wu[1][i] * p1 + wu[2][i] * cur); }
                        o[i] = cv[0] * __builtin_amdgcn_rcpf(1.0f + __expf(-cv[0])) * cv[1]; }
                    if (ok) { typedef unsigned u32x2e __attribute__((ext_vector_type(2))); u32x2e w; w.x = cvt_pk_bf16(o[0], o[1]); w.y = cvt_pk_bf16(o[2], o[3]);
                        *(u32x2e*)(O + ((size_t)b * seq + tl) * dff + ch0 + 4 * n) = w; }
                }
            }
        }
    }
};
template <class Epi, class Sched, bool ALIGN_EPI = false, bool SP2 = false>
__device__ __forceinline__ void gemm_phase(PG8_LAS unsigned char* lds, const Gemm g, const Sched& S, const Epi& E, const int tid_in) {
    const int tid = tid_in, wid = __builtin_amdgcn_readfirstlane(tid >> 6), lane = tid & 63, wr = wid >> 2, wc = wid & 3, fr = lane & 15, fq = lane >> 4;
    const int K = g.K, nt = K / BK;
    unsigned voffA[2], voffB[2];
#pragma unroll
    for (int i = 0; i < 2; ++i) { int R, C; stage_rc(tid * 16 + i * 8192, R, C); const int Rb = Epi::PERM ? ((R & ~31) + perm32(R & 31)) : R;
        voffA[i] = (unsigned)((R - (R >> 6) * g.ov) * K + C) * 2u; voffB[i] = (unsigned)(Rb * K + C) * 2u; }
    const size_t kstep = (size_t)(BK * 2);
    const size_t hstep = (size_t)HALF * K * 2;
    const size_t tstep = 2 * hstep;
    const size_t hstepA = (size_t)(HALF - 2 * g.ov) * K * 2;
#define PG8_ABASE(pm_) ((const char*)g.A + (g.ov ? ((size_t)((pm_) / g.tpb) * g.seq + (size_t)((pm_) % g.tpb) * (BM - 4 * g.ov)) * K * 2 - (size_t)g.ov * K * 2 : (size_t)(pm_) * tstep))
    const unsigned ldsw = (unsigned)wid * 1024u;
    const int aoff = lds_byte(wr * 64 + fr, fq * 8), boff = lds_byte(wc * 32 + fr, fq * 8);
#define PG8_SA(b, h) (((b) * 2 + (h)) * HTB)
#define PG8_SB(b, h) ((4 + (b) * 2 + (h)) * HTB)
#define PG8_STAGE(bufoff, gbase, voff) do { _Pragma("unroll") for (int _i = 0; _i < 2; ++_i) \
        __builtin_amdgcn_global_load_lds((const unsigned*)((const char*)(gbase) + (voff)[_i]), (PG8_LAS unsigned*)(lds + (bufoff) + ldsw + _i * 8192), 16, 0, 0); } while (0)
#define PG8_LDA(dst, b, h) do { _Pragma("unroll") for (int m = 0; m < 4; ++m) _Pragma("unroll") for (int k = 0; k < 2; ++k) dst[m][k] = *(const PG8_LAS bf16x8*)(lds + PG8_SA(b, h) + aoff + m * 2048 + k * 1024); } while (0)
#define PG8_LDB(dst, b, h) do { _Pragma("unroll") for (int n = 0; n < 2; ++n) _Pragma("unroll") for (int k = 0; k < 2; ++k) dst[n][k] = *(const PG8_LAS bf16x8*)(lds + PG8_SB(b, h) + boff + n * 2048 + k * 1024); } while (0)
#define PG8_MMA(ai, bj, At, Bt) do { __builtin_amdgcn_s_setprio(1); _Pragma("unroll") for (int m = 0; m < 4; ++m) _Pragma("unroll") for (int n = 0; n < 2; ++n) _Pragma("unroll") for (int k = 0; k < 2; ++k) \
        acc[ai][bj][m][n] = __builtin_amdgcn_mfma_f32_16x16x32_bf16(Bt[n][k], At[m][k], acc[ai][bj][m][n], 0, 0, 0); __builtin_amdgcn_s_setprio(0); } while (0)
#define PG8_WAIT_V(n) asm volatile("s_waitcnt vmcnt(" #n ")" ::: "memory")
#define PG8_WAIT_L(n) asm volatile("s_waitcnt lgkmcnt(" #n ")" ::: "memory")
#define PG8_BAR __builtin_amdgcn_s_barrier()
#define PG8_SCHED __builtin_amdgcn_sched_barrier(0)
    Unit cur, nxt; int ui = 0;
    if (!S.next(0, cur)) return;
    f32x4 acc[2][2][4][2];
#pragma unroll
    for (int a = 0; a < 2; ++a)
#pragma unroll
        for (int b = 0; b < 2; ++b)
#pragma unroll
            for (int m = 0; m < 4; ++m)
#pragma unroll
                for (int n = 0; n < 2; ++n) acc[a][b][m][n] = (f32x4){0.f, 0.f, 0.f, 0.f};
    bf16x8 At[4][2], B0[2][2], B1[2][2];
    const char* cA = PG8_ABASE(cur.pm); const char* cB = (const char*)g.Bt + (size_t)cur.pn * tstep;
    S.a_ready(cur);
    if constexpr (SP2) {
        PG8_STAGE(PG8_SB(0, 0), cB, voffB); PG8_STAGE(PG8_SB(0, 1), cB + hstep, voffB); PG8_STAGE(PG8_SA(0, 0), cA, voffA); PG8_STAGE(PG8_SA(0, 1), cA + hstepA, voffA);
        if (wr == 1) PG8_BAR;
        PG8_WAIT_V(2); PG8_BAR;
        PG8_STAGE(PG8_SB(1, 0), cB + kstep, voffB); PG8_STAGE(PG8_SA(1, 0), cA + kstep, voffA); PG8_STAGE(PG8_SB(1, 1), cB + hstep + kstep, voffB);
        PG8_WAIT_V(6); PG8_BAR;
    } else {
        PG8_STAGE(PG8_SB(0, 0), cB, voffB); PG8_STAGE(PG8_SA(0, 0), cA, voffA); PG8_STAGE(PG8_SB(0, 1), cB + hstep, voffB); PG8_STAGE(PG8_SA(0, 1), cA + hstepA, voffA);
        if (wr == 1) PG8_BAR;
        PG8_WAIT_V(4); PG8_BAR;
        PG8_STAGE(PG8_SB(1, 0), cB + kstep, voffB); PG8_STAGE(PG8_SA(1, 0), cA + kstep, voffA); PG8_STAGE(PG8_SB(1, 1), cB + hstep + kstep, voffB);
        PG8_WAIT_V(6); PG8_BAR;
    }
    for (;;) {
        const bool has_next = S.next(ui + 1, nxt);
        const char* nA = has_next ? PG8_ABASE(nxt.pm) : cA; const char* nB = has_next ? (const char*)g.Bt + (size_t)nxt.pn * tstep : cB;
        for (int t = 0; t < nt; t += 2) {
            const bool last = (t == nt - 2);
            const char* a1 = cA + (size_t)(t + 1) * kstep;
            const char* a2 = last ? nA : cA + (size_t)(t + 2) * kstep; const char* b2 = last ? nB : cB + (size_t)(t + 2) * kstep;
            const char* a3 = a2 + kstep; const char* b3 = b2 + kstep;
            if (last && has_next) S.a_ready(nxt);
            if constexpr (SP2) {
            PG8_LDB(B0, 0, 0); PG8_LDB(B1, 0, 1); PG8_SCHED; PG8_LDA(At, 0, 0); PG8_STAGE(PG8_SA(1, 1), a1 + hstepA, voffA);
            PG8_WAIT_V(8); PG8_WAIT_L(0); PG8_BAR; PG8_MMA(0, 0, At, B0); PG8_MMA(0, 1, At, B1); PG8_BAR; PG8_SCHED;
            PG8_LDA(At, 0, 1); PG8_STAGE(PG8_SB(0, 0), b2, voffB); PG8_STAGE(PG8_SB(0, 1), b2 + hstep, voffB); PG8_STAGE(PG8_SA(0, 0), a2, voffA);
            PG8_WAIT_V(8); PG8_WAIT_L(0); PG8_BAR; PG8_MMA(1, 0, At, B0); PG8_MMA(1, 1, At, B1); PG8_BAR; PG8_SCHED;
            PG8_LDB(B0, 1, 0); PG8_LDB(B1, 1, 1); PG8_SCHED; PG8_LDA(At, 1, 0); PG8_STAGE(PG8_SA(0, 1), a2 + hstepA, voffA);
            PG8_WAIT_V(8); PG8_WAIT_L(0); PG8_BAR; PG8_MMA(0, 0, At, B0); PG8_MMA(0, 1, At, B1); PG8_BAR; PG8_SCHED;
            PG8_LDA(At, 1, 1); PG8_STAGE(PG8_SB(1, 0), b3, voffB); PG8_STAGE(PG8_SB(1, 1), b3 + hstep, voffB); PG8_STAGE(PG8_SA(1, 0), a3, voffA);
            PG8_WAIT_V(8); PG8_WAIT_L(0); PG8_BAR; PG8_MMA(1, 0, At, B0); PG8_MMA(1, 1, At, B1); PG8_BAR; PG8_SCHED;
            } else {
            PG8_LDB(B0, 0, 0); PG8_SCHED; PG8_LDA(At, 0, 0); PG8_STAGE(PG8_SA(1, 1), a1 + hstepA, voffA);
            PG8_WAIT_L(8); PG8_BAR; PG8_WAIT_L(0); PG8_MMA(0, 0, At, B0); PG8_BAR; PG8_SCHED;
            PG8_LDB(B1, 0, 1); PG8_STAGE(PG8_SB(0, 0), b2, voffB);
            PG8_BAR; PG8_WAIT_L(0); PG8_MMA(0, 1, At, B1); PG8_BAR;
            PG8_LDA(At, 0, 1); PG8_STAGE(PG8_SA(0, 0), a2, voffA);
            PG8_BAR; PG8_WAIT_L(0); PG8_MMA(1, 0, At, B0); PG8_BAR; PG8_SCHED;
            PG8_STAGE(PG8_SB(0, 1), b2 + hstep, voffB);
            PG8_WAIT_V(6); PG8_BAR; PG8_MMA(1, 1, At, B1); PG8_BAR;
            PG8_LDB(B0, 1, 0); PG8_SCHED; PG8_LDA(At, 1, 0); PG8_STAGE(PG8_SA(0, 1), a2 + hstepA, voffA);
            PG8_WAIT_L(8); PG8_BAR; PG8_WAIT_L(0); PG8_MMA(0, 0, At, B0); PG8_BAR; PG8_SCHED;
            PG8_LDB(B1, 1, 1); PG8_STAGE(PG8_SB(1, 0), b3, voffB);
            PG8_BAR; PG8_WAIT_L(0); PG8_MMA(0, 1, At, B1); PG8_BAR;
            PG8_LDA(At, 1, 1); PG8_STAGE(PG8_SA(1, 0), a3, voffA);
            PG8_BAR; PG8_WAIT_L(0); PG8_MMA(1, 0, At, B0); PG8_BAR; PG8_SCHED;
            PG8_STAGE(PG8_SB(1, 1), b3 + hstep, voffB);
            PG8_WAIT_V(6); PG8_BAR; PG8_MMA(1, 1, At, B1); PG8_BAR;
            }
        }
        if constexpr (ALIGN_EPI) { if (wr == 0) PG8_BAR; }
        if constexpr (!Epi::AFTER_DRAIN) { E(acc, cur, wr, wc, fr, fq); S.done(cur); }
        if (!has_next) break;
#pragma unroll
        for (int a = 0; a < 2; ++a)
#pragma unroll
            for (int b = 0; b < 2; ++b)
#pragma unroll
                for (int m = 0; m < 4; ++m)
#pragma unroll
                    for (int n = 0; n < 2; ++n) acc[a][b][m][n] = (f32x4){0.f, 0.f, 0.f, 0.f};
        cur = nxt; cA = nA; cB = nB; ++ui;
        if constexpr (ALIGN_EPI) { if (wr == 1) PG8_BAR; }
    }
    PG8_WAIT_V(0);
    if constexpr (!ALIGN_EPI) { if (wr == 0) PG8_BAR; }
    PG8_BAR;
    if constexpr (Epi::AFTER_DRAIN) { E.fused(acc, cur, wr, wc, fr, fq, lds, wid, lane); S.done(cur); }
#undef PG8_ABASE
#undef PG8_SA
#undef PG8_SB
#undef PG8_STAGE
#undef PG8_LDA
#undef PG8_LDB
#undef PG8_MMA
#undef PG8_WAIT_V
#undef PG8_WAIT_L
#undef PG8_BAR
#undef PG8_SCHED
}
}

constexpr int NT = 16384, SEQ = 8192, DM = 1024, NMEM = 256, DFF = 2816, DFF2 = 5632;
constexpr float EPS = 1e-6f;
#define LAS __attribute__((address_space(3)))
typedef unsigned short bf16;
typedef float f32x4 __attribute__((ext_vector_type(4)));
typedef unsigned u32x4 __attribute__((ext_vector_type(4)));
typedef unsigned u32x2 __attribute__((ext_vector_type(2)));
constexpr size_t MiB = 1u << 20;
constexpr size_t WS_MEMN = 0, WS_BG = 1 * MiB, WS_KMEAN = 1 * MiB + 512 * 1024;
constexpr size_t WS_WTS = 4 * MiB;
constexpr size_t W_IN = WS_WTS, W_OUT = WS_WTS + 6 * MiB, W_Q = WS_WTS + 8 * MiB, W_KV = WS_WTS + 10 * MiB, W_O = WS_WTS + 14 * MiB, W_UP = WS_WTS + 16 * MiB, W_DN = WS_WTS + 27 * MiB;
constexpr size_t WS_XN = 37 * MiB, WS_KVX = 69 * MiB, WS_MIX = 71 * MiB, WS_QX = 103 * MiB, WS_F = 135 * MiB;
constexpr size_t WS_PROJ0 = WS_F, WS_Z = WS_F, WS_QKV = WS_F + 32 * MiB, WS_GATE = WS_F + 80 * MiB, WS_O = WS_QX;
constexpr size_t WS_U = WS_F + 32 * MiB, WS_W = WS_F + 48 * MiB, WS_KDT = WS_F + 64 * MiB, WS_QD = WS_F + 96 * MiB, WS_QKM = WS_F + 112 * MiB, WS_GL = 1 * MiB + 768 * 1024;
constexpr size_t WS_VT = WS_F + 48 * MiB, WS_XNP = WS_F + 64 * MiB, WS_MEMNP = 2 * MiB, WS_VXT = WS_KVX + 1 * MiB;
constexpr size_t WS_PWT = 3 * MiB + 64 * 1024, WS_WB = 3 * MiB + 256 * 1024;
constexpr size_t WS_VNT = WS_XN, WS_HB = WS_XN, WS_SS = 248 * MiB;
constexpr size_t WS_POOLED = WS_QX, WS_VN = WS_XN, WS_VV = WS_XN + 16 * MiB, WS_QN = WS_QX, WS_KN = WS_QX + 16 * MiB;
constexpr size_t WS_ACT = WS_MIX, WS_HUP = WS_MIX + 88 * MiB, WS_END = 256 * MiB;
static_assert(WS_HUP + 88 * MiB <= WS_END && WS_GATE + 16 * MiB <= WS_QD && WS_QKM + 8 * MiB <= WS_END, "ws map");
constexpr int LDS_BYTES = 147456;

__device__ __forceinline__ float bf2f(unsigned v) { return __uint_as_float(v << 16); }
__device__ __forceinline__ unsigned f2bf(float f) { unsigned u = __float_as_uint(f); return (u + 0x7fffu + ((u >> 16) & 1u)) >> 16; }
__device__ __forceinline__ unsigned pk2(float lo, float hi) { return f2bf(lo) | (f2bf(hi) << 16); }
__device__ __forceinline__ float lo16(unsigned w) { return __uint_as_float(w << 16); }
__device__ __forceinline__ float hi16(unsigned w) { return __uint_as_float(w & 0xffff0000u); }
__device__ __forceinline__ float wave_sum(float v) {
#pragma unroll
    for (int o = 1; o < 64; o <<= 1) v += __shfl_xor(v, o);
    return v;
}
__device__ __forceinline__ float wave_max(float v) {
#pragma unroll
    for (int o = 1; o < 64; o <<= 1) v = fmaxf(v, __shfl_xor(v, o));
    return v;
}
__device__ __forceinline__ float silu_f(float x) { return x * __builtin_amdgcn_rcpf(1.0f + __expf(-x)); }
#define LDS_WAIT() asm volatile("s_waitcnt lgkmcnt(0)" ::: "memory")

struct Args { const float* in[27]; float* out; unsigned char* ws; int ph_lo, ph_hi; };
typedef const __attribute__((address_space(4))) Args* ArgsP;
#define GAS1 __attribute__((address_space(1)))
__device__ __forceinline__ const float* inp_ptr(ArgsP ap, int i) { GAS1 const float* g = (GAS1 const float*)ap->in[i]; asm volatile("" : "+s"(g)); return (const float*)g; }
__device__ __forceinline__ unsigned char* ws_ptr(ArgsP ap) { GAS1 unsigned char* g = (GAS1 unsigned char*)ap->ws; asm volatile("" : "+s"(g)); return (unsigned char*)g; }
#define INP(ap, i) inp_ptr((ap), (i))
enum { I_X = 0, I_MEM, I_MEMNORM, I_NMIX, I_NXATTN, I_NFFN, I_EVIN, I_POOLW, I_POOLS, I_EVOUT, I_ODIN, I_SGUG, I_SGUB, I_SGUW, I_SGUBS, I_DNCONV, I_DNALOG, I_DNDT, I_DNNG, I_ODOUT,
       I_WQ, I_WKV, I_WO, I_FUP, I_FCONV, I_FDN, I_FNORM };

struct Ctx { LAS unsigned char* lds; int tid, lane, wave, G, gw, ngw, gtid, nthr; };

__device__ __forceinline__ void transpose_item(const float* W, int ldw, int K, int ncols, bf16* WT, LAS float* scr, int item, int lane, const float* gain = nullptr, int guperm = 0) {
    const int nblk = ncols / 32, kb = item / nblk, nb = item % nblk, k0 = 64 * kb, n0 = 32 * nb;
#pragma unroll
    for (int i = 0; i < 8; ++i) { const int kk = 8 * i + (lane >> 3), c4 = lane & 7;
        const f32x4 v = *(const f32x4*)(W + (size_t)(k0 + kk) * ldw + n0 + 4 * c4); const float gk = gain ? gain[k0 + kk] : 1.0f;
        LAS float* d = scr + kk * 33 + 4 * c4; d[0] = v.x * gk; d[1] = v.y * gk; d[2] = v.z * gk; d[3] = v.w * gk; }
    LDS_WAIT();
    const int c = lane & 7;
    int drow = n0; if (guperm) { const int isu = n0 >= guperm ? 1 : 0, nn = n0 - isu * guperm; drow = 256 * (nn >> 7) + 128 * isu + (nn & 127); }
#pragma unroll
    for (int j = 0; j < 4; ++j) { const int n = (lane >> 3) + 8 * j; const LAS float* s = scr + (8 * c) * 33 + n;
        u32x4 o; o.x = pk2(s[0 * 33], s[1 * 33]); o.y = pk2(s[2 * 33], s[3 * 33]); o.z = pk2(s[4 * 33], s[5 * 33]); o.w = pk2(s[6 * 33], s[7 * 33]);
        *(u32x4*)(WT + (size_t)(drow + n) * K + k0 + 8 * c) = o; }
    LDS_WAIT();
}
__device__ __forceinline__ void convert_weights(const Ctx& C, ArgsP a, int L, int part, int gw0, int ngw0) {
    LAS float* scr = (LAS float*)(C.lds + C.wave * 16384);
    unsigned char* ws = ws_ptr(a);
    const float* w_in = L == 0 ? INP(a, I_EVIN) : INP(a, I_ODIN); const int n_in = L == 0 ? 2048 : 3072, ld_in = L == 0 ? 2048 : 3080;
    const float* w_out = L == 0 ? INP(a, I_EVOUT) : INP(a, I_ODOUT);
    const float* wq = INP(a, I_WQ) + (size_t)L * DM * DM; const float* wkv = INP(a, I_WKV) + (size_t)L * DM * 2 * DM; const float* wo = INP(a, I_WO) + (size_t)L * DM * DM;
    const float* wup = INP(a, I_FUP) + (size_t)L * DM * DFF2; const float* wdn = INP(a, I_FDN) + (size_t)L * DFF * DM;
    const int i0 = (DM / 64) * (n_in / 32), i1 = (DM / 64) * (DM / 32), i2 = i1, i3 = (DM / 64) * (2 * DM / 32), i4 = i1, i5 = (DM / 64) * (DFF2 / 32), i6 = (DFF / 64) * (DM / 32);
    const int total = i0 + i1 + i2 + i3 + i4 + i5 + i6;
    for (int it = gw0; it < total; it += ngw0) {
        int r = it;
        { const bool first = (r < i0 + i1) || (r >= i0 + i1 + i2 && r < i0 + i1 + i2 + i3); if ((part == 0 && !first) || (part == 1 && first)) continue; }
        if (r < i0) {
            if (L == 0) {
                const int ia = (DM / 64) * (1024 / 32), ib = (DM / 64) * (512 / 32);
                if (r < ia) transpose_item(w_in, ld_in, DM, 1024, (bf16*)(ws + W_IN), scr, r, C.lane);
                else if (r < ia + ib) transpose_item(w_in + 1536, ld_in, DM, 512, (bf16*)(ws + W_IN) + (size_t)1024 * DM, scr, r - ia, C.lane);
                else transpose_item(w_in + 1024, ld_in, DM, 512, (bf16*)(ws + W_IN) + (size_t)1536 * DM, scr, r - ia - ib, C.lane);
            } else transpose_item(w_in, ld_in, DM, n_in, (bf16*)(ws + W_IN), scr, r, C.lane);
            continue; } r -= i0;
        if (r < i1) { transpose_item(w_out, DM, DM, DM, (bf16*)(ws + W_OUT), scr, r, C.lane); continue; } r -= i1;
        if (r < i2) { transpose_item(wq, DM, DM, DM, (bf16*)(ws + W_Q), scr, r, C.lane, INP(a, I_NXATTN) + L * DM); continue; } r -= i2;
        if (r < i3) { transpose_item(wkv, 2 * DM, DM, 2 * DM, (bf16*)(ws + W_KV), scr, r, C.lane); continue; } r -= i3;
        if (r < i4) { transpose_item(wo, DM, DM, DM, (bf16*)(ws + W_O), scr, r, C.lane); continue; } r -= i4;
        if (r < i5) { transpose_item(wup, DFF2, DM, DFF2, (bf16*)(ws + W_UP), scr, r, C.lane, INP(a, I_NFFN) + L * DM, DFF); continue; } r -= i5;
        transpose_item(wdn, DM, DFF, DM, (bf16*)(ws + W_DN), scr, r, C.lane);
    }
    if (L == 0) for (int it = gw0; it < 32; it += ngw0) { const int g = it >> 3; transpose_item(INP(a, I_POOLW) + (size_t)g * 128 * 128, 128, 128, 128, (bf16*)(ws + WS_PWT) + (size_t)g * 128 * 128, scr, it & 7, C.lane); }
}
__device__ __forceinline__ void rms_row_bf16(const float* xrow, const float* gain, bf16* orow, int lane, bf16* orow2 = nullptr) {
    const f32x4* xr = (const f32x4*)xrow + lane; const f32x4* gr = (const f32x4*)gain + lane;
    f32x4 v[4]; float s = 0.f;
#pragma unroll
    for (int j = 0; j < 4; ++j) { v[j] = xr[64 * j]; s += (v[j].x * v[j].x + v[j].y * v[j].y) + (v[j].z * v[j].z + v[j].w * v[j].w); }
    const float r = 1.0f / sqrtf(wave_sum(s) * (1.0f / DM) + EPS);
    u32x2* o8 = (u32x2*)orow + lane;
#pragma unroll
    for (int j = 0; j < 4; ++j) { const f32x4 g = gr[64 * j]; u32x2 w; w.x = pk2(v[j].x * r * g.x, v[j].y * r * g.y); w.y = pk2(v[j].z * r * g.z, v[j].w * r * g.w); o8[64 * j] = w; if (orow2) ((u32x2*)orow2 + lane)[64 * j] = w; }
}
__device__ __forceinline__ int perm32k_pos(int s) { return (s < 16) ? (8 * (s >> 2) + (s & 3)) : (8 * ((s - 16) >> 2) + 4 + (s & 3)); }
__device__ __forceinline__ void rms_all_rows(const Ctx& C, const float* src, const float* gain, bf16* dst, int nrows, bf16* dstp = nullptr) {
    for (int m = C.gw; m < nrows; m += C.ngw) rms_row_bf16(src + (size_t)m * DM, gain, dst + (size_t)m * DM, C.lane, dstp ? dstp + (size_t)((m & ~31) + perm32k_pos(m & 31)) * DM : nullptr);
}
__device__ __forceinline__ void rms_rows_bg(const Ctx& C, ArgsP a, const bf16* HBin, bf16* XN, float* BG) {
    const float* gain = INP(a, I_NMIX) + DM; const float* W = INP(a, I_ODIN);
    const int lane = C.lane;
    for (int m = C.gw; m < NT; m += C.ngw) {
        const u32x2* xr = (const u32x2*)(HBin + (size_t)m * DM) + lane; const f32x4* gr = (const f32x4*)gain + lane;
        f32x4 v[4]; float s = 0.f;
#pragma unroll
        for (int j = 0; j < 4; ++j) { const u32x2 w_ = xr[64 * j]; v[j].x = lo16(w_.x); v[j].y = hi16(w_.x); v[j].z = lo16(w_.y); v[j].w = hi16(w_.y); s += (v[j].x * v[j].x + v[j].y * v[j].y) + (v[j].z * v[j].z + v[j].w * v[j].w); }
        const float r = 1.0f / sqrtf(wave_sum(s) * (1.0f / DM) + EPS);
        u32x2* o8 = (u32x2*)(XN + (size_t)m * DM) + lane;
        float d[8];
#pragma unroll
        for (int c = 0; c < 8; ++c) d[c] = 0.f;
#pragma unroll
        for (int j = 0; j < 4; ++j) { const f32x4 g = gr[64 * j]; f32x4 y; y.x = v[j].x * r * g.x; y.y = v[j].y * r * g.y; y.z = v[j].z * r * g.z; y.w = v[j].w * r * g.w;
            u32x2 w; w.x = pk2(y.x, y.y); w.y = pk2(y.z, y.w); o8[64 * j] = w;
#pragma unroll
            for (int e = 0; e < 4; ++e) { const int k = 4 * lane + 256 * j + e; const f32x4 w0 = *(const f32x4*)(W + (size_t)k * 3080 + 3072), w1 = *(const f32x4*)(W + (size_t)k * 3080 + 3076);
                const float ye = y[e]; d[0] += ye * w0.x; d[1] += ye * w0.y; d[2] += ye * w0.z; d[3] += ye * w0.w; d[4] += ye * w1.x; d[5] += ye * w1.y; d[6] += ye * w1.z; d[7] += ye * w1.w; } }
#pragma unroll
        for (int c = 0; c < 8; ++c) d[c] = wave_sum(d[c]);
        if (lane < 4) {
            const float braw = lane == 0 ? d[0] : lane == 1 ? d[1] : lane == 2 ? d[2] : d[3];
            const float araw = lane == 0 ? d[4] : lane == 1 ? d[5] : lane == 2 ? d[6] : d[7];
            const float beta = 1.0f / (1.0f + expf(-braw));
            const float xx = araw + INP(a, I_DNDT)[lane];
            const float sp = xx > 20.f ? xx : log1pf(expf(xx));
            BG[(size_t)m * 8 + lane] = beta; BG[(size_t)m * 8 + 4 + lane] = -expf(INP(a, I_DNALOG)[lane]) * sp;
        }
    }
}
__device__ __forceinline__ void final_norm(const Ctx& C, const bf16* HBin, float* out, const float* gain) {
    for (int m = C.gw; m < NT; m += C.ngw) {
        const u32x2* xr = (const u32x2*)(HBin + (size_t)m * DM) + C.lane; const f32x4* gr = (const f32x4*)gain + C.lane; f32x4* orow = (f32x4*)(out + (size_t)m * DM) + C.lane;
        f32x4 v[4]; float s = 0.f;
#pragma unroll
        for (int j = 0; j < 4; ++j) { const u32x2 w_ = xr[64 * j]; v[j].x = lo16(w_.x); v[j].y = hi16(w_.x); v[j].z = lo16(w_.y); v[j].w = hi16(w_.y); s += (v[j].x * v[j].x + v[j].y * v[j].y) + (v[j].z * v[j].z + v[j].w * v[j].w); }
        const float r = 1.0f / sqrtf(wave_sum(s) * (1.0f / DM) + EPS);
#pragma unroll
        for (int j = 0; j < 4; ++j) { const f32x4 g = gr[64 * j]; f32x4 y; y.x = v[j].x * r * g.x; y.y = v[j].y * r * g.y; y.z = v[j].z * r * g.z; y.w = v[j].w * r * g.w; orow[64 * j] = y; }
    }
}
__device__ __forceinline__ void kmean_pooled(const Ctx& C, const bf16* PROJ, float* KMEAN) {
    const int lane = C.lane, d4 = lane & 15, rq = lane >> 4;
    for (int it = C.gw; it < 2 * 8 * 32; it += C.ngw) {
        const int blk = it & 31, h = (it >> 5) & 7, b = it >> 8;
        const bf16* p = PROJ + (size_t)(b * SEQ + blk * 256 + rq * 64) * 1536 + 512 + h * 64 + 4 * d4; float s0 = 0.f, s1 = 0.f, s2 = 0.f, s3 = 0.f;
#pragma unroll 8
        for (int r = 0; r < 64; ++r) { const u32x2 w = *(const u32x2*)(p + (size_t)r * 1536); s0 += lo16(w.x); s1 += hi16(w.x); s2 += lo16(w.y); s3 += hi16(w.y); }
        s0 += __shfl_xor(s0, 16); s1 += __shfl_xor(s1, 16); s2 += __shfl_xor(s2, 16); s3 += __shfl_xor(s3, 16);
        s0 += __shfl_xor(s0, 32); s1 += __shfl_xor(s1, 32); s2 += __shfl_xor(s2, 32); s3 += __shfl_xor(s3, 32);
        if (rq == 0) { f32x4 o; o.x = s0 * (1.0f / 256.0f); o.y = s1 * (1.0f / 256.0f); o.z = s2 * (1.0f / 256.0f); o.w = s3 * (1.0f / 256.0f); *(f32x4*)(KMEAN + (size_t)it * 64 + 4 * d4) = o; }
    }
}
__device__ __forceinline__ void unpack8(const u32x4 w, float* f) { f[0] = lo16(w.x); f[1] = hi16(w.x); f[2] = lo16(w.y); f[3] = hi16(w.y); f[4] = lo16(w.z); f[5] = hi16(w.z); f[6] = lo16(w.w); f[7] = hi16(w.w); }
__device__ __forceinline__ void moba_naive(const Ctx& C, const bf16* PROJ, const float* KMEAN, bf16* MIX) {
    for (int idx = C.gtid; idx < 2 * 8 * SEQ; idx += C.nthr) {
        const int t = idx & (SEQ - 1), bh = idx >> 13, h = bh & 7, b = bh >> 3, row = b * SEQ + t, qb = t >> 8;
        float q[64];
        { const u32x4* qp = (const u32x4*)(PROJ + (size_t)row * 2048 + h * 64);
#pragma unroll
          for (int i = 0; i < 8; ++i) unpack8(qp[i], q + 8 * i); }
        float b0 = -INFINITY, b1 = -INFINITY, b2 = -INFINITY; int i0 = -1, i1 = -1, i2 = -1;
        const float* km = KMEAN + (size_t)bh * 32 * 64;
        for (int j = 0; j < qb; ++j) { float s = 0.f;
#pragma unroll
            for (int d = 0; d < 64; ++d) s += q[d] * km[j * 64 + d];
            if (s > b0) { b2 = b1; i2 = i1; b1 = b0; i1 = i0; b0 = s; i0 = j; } else if (s > b1) { b2 = b1; i2 = i1; b1 = s; i1 = j; } else if (s > b2) { b2 = s; i2 = j; } }
        float m = -INFINITY, l = 0.f, o[64];
#pragma unroll
        for (int d = 0; d < 64; ++d) o[d] = 0.f;
        for (int si = 0; si < 4; ++si) {
            const int blk = si == 0 ? i0 : si == 1 ? i1 : si == 2 ? i2 : qb;
            if (blk < 0) continue;
            const int nk = (si == 3) ? (t - qb * 256 + 1) : 256;
            const bf16* kp = PROJ + (size_t)(b * SEQ + blk * 256) * 2048 + 512 + h * 64;
            for (int kk = 0; kk < nk; ++kk) {
                const u32x4* kr = (const u32x4*)(kp + (size_t)kk * 2048); const u32x4* vr = (const u32x4*)(kp + (size_t)kk * 2048 + 512);
                float s = 0.f;
#pragma unroll
                for (int i = 0; i < 8; ++i) { float f[8]; unpack8(kr[i], f);
#pragma unroll
                    for (int e = 0; e < 8; ++e) s += q[8 * i + e] * f[e]; }
                s *= 0.125f;
                const float mn = fmaxf(m, s), corr = __expf(m - mn), p = __expf(s - mn);
                l = l * corr + p; m = mn;
#pragma unroll
                for (int i = 0; i < 8; ++i) { float f[8]; unpack8(vr[i], f);
#pragma unroll
                    for (int e = 0; e < 8; ++e) o[8 * i + e] = o[8 * i + e] * corr + p * f[e]; }
            }
        }
        const float il = 1.0f / l; u32x4* op = (u32x4*)(MIX + (size_t)row * 1024 + h * 64);
#pragma unroll
        for (int i = 0; i < 8; ++i) { u32x4 w; w.x = pk2(o[8 * i] * il, o[8 * i + 1] * il); w.y = pk2(o[8 * i + 2] * il, o[8 * i + 3] * il); w.z = pk2(o[8 * i + 4] * il, o[8 * i + 5] * il); w.w = pk2(o[8 * i + 6] * il, o[8 * i + 7] * il); op[i] = w; }
    }
}
__device__ __forceinline__ void pool_linear_naive(const Ctx& C, const bf16* POOLED, const float* pool_w, const float* pool_scale, bf16* MIX) {
    for (size_t idx = C.gtid; idx < (size_t)NT * 512; idx += C.nthr) {
        const int co = (int)(idx & 511), row = (int)(idx >> 9), g = co >> 7, d = co & 127;
        const bf16* pp = POOLED + (size_t)row * 512 + g * 128; const float* w = pool_w + (size_t)g * 128 * 128 + d; float s = 0.f;
        for (int c = 0; c < 128; ++c) s += bf2f(pp[c]) * w[(size_t)c * 128];
        MIX[(size_t)row * 1024 + 512 + co] = (bf16)f2bf(s * pool_scale[co]);
    }
}
__device__ __forceinline__ void xattn_naive(const Ctx& C, const bf16* QX, const bf16* KVX, bf16* OX) {
    LAS float* qs = (LAS float*)(C.lds + C.wave * 2048); LAS float* ps = qs + 256; const int lane = C.lane;
    for (int it = C.gw; it < NT * 4; it += C.ngw) {
        const int row = it >> 2, hd = it & 3, b = row >> 13;
        { const u32x2 w = *((const u32x2*)(QX + (size_t)row * 1024 + hd * 256) + lane); qs[4 * lane] = lo16(w.x); qs[4 * lane + 1] = hi16(w.x); qs[4 * lane + 2] = lo16(w.y); qs[4 * lane + 3] = hi16(w.y); }
        LDS_WAIT();
        float s[4];
#pragma unroll
        for (int i = 0; i < 4; ++i) { const int j = lane + 64 * i; const u32x4* kr = (const u32x4*)(KVX + (size_t)(b * NMEM + j) * 2048 + hd * 256); float acc = 0.f;
            for (int d8 = 0; d8 < 32; ++d8) { float f[8]; unpack8(kr[d8], f); const f32x4 qa = *(const LAS f32x4*)(qs + 8 * d8), qb = *(const LAS f32x4*)(qs + 8 * d8 + 4);
                acc += f[0] * qa.x + f[1] * qa.y + f[2] * qa.z + f[3] * qa.w + f[4] * qb.x + f[5] * qb.y + f[6] * qb.z + f[7] * qb.w; }
            s[i] = acc * 0.0625f; }
        const float mx = wave_max(fmaxf(fmaxf(s[0], s[1]), fmaxf(s[2], s[3])));
        float p[4], sum = 0.f;
#pragma unroll
        for (int i = 0; i < 4; ++i) { p[i] = __expf(s[i] - mx); sum += p[i]; }
        sum = wave_sum(sum); const float inv = 1.0f / sum;
#pragma unroll
        for (int i = 0; i < 4; ++i) ps[lane + 64 * i] = p[i] * inv;
        LDS_WAIT();
        float o0 = 0.f, o1 = 0.f, o2 = 0.f, o3 = 0.f; const bf16* vb = KVX + (size_t)(b * NMEM) * 2048 + 1024 + hd * 256 + 4 * lane;
        for (int j = 0; j < 256; ++j) { const float pj = ps[j]; const u32x2 w = *(const u32x2*)(vb + (size_t)j * 2048); o0 += pj * lo16(w.x); o1 += pj * hi16(w.x); o2 += pj * lo16(w.y); o3 += pj * hi16(w.y); }
        u32x2 w; w.x = pk2(o0, o1); w.y = pk2(o2, o3); *((u32x2*)(OX + (size_t)row * 1024 + hd * 256) + lane) = w;
        LDS_WAIT();
    }
}
__device__ __forceinline__ void ffn_act(const Ctx& C, const bf16* HUP, const float* cw, bf16* ACT, int hb) {
    for (int idx = C.gtid; idx < (SEQ / 8) * 352; idx += C.nthr) {
        const int c8 = idx % 352, rb = idx / 352, c = c8 * 8, t0 = rb * 8;
        float wg[3][8], wu[3][8];
#pragma unroll
        for (int k = 0; k < 3; ++k) { const f32x4 a0 = *(const f32x4*)(cw + (size_t)k * DFF2 + c), a1 = *(const f32x4*)(cw + (size_t)k * DFF2 + c + 4), b0 = *(const f32x4*)(cw + (size_t)k * DFF2 + DFF + c), b1 = *(const f32x4*)(cw + (size_t)k * DFF2 + DFF + c + 4);
            wg[k][0] = a0.x; wg[k][1] = a0.y; wg[k][2] = a0.z; wg[k][3] = a0.w; wg[k][4] = a1.x; wg[k][5] = a1.y; wg[k][6] = a1.z; wg[k][7] = a1.w;
            wu[k][0] = b0.x; wu[k][1] = b0.y; wu[k][2] = b0.z; wu[k][3] = b0.w; wu[k][4] = b1.x; wu[k][5] = b1.y; wu[k][6] = b1.z; wu[k][7] = b1.w; }
        float g0[8], g1[8], u0[8], u1[8];
        if (t0 >= 2) { unpack8(*(const u32x4*)(HUP + (size_t)(t0 - 2) * DFF2 + c), g0); unpack8(*(const u32x4*)(HUP + (size_t)(t0 - 2) * DFF2 + DFF + c), u0);
                       unpack8(*(const u32x4*)(HUP + (size_t)(t0 - 1) * DFF2 + c), g1); unpack8(*(const u32x4*)(HUP + (size_t)(t0 - 1) * DFF2 + DFF + c), u1); }
        else {
#pragma unroll
            for (int e = 0; e < 8; ++e) { g0[e] = 0.f; g1[e] = 0.f; u0[e] = 0.f; u1[e] = 0.f; } }
#pragma unroll
        for (int r = 0; r < 8; ++r) {
            float g2[8], u2[8]; unpack8(*(const u32x4*)(HUP + (size_t)(t0 + r) * DFF2 + c), g2); unpack8(*(const u32x4*)(HUP + (size_t)(t0 + r) * DFF2 + DFF + c), u2);
            float o[8];
#pragma unroll
            for (int e = 0; e < 8; ++e) { const float gv = wg[0][e] * g0[e] + wg[1][e] * g1[e] + wg[2][e] * g2[e], uv = wu[0][e] * u0[e] + wu[1][e] * u1[e] + wu[2][e] * u2[e]; o[e] = silu_f(gv) * uv; }
            u32x4 w; w.x = pk2(o[0], o[1]); w.y = pk2(o[2], o[3]); w.z = pk2(o[4], o[5]); w.w = pk2(o[6], o[7]);
            *(u32x4*)(ACT + (size_t)(hb * SEQ + t0 + r) * DFF + c) = w;
#pragma unroll
            for (int e = 0; e < 8; ++e) { g0[e] = g1[e]; g1[e] = g2[e]; u0[e] = u1[e]; u1[e] = u2[e]; }
        }
    }
}
__device__ __forceinline__ void l1_prep_naive(const Ctx& C, ArgsP a, const bf16* Z, const bf16* QKV, bf16* VN, bf16* QN, bf16* KN, bf16* VV) {
    const int lane = C.lane;
    const float* lng = INP(a, I_SGUG); const float* lnb = INP(a, I_SGUB); const float* cw = INP(a, I_DNCONV);
    for (int row = C.gw; row < NT; row += C.ngw) {
        float f[8]; unpack8(*((const u32x4*)(Z + (size_t)row * 1024 + 512) + lane), f);
        float s = 0.f;
#pragma unroll
        for (int e = 0; e < 8; ++e) s += f[e];
        const float mu = wave_sum(s) * (1.0f / 512.0f); float q = 0.f;
#pragma unroll
        for (int e = 0; e < 8; ++e) { f[e] -= mu; q += f[e] * f[e]; }
        const float rstd = 1.0f / sqrtf(wave_sum(q) * (1.0f / 512.0f) + EPS);
        const f32x4 g0 = *((const f32x4*)lng + 2 * lane), g1 = *((const f32x4*)lng + 2 * lane + 1), c0 = *((const f32x4*)lnb + 2 * lane), c1 = *((const f32x4*)lnb + 2 * lane + 1);
        u32x4 w; w.x = pk2(f[0] * rstd * g0.x + c0.x, f[1] * rstd * g0.y + c0.y); w.y = pk2(f[2] * rstd * g0.z + c0.z, f[3] * rstd * g0.w + c0.w);
        w.z = pk2(f[4] * rstd * g1.x + c1.x, f[5] * rstd * g1.y + c1.y); w.w = pk2(f[6] * rstd * g1.z + c1.z, f[7] * rstd * g1.w + c1.w);
        { bf16* vt = VN + ((size_t)(row >> 7) * 512 + 8 * lane) * 128 + (row & 127);
          vt[0] = (bf16)(w.x & 0xffffu); vt[128] = (bf16)(w.x >> 16); vt[256] = (bf16)(w.y & 0xffffu); vt[384] = (bf16)(w.y >> 16);
          vt[512] = (bf16)(w.z & 0xffffu); vt[640] = (bf16)(w.z >> 16); vt[768] = (bf16)(w.w & 0xffffu); vt[896] = (bf16)(w.w >> 16); }
    }
    for (int it = C.gw; it < NT * 4; it += C.ngw) {
        const int row = it >> 2, hh = it & 3, tl = row & (SEQ - 1), c = hh * 128 + 2 * lane;
        float y[3][2];
#pragma unroll
        for (int s3 = 0; s3 < 3; ++s3) { const int cs = s3 * 512 + c; float a0 = 0.f, a1 = 0.f;
#pragma unroll
            for (int j = 0; j < 4; ++j) { const int ts = tl - 3 + j; if (ts < 0) continue;
                const unsigned w = *(const unsigned*)(QKV + (size_t)(row - 3 + j) * 1536 + cs); a0 += cw[j * 1536 + cs] * lo16(w); a1 += cw[j * 1536 + cs + 1] * hi16(w); }
            y[s3][0] = silu_f(a0); y[s3][1] = silu_f(a1); }
        const float rq = 1.0f / sqrtf(wave_sum(y[0][0] * y[0][0] + y[0][1] * y[0][1]) + EPS) * 0.08838834764831845f;
        const float rk = 1.0f / sqrtf(wave_sum(y[1][0] * y[1][0] + y[1][1] * y[1][1]) + EPS);
        *(unsigned*)(QN + (size_t)row * 512 + c) = pk2(y[0][0] * rq, y[0][1] * rq);
        *(unsigned*)(KN + (size_t)row * 512 + c) = pk2(y[1][0] * rk, y[1][1] * rk);
        *(unsigned*)(VV + (size_t)row * 512 + c) = pk2(y[2][0], y[2][1]);
    }
}
__device__ __forceinline__ void sgu_naive(const Ctx& C, ArgsP a, const bf16* Z, const bf16* VN, bf16* MIX, int blk0, int nblk) {
    const float* sw = INP(a, I_SGUW); const float* sb = INP(a, I_SGUBS);
    const size_t start = (size_t)(blockIdx.x - blk0) * 512 + C.tid, stride = (size_t)nblk * 512;
    for (size_t idx = start; idx < (size_t)NT * 512; idx += stride) {
        const int ch = (int)(idx & 511), row = (int)(idx >> 9), g = ch >> 7, tl = row & 127, r0 = row & ~127;
        const float* w = sw + (size_t)(g * 128 + tl) * 128; const bf16* vp = VN + (size_t)r0 * 512 + ch; float s = 0.f;
        for (int k = 0; k <= tl; ++k) s += w[k] * bf2f(vp[(size_t)k * 512]);
        s += sb[g * 128 + tl];
        MIX[(size_t)row * 1024 + ch] = (bf16)f2bf(bf2f(Z[(size_t)row * 1024 + ch]) * s);
    }
}
__device__ __forceinline__ void dn_recurrent(const Ctx& C, const bf16* QN, const bf16* KN, const bf16* VV, const float* BG, float* O, int bh) {
    const int b = bh >> 2, hh = bh & 3, dv = C.tid & 127, g4 = C.tid >> 7;
    LAS float* red1 = (LAS float*)C.lds; LAS float* red2 = red1 + 512;
    float S[32];
#pragma unroll
    for (int i = 0; i < 32; ++i) S[i] = 0.f;
    for (int t = 0; t < SEQ; ++t) {
        const size_t row = (size_t)b * SEQ + t;
        const u32x4* kp = (const u32x4*)(KN + row * 512 + hh * 128 + 32 * g4); const u32x4* qp = (const u32x4*)(QN + row * 512 + hh * 128 + 32 * g4);
        float kk[32], qq[32];
#pragma unroll
        for (int i = 0; i < 4; ++i) { unpack8(kp[i], kk + 8 * i); unpack8(qp[i], qq + 8 * i); }
        const float vv = bf2f(VV[row * 512 + hh * 128 + dv]), beta = BG[row * 8 + hh], av = __expf(BG[row * 8 + 4 + hh]);
        float part = 0.f;
#pragma unroll
        for (int i = 0; i < 32; ++i) part += kk[i] * S[i];
        red1[g4 * 128 + dv] = part; __syncthreads();
        const float kS = (red1[dv] + red1[128 + dv]) + (red1[256 + dv] + red1[384 + dv]);
        const float vnew = beta * (vv - av * kS);
        float op = 0.f;
#pragma unroll
        for (int i = 0; i < 32; ++i) { S[i] = av * S[i] + kk[i] * vnew; op += qq[i] * S[i]; }
        red2[g4 * 128 + dv] = op; __syncthreads();
        if (g4 == 0) O[row * 512 + hh * 128 + dv] = (red2[dv] + red2[128 + dv]) + (red2[256 + dv] + red2[384 + dv]);
    }
    __syncthreads();
}
__device__ __forceinline__ void dn_out_gate(const Ctx& C, ArgsP a, const float* O, const bf16* GATE, bf16* MIX) {
    const float* ng = INP(a, I_DNNG); const int lane = C.lane;
    const f32x4 n0 = *(const f32x4*)(ng + ((8 * lane) & 127)), n1 = *(const f32x4*)(ng + ((8 * lane) & 127) + 4);
    for (int row = C.gw; row < NT; row += C.ngw) {
        const f32x4 o0 = *((const f32x4*)(O + (size_t)row * 512) + 2 * lane), o1 = *((const f32x4*)(O + (size_t)row * 512) + 2 * lane + 1);
        float ss = ((o0.x * o0.x + o0.y * o0.y) + (o0.z * o0.z + o0.w * o0.w)) + ((o1.x * o1.x + o1.y * o1.y) + (o1.z * o1.z + o1.w * o1.w));
        ss += __shfl_xor(ss, 1); ss += __shfl_xor(ss, 2); ss += __shfl_xor(ss, 4); ss += __shfl_xor(ss, 8);
        const float r = 1.0f / sqrtf(ss * (1.0f / 128.0f) + EPS);
        float g[8]; unpack8(*((const u32x4*)(GATE + (size_t)row * 512) + lane), g);
        u32x4 w; w.x = pk2(o0.x * r * n0.x * silu_f(g[0]), o0.y * r * n0.y * silu_f(g[1])); w.y = pk2(o0.z * r * n0.z * silu_f(g[2]), o0.w * r * n0.w * silu_f(g[3]));
        w.z = pk2(o1.x * r * n1.x * silu_f(g[4]), o1.y * r * n1.y * silu_f(g[5])); w.w = pk2(o1.z * r * n1.z * silu_f(g[6]), o1.w * r * n1.w * silu_f(g[7]));
        *((u32x4*)(MIX + (size_t)row * 1024 + 512) + lane) = w;
    }
}
typedef short bf16x8 __attribute__((ext_vector_type(8)));
#define MFMA16(a, b, c) __builtin_amdgcn_mfma_f32_16x16x32_bf16((a), (b), (c), 0, 0, 0)
__device__ __forceinline__ float rdlane(float v, int i) { return __uint_as_float(__builtin_amdgcn_readlane(__float_as_uint(v), i)); }
#define WG_BAR() do { asm volatile("s_waitcnt vmcnt(0) lgkmcnt(0)" ::: "memory"); __builtin_amdgcn_s_barrier(); asm volatile("" ::: "memory"); } while (0)
#define LDS_BAR() do { asm volatile("s_waitcnt lgkmcnt(0)" ::: "memory"); __builtin_amdgcn_s_barrier(); asm volatile("" ::: "memory"); } while (0)

#define FRAG_W(i, k)  (((((i) >> 4) * 4 + ((k) >> 5)) * 64 + (((k) >> 3) & 3) * 16 + ((i) & 15)) * 8 + ((k) & 7))
#define FRAG_QK(i, j) (((((i) >> 4) * 2 + ((j) >> 5)) * 64 + (((j) >> 3) & 3) * 16 + ((i) & 15)) * 8 + ((j) & 7))
#define FRAG_KD(d, t) ((((((d) >> 5) * 2 + (((d) >> 4) & 1)) * 2 + ((t) >> 5)) * 64 + (((t) >> 3) & 3) * 16 + ((d) & 15)) * 8 + ((t) & 7))
#define FRAG_U(i, v)  (((((v) >> 4) * 4 + ((i) >> 4)) * 64 + (((i) >> 2) & 3) * 16 + ((v) & 15)) * 4 + ((i) & 3))
__device__ __forceinline__ void dn_chunk_prep(const Ctx& C, const bf16* QN, const bf16* KN, const bf16* VV, const float* BG, bf16* U, bf16* Wm, bf16* QD, bf16* KDT, bf16* QKm, float* GL) {
    LAS float* Am = (LAS float*)(C.lds + C.wave * 16384);
    const int lane = C.lane, fr = lane & 15, fq = lane >> 4;
    for (int it4 = C.gw; it4 < 4096; it4 += C.ngw) {
        const int it = it4 >> 2, ps = it4 & 3;
        const int n = it & 127, hh = (it >> 7) & 3, b = it >> 9;
        const size_t row0 = (size_t)b * SEQ + (size_t)n * 64;
        const float beta = BG[(row0 + lane) * 8 + hh], gg = BG[(row0 + lane) * 8 + 4 + hh];
        float gc = gg;
#pragma unroll
        for (int o = 1; o < 64; o <<= 1) { const float t = __shfl_up(gc, o); if (lane >= o) gc += t; }
        const float gcl = rdlane(gc, 63);
        const bf16* Kb = KN + row0 * 512 + hh * 128; const bf16* Qb = QN + row0 * 512 + hh * 128; const bf16* Vb = VV + row0 * 512 + hh * 128;
        bf16* qkm = QKm + (size_t)it * 4096;
#pragma unroll 1
        for (int mt = 0; mt < 4; ++mt) {
            bf16x8 ak[4], aq[4];
#pragma unroll
            for (int ks = 0; ks < 4; ++ks) { ak[ks] = *(const bf16x8*)(Kb + (size_t)(16 * mt + fr) * 512 + 32 * ks + 8 * fq); aq[ks] = *(const bf16x8*)(Qb + (size_t)(16 * mt + fr) * 512 + 32 * ks + 8 * fq); }
#pragma unroll 1
            for (int nt = 0; nt < 4; ++nt) {
                const int j = 16 * nt + fr;
                if (nt > mt) {
                    if (ps == 0) {
#pragma unroll
                        for (int r = 0; r < 4; ++r) qkm[FRAG_QK(16 * mt + 4 * fq + r, j)] = 0; }
                    continue;
                }
                f32x4 ckk = {0.f, 0.f, 0.f, 0.f}, cqk = {0.f, 0.f, 0.f, 0.f};
#pragma unroll
                for (int ks = 0; ks < 4; ++ks) { const bf16x8 bk = *(const bf16x8*)(Kb + (size_t)(16 * nt + fr) * 512 + 32 * ks + 8 * fq); ckk = MFMA16(ak[ks], bk, ckk); cqk = MFMA16(aq[ks], bk, cqk); }
                const float gj = __shfl(gc, j);
#pragma unroll
                for (int r = 0; r < 4; ++r) { const int i = 16 * mt + 4 * fq + r; const float gi = __shfl(gc, i), bi = __shfl(beta, i);
                    const float dec = (i >= j) ? __expf(gi - gj) : 0.f;
                    Am[i * 64 + j] = (i > j) ? bi * ckk[r] * dec : 0.f;
                    if (ps == 0) qkm[FRAG_QK(i, j)] = (bf16)f2bf((i >= j) ? cqk[r] * dec : 0.f); }
            }
        }
        LDS_WAIT();
        { const int p = ps;
            const int c = lane + 64 * (p & 1); const bf16* src = (p < 2 ? Vb : Kb) + c; bf16* dstb = (p < 2 ? U : Wm) + (size_t)it * 8192;
            float x[64];
#pragma unroll
            for (int i = 0; i < 64; ++i) { const float bi = rdlane(beta, i), gi = rdlane(gc, i); x[i] = bf2f(src[(size_t)i * 512]) * (p < 2 ? bi : bi * __expf(gi)); if ((i & 7) == 7) __builtin_amdgcn_sched_barrier(0); }
            float Ar[64];
#pragma unroll
            for (int i = 1; i < 64; ++i) Ar[i] = Am[i * 64 + lane];
            LDS_WAIT();
#pragma unroll
            for (int i = 1; i < 64; ++i) {
                float acc = x[i];
#pragma unroll
                for (int j = 0; j < i; ++j) acc -= rdlane(Ar[i], j) * x[j];
                x[i] = acc;
            }
#pragma unroll
            for (int i = 0; i < 64; ++i) dstb[p < 2 ? FRAG_U(i, c) : FRAG_W(i, c)] = (bf16)f2bf(x[i]);
        }
        bf16* qd = QD + (size_t)it * 8192;
        if (ps == 1)
#pragma unroll 4
        for (int i = 0; i < 64; ++i) { const float e = __expf(__shfl(gc, i)); const unsigned w = *(const unsigned*)(Qb + (size_t)i * 512 + 2 * lane); *(unsigned*)(qd + FRAG_W(i, 2 * lane)) = pk2(lo16(w) * e, hi16(w) * e); }
        bf16* kdt = KDT + (size_t)it * 8192; const float ek = __expf(gcl - gc);
        if (ps == 2)
#pragma unroll 2
        for (int d8 = 0; d8 < 16; ++d8) { float f[8]; unpack8(*(const u32x4*)(Kb + (size_t)lane * 512 + 8 * d8), f);
#pragma unroll
            for (int e = 0; e < 8; ++e) kdt[FRAG_KD(8 * d8 + e, lane)] = (bf16)f2bf(f[e] * ek); }
        if (ps == 3 && lane == 0) GL[it] = __expf(gcl);
        LDS_WAIT();
    }
}
constexpr int SB_LD = 136, VN_LD = 72;
__device__ __forceinline__ void dn_scan(const Ctx& C, const bf16* U, const bf16* Wm, const bf16* QD, const bf16* KDT, const bf16* QKm, const float* GL, float* O, int it) {
    const int bh = it & 7, sl = it >> 3, hh = bh & 3, b = bh >> 2, dv0 = sl * 16;
    LAS bf16* SbT = (LAS bf16*)C.lds;
    LAS bf16* VnT = (LAS bf16*)(C.lds + 16384);
    LAS float* glb = (LAS float*)(C.lds + 24576);
    for (int i = C.tid; i < 2 * 16 * SB_LD / 2; i += 512) ((LAS unsigned*)SbT)[i] = 0u;
    if (C.tid < 128) glb[C.tid] = GL[(size_t)(it & 7) * 128 + C.tid];
    __syncthreads();
    const int w = C.wave, lane = C.lane, fr = lane & 15, fq = lane >> 4;
    f32x4 S0 = {0.f, 0.f, 0.f, 0.f}, S1 = S0;
    const size_t item0 = (size_t)bh * 128;
    if (w < 4) {
        bf16x8 cw[4][4], ck[4][4]; float cu[4][4];
#define DN_LOAD_A(set, st) do { const size_t it_ = item0 + (st); \
            const bf16* wp_ = Wm + it_ * 8192 + (size_t)(w * 4 * 64 + lane) * 8; const bf16* up_ = U + it_ * 8192 + (size_t)((sl * 4 + w) * 64 + lane) * 4; const bf16* kp_ = KDT + it_ * 8192 + (size_t)(w * 4 * 64 + lane) * 8; \
            _Pragma("unroll") for (int ks = 0; ks < 4; ++ks) cw[set][ks] = *(const bf16x8*)(wp_ + 512 * ks); \
            { const u32x2 uw_ = *(const u32x2*)up_; cu[set][0] = lo16(uw_.x); cu[set][1] = hi16(uw_.x); cu[set][2] = lo16(uw_.y); cu[set][3] = hi16(uw_.y); } \
            ck[set][0] = *(const bf16x8*)(kp_); ck[set][1] = *(const bf16x8*)(kp_ + 512); ck[set][2] = *(const bf16x8*)(kp_ + 1024); ck[set][3] = *(const bf16x8*)(kp_ + 1536); } while (0)
        DN_LOAD_A(0, 0); DN_LOAD_A(1, 1); DN_LOAD_A(2, 2);
        for (int n0 = 0; n0 < 128; n0 += 4) {
#pragma unroll
            for (int k = 0; k < 4; ++k) {
                const int n = n0 + k, ns = (n + 3 < 128) ? n + 3 : 127;
                DN_LOAD_A((k + 3) & 3, ns);
                LAS bf16* Sc = SbT + (k & 1) * 16 * SB_LD; LAS bf16* Sn = SbT + ((k & 1) ^ 1) * 16 * SB_LD;
                f32x4 t1 = {0.f, 0.f, 0.f, 0.f};
                { bf16x8 sb[4];
#pragma unroll
                  for (int ks = 0; ks < 4; ++ks) sb[ks] = *(const LAS bf16x8*)(Sc + fr * SB_LD + 32 * ks + 8 * fq);
                  __builtin_amdgcn_sched_barrier(0);
#pragma unroll
                  for (int ks = 0; ks < 4; ++ks) t1 = MFMA16(cw[k][ks], sb[ks], t1); }
                u32x2 pw; pw.x = pk2(cu[k][0] - t1[0], cu[k][1] - t1[1]); pw.y = pk2(cu[k][2] - t1[2], cu[k][3] - t1[3]);
                *(LAS u32x2*)(VnT + fr * VN_LD + 16 * w + 4 * fq) = pw;
                LDS_BAR();
                bf16x8 vb[2];
                { const float gl = glb[n]; S0 = S0 * gl; S1 = S1 * gl; }
#pragma unroll
                for (int ks = 0; ks < 2; ++ks) vb[ks] = *(const LAS bf16x8*)(VnT + fr * VN_LD + 32 * ks + 8 * fq);
                __builtin_amdgcn_sched_barrier(0);
#pragma unroll
                for (int ks = 0; ks < 2; ++ks) { S0 = MFMA16(ck[k][ks], vb[ks], S0); S1 = MFMA16(ck[k][2 + ks], vb[ks], S1); }
                u32x2 s0; s0.x = pk2(S0[0], S0[1]); s0.y = pk2(S0[2], S0[3]); u32x2 s1; s1.x = pk2(S1[0], S1[1]); s1.y = pk2(S1[2], S1[3]);
                *(LAS u32x2*)(Sn + fr * SB_LD + 32 * w + 4 * fq) = s0; *(LAS u32x2*)(Sn + fr * SB_LD + 32 * w + 16 + 4 * fq) = s1;
                LDS_BAR();
            }
        }
#undef DN_LOAD_A
    } else {
        const int w2 = w - 4;
        bf16x8 cq[4][4], cm[4][2];
#define DN_LOAD_B(set, st) do { const size_t it_ = item0 + (st); const bf16* qp_ = QD + it_ * 8192 + (size_t)(w2 * 4 * 64 + lane) * 8; const bf16* mp_ = QKm + it_ * 4096 + (size_t)(w2 * 2 * 64 + lane) * 8; \
            _Pragma("unroll") for (int ks = 0; ks < 4; ++ks) cq[set][ks] = *(const bf16x8*)(qp_ + 512 * ks); \
            cm[set][0] = *(const bf16x8*)(mp_); cm[set][1] = *(const bf16x8*)(mp_ + 512); } while (0)
        DN_LOAD_B(0, 0); DN_LOAD_B(1, 1); DN_LOAD_B(2, 2);
        for (int n0 = 0; n0 < 128; n0 += 4) {
#pragma unroll
            for (int k = 0; k < 4; ++k) {
                const int n = n0 + k, ns = (n + 3 < 128) ? n + 3 : 127;
                DN_LOAD_B((k + 3) & 3, ns);
                LAS bf16* Sc = SbT + (k & 1) * 16 * SB_LD;
                f32x4 o = {0.f, 0.f, 0.f, 0.f};
                { bf16x8 sb[4];
#pragma unroll
                  for (int ks = 0; ks < 4; ++ks) sb[ks] = *(const LAS bf16x8*)(Sc + fr * SB_LD + 32 * ks + 8 * fq);
                  __builtin_amdgcn_sched_barrier(0);
#pragma unroll
                  for (int ks = 0; ks < 4; ++ks) o = MFMA16(cq[k][ks], sb[ks], o); }
                LDS_BAR();
                o = MFMA16(cm[k][0], *(const LAS bf16x8*)(VnT + fr * VN_LD + 8 * fq), o);
                o = MFMA16(cm[k][1], *(const LAS bf16x8*)(VnT + fr * VN_LD + 32 + 8 * fq), o);
                float* op = O + ((size_t)b * SEQ + (size_t)n * 64 + 16 * w2 + 4 * fq) * 512 + hh * 128 + dv0 + fr;
                op[0] = o[0]; op[512] = o[1]; op[1024] = o[2]; op[1536] = o[3];
                LDS_BAR();
            }
        }
#undef DN_LOAD_B
    }
    __syncthreads();
}
__device__ __forceinline__ int perm32k_inv(int s) { return (s < 16) ? (8 * (s >> 2) + (s & 3)) : (8 * ((s - 16) >> 2) + 4 + (s & 3)); }
__device__ __forceinline__ bf16x8 pack_p(const f32x4 a, const f32x4 b) { u32x4 w; w.x = pk2(a[0], a[1]); w.y = pk2(a[2], a[3]); w.z = pk2(b[0], b[1]); w.w = pk2(b[2], b[3]); return __builtin_bit_cast(bf16x8, w); }

__device__ __forceinline__ void xattn_mfma(const Ctx& C, const bf16* QX, const bf16* KX, const bf16* VXT, bf16* OX) {
    const int lane = C.lane, fr = lane & 15, fq = lane >> 4;
    for (int it = C.gw; it < (NT / 16) * 4; it += C.ngw) {
        const int hd = it & 3, qt = it >> 2, row0 = qt * 16, b = row0 >> 13;
        bf16x8 qf[8];
        const bf16* qp = QX + (size_t)(row0 + fr) * 1024 + hd * 256 + 8 * fq;
#pragma unroll
        for (int ks = 0; ks < 8; ++ks) qf[ks] = *(const bf16x8*)(qp + 32 * ks);
        f32x4 st[16];
        const bf16* kp = KX + (size_t)(b * NMEM + fr) * 1024 + hd * 256 + 8 * fq;
#pragma unroll
        for (int kt = 0; kt < 16; ++kt) { f32x4 acc = {0.f, 0.f, 0.f, 0.f};
#pragma unroll
            for (int ks = 0; ks < 8; ++ks) acc = MFMA16(*(const bf16x8*)(kp + (size_t)kt * 16 * 1024 + 32 * ks), qf[ks], acc);
            st[kt] = acc; }
        float mx = -INFINITY;
#pragma unroll
        for (int kt = 0; kt < 16; ++kt) mx = fmaxf(mx, fmaxf(fmaxf(st[kt][0], st[kt][1]), fmaxf(st[kt][2], st[kt][3])));
        mx = fmaxf(mx, __shfl_xor(mx, 16)); mx = fmaxf(mx, __shfl_xor(mx, 32));
        float sum = 0.f; const float mxs = mx * 0.0625f;
#pragma unroll
        for (int kt = 0; kt < 16; ++kt) {
#pragma unroll
            for (int r = 0; r < 4; ++r) { const float p = __expf(st[kt][r] * 0.0625f - mxs); st[kt][r] = p; sum += p; } }
        sum += __shfl_xor(sum, 16); sum += __shfl_xor(sum, 32);
        const float inv = 1.0f / sum;
        bf16x8 pf[8];
#pragma unroll
        for (int kk = 0; kk < 8; ++kk) pf[kk] = pack_p(st[2 * kk], st[2 * kk + 1]);
        const bf16* vp = VXT + (size_t)(hd * 256 + fr) * 512 + b * NMEM + 8 * fq;
        bf16* op = OX + (size_t)(row0 + fr) * 1024 + hd * 256 + 4 * fq;
#pragma unroll 4
        for (int dt = 0; dt < 16; ++dt) { f32x4 acc = {0.f, 0.f, 0.f, 0.f};
#pragma unroll
            for (int kk = 0; kk < 8; ++kk) acc = MFMA16(*(const bf16x8*)(vp + (size_t)dt * 16 * 512 + 32 * kk), pf[kk], acc);
            u32x2 w; w.x = pk2(acc[0] * inv, acc[1] * inv); w.y = pk2(acc[2] * inv, acc[3] * inv);
            *(u32x2*)(op + 16 * dt) = w; }
    }
}

__device__ __forceinline__ void moba_item(const bf16* PQ, const bf16* VT, const float* KMEAN, bf16* MIX, int bh, int tile, int lane) {
    const int fr = lane & 15, fq = lane >> 4, h = bh & 7, b = bh >> 3, qb = tile >> 3;
    const int row0 = b * SEQ + tile * 32;
    unsigned mask = 0u;
    if (qb > 0) {
        float q[64];
        { const u32x4* qp = (const u32x4*)(PQ + (size_t)(row0 + (lane & 31)) * 1536 + h * 64);
#pragma unroll
          for (int i = 0; i < 8; ++i) unpack8(qp[i], q + 8 * i); }
        float b0 = -INFINITY, b1 = -INFINITY, b2 = -INFINITY; int i0 = -1, i1 = -1, i2 = -1;
        const float* km = KMEAN + (size_t)bh * 32 * 64;
        for (int j = 0; j < qb; ++j) { float s = 0.f;
#pragma unroll
            for (int d = 0; d < 64; ++d) s += q[d] * km[j * 64 + d];
            if (s > b0) { b2 = b1; i2 = i1; b1 = b0; i1 = i0; b0 = s; i0 = j; } else if (s > b1) { b2 = b1; i2 = i1; b1 = s; i1 = j; } else if (s > b2) { b2 = s; i2 = j; } }
        if (i0 >= 0) mask |= 1u << i0; if (i1 >= 0) mask |= 1u << i1; if (i2 >= 0) mask |= 1u << i2;
    }
    const unsigned m0 = (unsigned)__shfl((int)mask, fr), m1 = (unsigned)__shfl((int)mask, 16 + fr);
    bf16x8 qf[2][2];
#pragma unroll
    for (int qt = 0; qt < 2; ++qt)
#pragma unroll
        for (int ks = 0; ks < 2; ++ks) qf[qt][ks] = *(const bf16x8*)(PQ + (size_t)(row0 + 16 * qt + fr) * 1536 + h * 64 + 32 * ks + 8 * fq);
    f32x4 oacc[2][4];
#pragma unroll
    for (int qt = 0; qt < 2; ++qt)
#pragma unroll
        for (int dt = 0; dt < 4; ++dt) oacc[qt][dt] = (f32x4){0.f, 0.f, 0.f, 0.f};
    float mrow[2] = {-INFINITY, -INFINITY}, lrow[2] = {0.f, 0.f};
    const int qoff0 = (tile & 7) * 32;
    for (int bi = 0; bi <= qb; ++bi) {
        const int blk = (bi == 0) ? qb : bi - 1; const bool own = (bi == 0);
        if (!own && !__any((int)(((m0 | m1) >> blk) & 1u))) continue;
        const bool s0 = own || ((m0 >> blk) & 1u), s1 = own || ((m1 >> blk) & 1u);
        for (int hf = 0; hf < 2; ++hf) {
            if (own && hf * 128 > qoff0 + 31) continue;
            const int key0 = b * SEQ + blk * 256 + hf * 128;
            f32x4 st[2][8];
            const bf16* kp = PQ + (size_t)(key0 + fr) * 1536 + 512 + h * 64 + 8 * fq;
#pragma unroll
            for (int kt = 0; kt < 8; ++kt) { const bf16x8 k0 = *(const bf16x8*)(kp + (size_t)kt * 16 * 1536), k1 = *(const bf16x8*)(kp + (size_t)kt * 16 * 1536 + 32);
#pragma unroll
                for (int qt = 0; qt < 2; ++qt) { f32x4 acc = {0.f, 0.f, 0.f, 0.f}; acc = MFMA16(k0, qf[qt][0], acc); acc = MFMA16(k1, qf[qt][1], acc); st[qt][kt] = acc; } }
            bf16x8 pf[2][4];
#pragma unroll
            for (int qt = 0; qt < 2; ++qt) {
                const bool sel = qt == 0 ? s0 : s1; const int qoff = qoff0 + 16 * qt + fr;
                float mx = -INFINITY;
#pragma unroll
                for (int kt = 0; kt < 8; ++kt)
#pragma unroll
                    for (int r = 0; r < 4; ++r) { float s = st[qt][kt][r] * 0.125f; const int kin = hf * 128 + 16 * kt + 4 * fq + r;
                        if (!sel || (own && kin > qoff)) s = -INFINITY; st[qt][kt][r] = s; mx = fmaxf(mx, s); }
                mx = fmaxf(mx, __shfl_xor(mx, 16)); mx = fmaxf(mx, __shfl_xor(mx, 32));
                const float mn = fmaxf(mrow[qt], mx);
                const float corr = __expf(mrow[qt] - mn); mrow[qt] = mn;
                float ps = 0.f;
#pragma unroll
                for (int kt = 0; kt < 8; ++kt)
#pragma unroll
                    for (int r = 0; r < 4; ++r) { const float p = __expf(st[qt][kt][r] - mn); st[qt][kt][r] = p; ps += p; }
                lrow[qt] = lrow[qt] * corr + ps;
#pragma unroll
                for (int dt = 0; dt < 4; ++dt) oacc[qt][dt] = oacc[qt][dt] * corr;
#pragma unroll
                for (int kk = 0; kk < 4; ++kk) pf[qt][kk] = pack_p(st[qt][2 * kk], st[qt][2 * kk + 1]);
            }
            const bf16* vp = VT + (size_t)(h * 64 + fr) * NT + key0 + 8 * fq;
#pragma unroll
            for (int dt = 0; dt < 4; ++dt)
#pragma unroll
                for (int kk = 0; kk < 4; ++kk) { const bf16x8 vf = *(const bf16x8*)(vp + (size_t)dt * 16 * NT + 32 * kk);
                    oacc[0][dt] = MFMA16(vf, pf[0][kk], oacc[0][dt]); oacc[1][dt] = MFMA16(vf, pf[1][kk], oacc[1][dt]); }
        }
    }
#pragma unroll
    for (int qt = 0; qt < 2; ++qt) {
        float l = lrow[qt]; l += __shfl_xor(l, 16); l += __shfl_xor(l, 32); const float inv = 1.0f / l;
        bf16* op = MIX + (size_t)(row0 + 16 * qt + fr) * 1024 + h * 64 + 4 * fq;
#pragma unroll
        for (int dt = 0; dt < 4; ++dt) { u32x2 w; w.x = pk2(oacc[qt][dt][0] * inv, oacc[qt][dt][1] * inv); w.y = pk2(oacc[qt][dt][2] * inv, oacc[qt][dt][3] * inv); *(u32x2*)(op + 16 * dt) = w; }
    }
}
__device__ __forceinline__ void moba_mfma(const Ctx& C, const bf16* PQ, const bf16* VT, const float* KMEAN, bf16* MIX) {
    for (int pi = C.gw; pi < 2048; pi += C.ngw) {
        const int bh = pi >> 7, pp = pi & 127;
        moba_item(PQ, VT, KMEAN, MIX, bh, pp, C.lane);
        moba_item(PQ, VT, KMEAN, MIX, bh, 255 - pp, C.lane);
    }
}
__device__ __forceinline__ void pool_mfma(const Ctx& C, const bf16* PQ, const bf16* PWT, const float* pool_scale, bf16* MIX) {
    const int lane = C.lane, fr = lane & 15, fq = lane >> 4;
    for (int it = C.gw; it < (NT / 16) * 4; it += C.ngw) {
        const int g = it & 3, tt = it >> 2, row = tt * 16 + fr, tl = row & (SEQ - 1), w = 2 << g;
        const int cnt = (tl + 1 < w) ? tl + 1 : w; const float icnt = 1.0f / (float)cnt;
        bf16x8 bfr[4];
#pragma unroll
        for (int ks = 0; ks < 4; ++ks) {
            const bf16* p = PQ + (size_t)row * 1536 + 1024 + g * 128 + 32 * ks + 8 * fq;
            float cur[8], s[8]; unpack8(*(const u32x4*)p, cur);
#pragma unroll
            for (int e = 0; e < 8; ++e) s[e] = cur[e];
            for (int i = 1; i < cnt; ++i) { float f[8]; unpack8(*(const u32x4*)(p - (size_t)i * 1536), f);
#pragma unroll
                for (int e = 0; e < 8; ++e) s[e] += f[e]; }
            u32x4 wv; wv.x = pk2(s[0] * icnt - cur[0], s[1] * icnt - cur[1]); wv.y = pk2(s[2] * icnt - cur[2], s[3] * icnt - cur[3]);
            wv.z = pk2(s[4] * icnt - cur[4], s[5] * icnt - cur[5]); wv.w = pk2(s[6] * icnt - cur[6], s[7] * icnt - cur[7]);
            bfr[ks] = __builtin_bit_cast(bf16x8, wv);
        }
        const bf16* ap = PWT + (size_t)g * 128 * 128 + (size_t)fr * 128 + 8 * fq;
        bf16* op = MIX + (size_t)row * 1024 + 512 + g * 128 + 4 * fq; const float* sp = pool_scale + g * 128 + 4 * fq;
#pragma unroll 2
        for (int dt = 0; dt < 8; ++dt) { f32x4 acc = {0.f, 0.f, 0.f, 0.f};
#pragma unroll
            for (int ks = 0; ks < 4; ++ks) acc = MFMA16(*(const bf16x8*)(ap + (size_t)dt * 16 * 128 + 32 * ks), bfr[ks], acc);
            const f32x4 sc = *(const f32x4*)(sp + 16 * dt);
            u32x2 wv; wv.x = pk2(acc[0] * sc.x, acc[1] * sc.y); wv.y = pk2(acc[2] * sc.z, acc[3] * sc.w); *(u32x2*)(op + 16 * dt) = wv; }
    }
}
__device__ __forceinline__ void sgu_mfma(const Ctx& C, const bf16* Z, const bf16* VNT, const bf16* Wb, const float* sgu_b, bf16* MIX, int gw0, int ngw0) {
    const int lane = C.lane, fr = lane & 15, fq = lane >> 4;
    for (int it = gw0; it < 128 * 4 * 8; it += ngw0) {
        const int tt = it & 7, g = (it >> 3) & 3, n = it >> 5, nks = (tt >> 1) + 1;
        const int row = n * 128 + tt * 16 + fr;
        bf16x8 bfr[4];
#pragma unroll
        for (int ks = 0; ks < 4; ++ks) bfr[ks] = (ks < nks) ? *(const bf16x8*)(Wb + (size_t)(g * 128 + tt * 16 + fr) * 128 + 32 * ks + 8 * fq) : (bf16x8){0, 0, 0, 0, 0, 0, 0, 0};
        const float bias = sgu_b[g * 128 + tt * 16 + fr];
        const bf16* ap = VNT + ((size_t)n * 512 + g * 128 + fr) * 128 + 8 * fq;
        const bf16* up = Z + (size_t)row * 1024 + g * 128 + 4 * fq; bf16* op = MIX + (size_t)row * 1024 + g * 128 + 4 * fq;
#pragma unroll 2
        for (int ct = 0; ct < 8; ++ct) { f32x4 acc = {0.f, 0.f, 0.f, 0.f};
#pragma unroll
            for (int ks = 0; ks < 4; ++ks) if (ks < nks) acc = MFMA16(*(const bf16x8*)(ap + (size_t)ct * 16 * 128 + 32 * ks), bfr[ks], acc);
            const u32x2 uw = *(const u32x2*)(up + 16 * ct);
            u32x2 wv; wv.x = pk2(lo16(uw.x) * (acc[0] + bias), hi16(uw.x) * (acc[1] + bias)); wv.y = pk2(lo16(uw.y) * (acc[2] + bias), hi16(uw.y) * (acc[3] + bias)); *(u32x2*)(op + 16 * ct) = wv; }
    }
}
__device__ __forceinline__ void sgu_w_convert(const Ctx& C, const float* sw, bf16* Wb) {
    for (int idx = C.gtid; idx < 4 * 128 * 128; idx += C.nthr) { const int s = idx & 127, t = (idx >> 7) & 127; Wb[idx] = (bf16)((s <= t) ? f2bf(sw[idx]) : 0u); }
}
constexpr int MK_LD = 72, MV_LD = 136;
constexpr int MK_BYTES = 128 * MK_LD * 2, MV_BYTES = 64 * MV_LD * 2;
__device__ __forceinline__ void moba_wg_block(const Ctx& C, const bf16* PQ, const bf16* VT, const float* KMEAN, bf16* MIX, int bh, int qb) {
    const int lane = C.lane, fr = lane & 15, fq = lane >> 4, h = bh & 7, b = bh >> 3, w = C.wave, tid = C.tid;
    const int tile = qb * 8 + w, row0 = b * SEQ + tile * 32;
    LAS bf16* Kb0 = (LAS bf16*)C.lds; LAS bf16* Vb0 = (LAS bf16*)(C.lds + 2 * MK_BYTES);
    unsigned mask = 0u;
    if (qb > 0) {
        float q[64];
        { const u32x4* qp = (const u32x4*)(PQ + (size_t)(row0 + (lane & 31)) * 1536 + h * 64);
#pragma unroll
          for (int i = 0; i < 8; ++i) unpack8(qp[i], q + 8 * i); }
        float b0 = -INFINITY, b1 = -INFINITY, b2 = -INFINITY; int i0 = -1, i1 = -1, i2 = -1;
        const float* km = KMEAN + (size_t)bh * 32 * 64;
        for (int j = 0; j < qb; ++j) { float s = 0.f;
#pragma unroll
            for (int d = 0; d < 64; ++d) s += q[d] * km[j * 64 + d];
            if (s > b0) { b2 = b1; i2 = i1; b1 = b0; i1 = i0; b0 = s; i0 = j; } else if (s > b1) { b2 = b1; i2 = i1; b1 = s; i1 = j; } else if (s > b2) { b2 = s; i2 = j; } }
        if (i0 >= 0) mask |= 1u << i0; if (i1 >= 0) mask |= 1u << i1; if (i2 >= 0) mask |= 1u << i2;
    }
    const unsigned m0 = (unsigned)__shfl((int)mask, fr), m1 = (unsigned)__shfl((int)mask, 16 + fr);
    bf16x8 qf[2][2];
#pragma unroll
    for (int qt = 0; qt < 2; ++qt)
#pragma unroll
        for (int ks = 0; ks < 2; ++ks) qf[qt][ks] = *(const bf16x8*)(PQ + (size_t)(row0 + 16 * qt + fr) * 1536 + h * 64 + 32 * ks + 8 * fq);
    f32x4 oacc[2][4];
#pragma unroll
    for (int qt = 0; qt < 2; ++qt)
#pragma unroll
        for (int dt = 0; dt < 4; ++dt) oacc[qt][dt] = (f32x4){0.f, 0.f, 0.f, 0.f};
    float mrow[2] = {-INFINITY, -INFINITY}, lrow[2] = {0.f, 0.f};
    const int qoff0 = w * 32;
    const int kr = tid >> 3, kc = tid & 7, vr = tid >> 4, vc = tid & 15;
    const int nh = 2 * (qb + 1);
    u32x4 kq0, kq1, vq0, vq1;
#define MOBA_KEY0(i) (b * SEQ + (((i) < 2) ? qb : (((i) - 2) >> 1)) * 256 + ((i) & 1) * 128)
#define MOBA_GLOAD(i) do { const int k0_ = MOBA_KEY0(i); \
        kq0 = *(const u32x4*)(PQ + (size_t)(k0_ + kr) * 1536 + 512 + h * 64 + 8 * kc); kq1 = *(const u32x4*)(PQ + (size_t)(k0_ + kr + 64) * 1536 + 512 + h * 64 + 8 * kc); \
        vq0 = *(const u32x4*)(VT + (size_t)(h * 64 + vr) * NT + k0_ + 8 * vc); vq1 = *(const u32x4*)(VT + (size_t)(h * 64 + vr + 32) * NT + k0_ + 8 * vc); } while (0)
#define MOBA_LSTORE(buf) do { LAS bf16* kb_ = Kb0 + (buf) * (MK_BYTES / 2); LAS bf16* vb_ = Vb0 + (buf) * (MV_BYTES / 2); \
        *(LAS u32x4*)(kb_ + kr * MK_LD + 8 * kc) = kq0; *(LAS u32x4*)(kb_ + (kr + 64) * MK_LD + 8 * kc) = kq1; \
        *(LAS u32x4*)(vb_ + vr * MV_LD + 8 * vc) = vq0; *(LAS u32x4*)(vb_ + (vr + 32) * MV_LD + 8 * vc) = vq1; } while (0)
    MOBA_GLOAD(0); MOBA_LSTORE(0);
    WG_BAR();
    for (int i = 0; i < nh; ++i) {
        if (i + 1 < nh) MOBA_GLOAD(i + 1);
        const bool own = i < 2; const int blk = own ? qb : ((i - 2) >> 1), hf = i & 1;
        const bool s0 = own || ((m0 >> blk) & 1u), s1 = own || ((m1 >> blk) & 1u);
        const bool need = own ? !(hf * 128 > qoff0 + 31) : (__any((int)(((m0 | m1) >> blk) & 1u)) != 0);
        if (need) {
            const LAS bf16* Kb = Kb0 + (i & 1) * (MK_BYTES / 2); const LAS bf16* Vb = Vb0 + (i & 1) * (MV_BYTES / 2);
            f32x4 st[2][8];
            __builtin_amdgcn_s_setprio(1);
#pragma unroll
            for (int kt = 0; kt < 8; ++kt) { const bf16x8 k0 = *(const LAS bf16x8*)(Kb + (16 * kt + fr) * MK_LD + 8 * fq), k1 = *(const LAS bf16x8*)(Kb + (16 * kt + fr) * MK_LD + 32 + 8 * fq);
#pragma unroll
                for (int qt = 0; qt < 2; ++qt) { f32x4 acc = {0.f, 0.f, 0.f, 0.f}; acc = MFMA16(k0, qf[qt][0], acc); acc = MFMA16(k1, qf[qt][1], acc); st[qt][kt] = acc; } }
            __builtin_amdgcn_s_setprio(0);
            bf16x8 pf[2][4];
            constexpr float SC2 = 0.125f * 1.4426950408889634f;
#pragma unroll
            for (int qt = 0; qt < 2; ++qt) {
                const bool sel = qt == 0 ? s0 : s1; const int qoff = qoff0 + 16 * qt + fr;
                float mx = -INFINITY;
                if (own) {
#pragma unroll
                    for (int kt = 0; kt < 8; ++kt)
#pragma unroll
                        for (int r = 0; r < 4; ++r) { const int kin = hf * 128 + 16 * kt + 4 * fq + r; if (kin > qoff) st[qt][kt][r] = -INFINITY; }
                }
#pragma unroll
                for (int kt = 0; kt < 8; ++kt) mx = fmaxf(mx, fmaxf(fmaxf(st[qt][kt][0], st[qt][kt][1]), fmaxf(st[qt][kt][2], st[qt][kt][3])));
                mx *= SC2;
                if (!sel) mx = -INFINITY;
                mx = fmaxf(mx, __shfl_xor(mx, 16)); mx = fmaxf(mx, __shfl_xor(mx, 32));
                const float mn = fmaxf(mrow[qt], mx);
                const float corr = __builtin_amdgcn_exp2f(mrow[qt] - mn); mrow[qt] = mn;
                float ps = 0.f;
#pragma unroll
                for (int kt = 0; kt < 8; ++kt)
#pragma unroll
                    for (int r = 0; r < 4; ++r) { const float p = __builtin_amdgcn_exp2f(__builtin_fmaf(st[qt][kt][r], SC2, -mn)); st[qt][kt][r] = p; ps += p; }
                if (!sel) ps = 0.f;
                lrow[qt] = lrow[qt] * corr + ps;
#pragma unroll
                for (int dt = 0; dt < 4; ++dt) oacc[qt][dt] = oacc[qt][dt] * corr;
#pragma unroll
                for (int kk = 0; kk < 4; ++kk) { bf16x8 pv = pack_p(st[qt][2 * kk], st[qt][2 * kk + 1]); if (!sel) pv = (bf16x8){0, 0, 0, 0, 0, 0, 0, 0}; pf[qt][kk] = pv; }
            }
            __builtin_amdgcn_s_setprio(1);
#pragma unroll
            for (int dt = 0; dt < 4; ++dt)
#pragma unroll
                for (int kk = 0; kk < 4; ++kk) { const bf16x8 vf = *(const LAS bf16x8*)(Vb + (16 * dt + fr) * MV_LD + 32 * kk + 8 * fq);
                    oacc[0][dt] = MFMA16(vf, pf[0][kk], oacc[0][dt]); oacc[1][dt] = MFMA16(vf, pf[1][kk], oacc[1][dt]); }
            __builtin_amdgcn_s_setprio(0);
        }
        if (i + 1 < nh) MOBA_LSTORE((i + 1) & 1);
        WG_BAR();
    }
#undef MOBA_KEY0
#undef MOBA_GLOAD
#undef MOBA_LSTORE
#pragma unroll
    for (int qt = 0; qt < 2; ++qt) {
        float l = lrow[qt]; l += __shfl_xor(l, 16); l += __shfl_xor(l, 32); const float inv = 1.0f / l;
        bf16* op = MIX + (size_t)(row0 + 16 * qt + fr) * 1024 + h * 64 + 4 * fq;
#pragma unroll
        for (int dt = 0; dt < 4; ++dt) { u32x2 wv; wv.x = pk2(oacc[qt][dt][0] * inv, oacc[qt][dt][1] * inv); wv.y = pk2(oacc[qt][dt][2] * inv, oacc[qt][dt][3] * inv); *(u32x2*)(op + 16 * dt) = wv; }
    }
}
__device__ __forceinline__ void moba_wg(const Ctx& C, const bf16* PQ, const bf16* VT, const float* KMEAN, bf16* MIX) {
    for (int it = blockIdx.x; it < 256; it += C.G) {
        const int bh = it & 15, pp = it >> 4;
        moba_wg_block(C, PQ, VT, KMEAN, MIX, bh, 31 - pp);
        moba_wg_block(C, PQ, VT, KMEAN, MIX, bh, pp);
    }
}
constexpr int XK_LD = 264, XV_LD = 136;
constexpr int XK_BYTES = 128 * XK_LD * 2, XV_BYTES = 256 * XV_LD * 2;
static_assert(XK_BYTES + XV_BYTES <= LDS_BYTES - 256, "xattn LDS");
__device__ __forceinline__ void xattn_wg(const Ctx& C, const bf16* QX, const bf16* KX, const bf16* VXT, bf16* OX) {
    const int lane = C.lane, fr = lane & 15, fq = lane >> 4, w = C.wave, tid = C.tid;
    LAS bf16* Kb = (LAS bf16*)C.lds; LAS bf16* Vb = (LAS bf16*)(C.lds + XK_BYTES);
    constexpr float SC2 = 0.0625f * 1.4426950408889634f;
    for (int it = blockIdx.x; it < 512; it += C.G) {
        const int hd = it & 3, bq = it >> 2, row0 = bq * 128 + w * 16, b = bq >> 6;
        bf16x8 qf[8];
        { const bf16* qp = QX + (size_t)(row0 + fr) * 1024 + hd * 256 + 8 * fq;
#pragma unroll
          for (int ks = 0; ks < 8; ++ks) qf[ks] = *(const bf16x8*)(qp + 32 * ks); }
        f32x4 oacc[16];
#pragma unroll
        for (int dt = 0; dt < 16; ++dt) oacc[dt] = (f32x4){0.f, 0.f, 0.f, 0.f};
        float mrow = -INFINITY, lrow = 0.f;
        for (int hf = 0; hf < 2; ++hf) {
            WG_BAR();
#pragma unroll
            for (int i = 0; i < 8; ++i) { const int id = tid + 512 * i;
                { const int r = id >> 5, c = id & 31; *(LAS u32x4*)(Kb + r * XK_LD + 8 * c) = *(const u32x4*)(KX + (size_t)(b * NMEM + 128 * hf + r) * 1024 + hd * 256 + 8 * c); }
                { const int r = id >> 4, c = id & 15; *(LAS u32x4*)(Vb + r * XV_LD + 8 * c) = *(const u32x4*)(VXT + (size_t)(hd * 256 + r) * 512 + b * NMEM + 128 * hf + 8 * c); } }
            WG_BAR();
            f32x4 st[8];
#pragma unroll
            for (int kt = 0; kt < 8; ++kt) { f32x4 acc = {0.f, 0.f, 0.f, 0.f};
#pragma unroll
                for (int ks = 0; ks < 8; ++ks) acc = MFMA16(*(const LAS bf16x8*)(Kb + (16 * kt + fr) * XK_LD + 32 * ks + 8 * fq), qf[ks], acc);
                st[kt] = acc; }
            float mx = -INFINITY;
#pragma unroll
            for (int kt = 0; kt < 8; ++kt)
#pragma unroll
                for (int r = 0; r < 4; ++r) { const float sv = st[kt][r] * SC2; st[kt][r] = sv; mx = fmaxf(mx, sv); }
            mx = fmaxf(mx, __shfl_xor(mx, 16)); mx = fmaxf(mx, __shfl_xor(mx, 32));
            const float mn = fmaxf(mrow, mx), corr = __builtin_amdgcn_exp2f(mrow - mn); mrow = mn;
            float ps = 0.f;
#pragma unroll
            for (int kt = 0; kt < 8; ++kt)
#pragma unroll
                for (int r = 0; r < 4; ++r) { const float p = __builtin_amdgcn_exp2f(st[kt][r] - mn); st[kt][r] = p; ps += p; }
            lrow = lrow * corr + ps;
            bf16x8 pf[4];
#pragma unroll
            for (int kk = 0; kk < 4; ++kk) pf[kk] = pack_p(st[2 * kk], st[2 * kk + 1]);
#pragma unroll
            for (int dt = 0; dt < 16; ++dt) { f32x4 acc = oacc[dt] * corr;
#pragma unroll
                for (int kk = 0; kk < 4; ++kk) acc = MFMA16(*(const LAS bf16x8*)(Vb + (16 * dt + fr) * XV_LD + 32 * kk + 8 * fq), pf[kk], acc);
                oacc[dt] = acc; }
        }
        lrow += __shfl_xor(lrow, 16); lrow += __shfl_xor(lrow, 32);
        const float inv = 1.0f / lrow;
        bf16* op = OX + (size_t)(row0 + fr) * 1024 + hd * 256 + 4 * fq;
#pragma unroll
        for (int dt = 0; dt < 16; ++dt) { u32x2 wv; wv.x = pk2(oacc[dt][0] * inv, oacc[dt][1] * inv); wv.y = pk2(oacc[dt][2] * inv, oacc[dt][3] * inv); *(u32x2*)(op + 16 * dt) = wv; }
    }
    WG_BAR();
}
__device__ __forceinline__ void l1_prep(const Ctx& C, ArgsP a, const bf16* Z, const bf16* QKV, bf16* VNT, bf16* QN, bf16* KN, bf16* VV) {
    const int lane = C.lane;
    const float* lng = INP(a, I_SGUG); const float* lnb = INP(a, I_SGUB); const float* cw = INP(a, I_DNCONV);
    for (int blk = C.gw; blk < NT / 8; blk += C.ngw) {
        const int row0 = blk * 8;
        {
            const f32x4 g0 = *((const f32x4*)lng + 2 * lane), g1 = *((const f32x4*)lng + 2 * lane + 1), c0 = *((const f32x4*)lnb + 2 * lane), c1 = *((const f32x4*)lnb + 2 * lane + 1);
            unsigned vt[8][4];
#pragma unroll
            for (int e = 0; e < 8; ++e)
#pragma unroll
                for (int q = 0; q < 4; ++q) vt[e][q] = 0u;
#pragma unroll
            for (int r = 0; r < 8; ++r) {
                float f[8]; unpack8(*((const u32x4*)(Z + (size_t)(row0 + r) * 1024 + 512) + lane), f);
                float s = 0.f;
#pragma unroll
                for (int e = 0; e < 8; ++e) s += f[e];
                const float mu = wave_sum(s) * (1.0f / 512.0f); float q = 0.f;
#pragma unroll
                for (int e = 0; e < 8; ++e) { f[e] -= mu; q += f[e] * f[e]; }
                const float rstd = 1.0f / sqrtf(wave_sum(q) * (1.0f / 512.0f) + EPS);
                const float y[8] = {f[0] * rstd * g0.x + c0.x, f[1] * rstd * g0.y + c0.y, f[2] * rstd * g0.z + c0.z, f[3] * rstd * g0.w + c0.w,
                                    f[4] * rstd * g1.x + c1.x, f[5] * rstd * g1.y + c1.y, f[6] * rstd * g1.z + c1.z, f[7] * rstd * g1.w + c1.w};
#pragma unroll
                for (int e = 0; e < 8; ++e) vt[e][r >> 1] |= f2bf(y[e]) << (16 * (r & 1));
            }
            bf16* vp = VNT + ((size_t)(row0 >> 7) * 512 + 8 * lane) * 128 + (row0 & 127);
#pragma unroll
            for (int e = 0; e < 8; ++e) { u32x4 w; w.x = vt[e][0]; w.y = vt[e][1]; w.z = vt[e][2]; w.w = vt[e][3]; *(u32x4*)(vp + (size_t)e * 128) = w; }
        }
        const bool hist = (row0 & (SEQ - 1)) != 0;
#pragma unroll 1
        for (int s3 = 0; s3 < 3; ++s3) {
            const int cs = s3 * 512 + 8 * lane;
            float w[4][8];
#pragma unroll
            for (int j = 0; j < 4; ++j) { const f32x4 a0 = *(const f32x4*)(cw + j * 1536 + cs), a1 = *(const f32x4*)(cw + j * 1536 + cs + 4);
                w[j][0] = a0.x; w[j][1] = a0.y; w[j][2] = a0.z; w[j][3] = a0.w; w[j][4] = a1.x; w[j][5] = a1.y; w[j][6] = a1.z; w[j][7] = a1.w; }
            float x0[8], x1[8], x2[8];
            if (hist) { unpack8(*(const u32x4*)(QKV + (size_t)(row0 - 3) * 1536 + cs), x0); unpack8(*(const u32x4*)(QKV + (size_t)(row0 - 2) * 1536 + cs), x1); unpack8(*(const u32x4*)(QKV + (size_t)(row0 - 1) * 1536 + cs), x2); }
            else {
#pragma unroll
                for (int e = 0; e < 8; ++e) { x0[e] = 0.f; x1[e] = 0.f; x2[e] = 0.f; } }
            bf16* dst = (s3 == 0 ? QN : s3 == 1 ? KN : VV) + (size_t)row0 * 512 + 8 * lane;
#pragma unroll
            for (int r = 0; r < 8; ++r) {
                float x3[8]; unpack8(*(const u32x4*)(QKV + (size_t)(row0 + r) * 1536 + cs), x3);
                float y[8], ss = 0.f;
#pragma unroll
                for (int e = 0; e < 8; ++e) { y[e] = silu_f(w[0][e] * x0[e] + w[1][e] * x1[e] + w[2][e] * x2[e] + w[3][e] * x3[e]); ss += y[e] * y[e]; }
                float sc = 1.0f;
                if (s3 < 2) { ss += __shfl_xor(ss, 1); ss += __shfl_xor(ss, 2); ss += __shfl_xor(ss, 4); ss += __shfl_xor(ss, 8);
                    sc = 1.0f / sqrtf(ss + EPS); if (s3 == 0) sc *= 0.08838834764831845f; }
                u32x4 o; o.x = pk2(y[0] * sc, y[1] * sc); o.y = pk2(y[2] * sc, y[3] * sc); o.z = pk2(y[4] * sc, y[5] * sc); o.w = pk2(y[6] * sc, y[7] * sc);
                *(u32x4*)(dst + (size_t)r * 512) = o;
#pragma unroll
                for (int e = 0; e < 8; ++e) { x0[e] = x1[e]; x1[e] = x2[e]; x2[e] = x3[e]; }
            }
        }
    }
}

#ifndef MK_MULTI
#define MK_MULTI 0
#endif
enum { OP_PRO0 = 0, OP_KMEAN, OP_MOBA, OP_RMSX, OP_XATTN, OP_RMSF, OP_ACT, OP_PRO1, OP_L1PREP, OP_DNPREP, OP_DNSCAN, OP_DNGATE, OP_FINAL, OP_GSTORE, OP_GRESID, OP_GCONV };
struct PD { int op, sync, L, hb, M, N, K; unsigned long long a, b, p0, p1, p2; int ld0, ld1, ld2, t1, t2, gelu0, basex, rot; long long ss; };
#define PH_TABLE \
  {OP_PRO0, 1, 0, 0, 0, 0, 0, 0ull, 0ull, 0ull, 0ull, 0ull, 0, 0, 0, 0, 0, 0, 0, 0, -1ll}, \
  {OP_GSTORE, 0, 0, 0, 16384, 1536, 1024, 38797312ull, 4194304ull, 141557760ull, 0ull, 0ull, 1536, 0, 0, 1000, 1000, 0, 0, 0, -1ll}, \
  {OP_GSTORE, 1, 0, 0, 512, 16384, 1024, 7340032ull, 208666624ull, 191889408ull, 0ull, 0ull, 16384, 0, 0, 1000, 1000, 0, 0, 128, -1ll}, \
  {OP_KMEAN, 0, 0, 0, 0, 0, 0, 0ull, 0ull, 0ull, 0ull, 0ull, 0, 0, 0, 0, 0, 0, 0, 0, -1ll}, \
  {OP_GSTORE, 0, 0, 0, 512, 1024, 1024, 0ull, 14680064ull, 72351744ull, 0ull, 0ull, 1024, 0, 0, 1000, 1000, 0, 0, 64, -1ll}, \
  {OP_GSTORE, 1, 0, 0, 1024, 512, 1024, 16777216ull, 2097152ull, 73400320ull, 0ull, 0ull, 512, 0, 0, 1000, 1000, 0, 0, 72, -1ll}, \
  {OP_MOBA, 1, 0, 0, 0, 0, 0, 0ull, 0ull, 0ull, 0ull, 0ull, 0, 0, 0, 0, 0, 0, 0, 0, -1ll}, \
  {OP_GRESID, 1, 0, 0, 16384, 1024, 1024, 74448896ull, 10485760ull, 0ull, 0ull, 0ull, 0, 0, 0, 0, 0, 0, 1, 0, 260046848ll}, \
  {OP_GSTORE, 1, 0, 0, 16384, 1024, 1024, 38797312ull, 12582912ull, 108003328ull, 0ull, 0ull, 1024, 0, 0, 1000, 1000, 0, 0, 0, 260046848ll}, \
  {OP_XATTN, 1, 0, 0, 0, 0, 0, 0ull, 0ull, 0ull, 0ull, 0ull, 0, 0, 0, 0, 0, 0, 0, 0, -1ll}, \
  {OP_GRESID, 1, 0, 0, 16384, 1024, 1024, 74448896ull, 18874368ull, 0ull, 0ull, 0ull, 0, 0, 0, 0, 0, 0, 0, 0, 260046848ll}, \
  {OP_GCONV, 1, 0, 0, 17408, 5632, 1024, 38797312ull, 20971520ull, 74448896ull, 0ull, 0ull, 0, 0, 0, 0, 0, 0, 0, 0, 260046848ll}, \
  {OP_GRESID, 1, 0, 2, 16384, 1024, 2816, 74448896ull, 32505856ull, 0ull, 0ull, 0ull, 0, 0, 0, 0, 0, 0, 0, 0, -1ll}, \
  {OP_PRO1, 1, 0, 0, 0, 0, 0, 0ull, 0ull, 0ull, 0ull, 0ull, 0, 0, 0, 0, 0, 0, 0, 0, -1ll}, \
  {OP_GSTORE, 1, 0, 0, 16384, 3072, 1024, 38797312ull, 4194304ull, 141557760ull, 175112192ull, 225443840ull, 1024, 1536, 512, 4, 10, 1, 0, 0, -1ll}, \
  {OP_L1PREP, 1, 0, 0, 0, 0, 0, 0ull, 0ull, 0ull, 0ull, 0ull, 0, 0, 0, 0, 0, 0, 0, 0, -1ll}, \
  {OP_DNPREP, 0, 0, 0, 0, 0, 0, 0ull, 0ull, 0ull, 0ull, 0ull, 0, 0, 0, 0, 0, 0, 0, 0, -1ll}, \
  {OP_GSTORE, 0, 0, 0, 512, 1024, 1024, 0ull, 14680064ull, 72351744ull, 0ull, 0ull, 1024, 0, 0, 1000, 1000, 0, 0, 128, -1ll}, \
  {OP_GSTORE, 1, 0, 0, 1024, 512, 1024, 16777216ull, 2097152ull, 73400320ull, 0ull, 0ull, 512, 0, 0, 1000, 1000, 0, 0, 136, -1ll}, \
  {OP_DNSCAN, 1, 0, 0, 0, 0, 0, 0ull, 0ull, 0ull, 0ull, 0ull, 0, 0, 0, 0, 0, 0, 0, 0, -1ll}, \
  {OP_DNGATE, 1, 0, 0, 0, 0, 0, 0ull, 0ull, 0ull, 0ull, 0ull, 0, 0, 0, 0, 0, 0, 0, 0, -1ll}, \
  {OP_GRESID, 1, 0, 1, 16384, 1024, 1024, 74448896ull, 10485760ull, 0ull, 0ull, 0ull, 0, 0, 0, 0, 0, 0, 0, 0, 260046848ll}, \
  {OP_GSTORE, 1, 0, 0, 16384, 1024, 1024, 38797312ull, 12582912ull, 108003328ull, 0ull, 0ull, 1024, 0, 0, 1000, 1000, 0, 0, 0, 260046848ll}, \
  {OP_XATTN, 1, 1, 0, 0, 0, 0, 0ull, 0ull, 0ull, 0ull, 0ull, 0, 0, 0, 0, 0, 0, 0, 0, -1ll}, \
  {OP_GRESID, 1, 0, 0, 16384, 1024, 1024, 74448896ull, 18874368ull, 0ull, 0ull, 0ull, 0, 0, 0, 0, 0, 0, 0, 0, 260046848ll}, \
  {OP_GCONV, 1, 1, 0, 17408, 5632, 1024, 38797312ull, 20971520ull, 74448896ull, 0ull, 0ull, 0, 0, 0, 0, 0, 0, 0, 0, 260046848ll}, \
  {OP_GRESID, 1, 0, 0, 16384, 1024, 2816, 74448896ull, 32505856ull, 0ull, 0ull, 0ull, 0, 0, 0, 0, 0, 0, 0, 0, -1ll}, \
  {OP_FINAL, 0, 0, 0, 0, 0, 0, 0ull, 0ull, 0ull, 0ull, 0ull, 0, 0, 0, 0, 0, 0, 0, 0, -1ll},
constexpr int NENT = 28;
__constant__ PD PH_DEV[NENT] = { PH_TABLE };
#define XB_TMO      128
#define XB_XCNT(j)  (256  + 64 * (j))
#define XB_XSUB(j)  (1280 + 64 * (j))
#define XB_XGEN(j)  (2304 + 64 * (j))
#define XB_TOP      3328
#define XB_TOPGEN   3392
#define XCD_BAR_WORDS 3456
#define XB_SPIN_CAP (1u << 18)

__device__ __forceinline__ unsigned xb_ld(unsigned* p)              { return __hip_atomic_load(p, __ATOMIC_RELAXED, __HIP_MEMORY_SCOPE_AGENT); }
__device__ __forceinline__ unsigned xb_add(unsigned* p, unsigned v) { return __hip_atomic_fetch_add(p, v, __ATOMIC_RELAXED, __HIP_MEMORY_SCOPE_AGENT); }
__device__ __forceinline__ unsigned xb_xcc_id() { return (unsigned)__builtin_amdgcn_s_getreg((3 << 11) | 20) & 0xFu; }
#define XB_SPIN(cond, bar) do { unsigned _sp = 0; while (cond) { __builtin_amdgcn_s_sleep(1); \
    if ((++_sp & 255u) == 0u) { if (xb_ld(&(bar)[XB_TMO])) break; if (_sp > XB_SPIN_CAP) { atomicAdd(&(bar)[XB_TMO], 1u); break; } } } } while (0)

struct XcdBarrier {
    unsigned* bar; unsigned x;
    volatile LAS unsigned* st;
};

__device__ __forceinline__ XcdBarrier xcd_barrier_post(unsigned* bar, volatile LAS unsigned* st) {
    XcdBarrier b; b.bar = bar; b.x = xb_xcc_id(); b.st = st;
    if (threadIdx.x == 0) (void)xb_add(&bar[XB_XCNT(b.x)], 1u);
    return b;
}
__device__ __forceinline__ void xcd_barrier_complete(unsigned* bar, unsigned x, unsigned& nloc, unsigned& nx) {
    const unsigned G = gridDim.x * gridDim.y * gridDim.z;
    unsigned sum, cnt, mine, sp = 0u;
    for (;;) {
        sum = 0u; cnt = 0u; mine = 0u;
#pragma unroll
        for (unsigned j = 0; j < 16; ++j) { const unsigned c = xb_ld(&bar[XB_XCNT(j)]); sum += c; cnt += (c > 0u) ? 1u : 0u; mine = (j == x) ? c : mine; }
        if (sum == G) break;
        __builtin_amdgcn_s_sleep(1);
        if ((++sp & 255u) == 0u) { if (xb_ld(&bar[XB_TMO])) break; if (sp > XB_SPIN_CAP) { atomicAdd(&bar[XB_TMO], 1u); break; } }
    }
    nloc = mine > 0u ? mine : 1u; nx = cnt > 0u ? cnt : 1u;
}

__device__ __forceinline__ void xcd_barrier(const XcdBarrier& b) {
    asm volatile("s_waitcnt vmcnt(0)" ::: "memory");
    __syncthreads();
    if (threadIdx.x == 0) {
        unsigned* bar = b.bar;
        __builtin_amdgcn_s_waitcnt(0);
        unsigned nloc = b.st[0], nx = b.st[1];
        if (nloc == 0u) { xcd_barrier_complete(bar, b.x, nloc, nx); b.st[0] = nloc; b.st[1] = nx; }
        const unsigned old = xb_add(&bar[XB_XSUB(b.x)], 1u);
        const unsigned gen = old / nloc;
        if (old + 1u == (gen + 1u) * nloc) {
            __builtin_amdgcn_fence(__ATOMIC_RELEASE, "agent");
            asm volatile("s_waitcnt vmcnt(0)" ::: "memory");
            const unsigned og = xb_add(&bar[XB_TOP], 1u);
            const unsigned tg = og / nx;
            if (og + 1u == (tg + 1u) * nx) xb_add(&bar[XB_TOPGEN], 1u);
            else XB_SPIN(xb_ld(&bar[XB_TOPGEN]) == tg, bar);
            __builtin_amdgcn_fence(__ATOMIC_ACQUIRE, "agent");
            xb_add(&bar[XB_XGEN(b.x)], 1u);
            asm volatile("s_waitcnt vmcnt(0)" ::: "memory");
        } else {
            XB_SPIN(xb_ld(&bar[XB_XGEN(b.x)]) == gen, bar);
            __builtin_amdgcn_fence(__ATOMIC_ACQUIRE, "agent");
            asm volatile("s_waitcnt vmcnt(0)" ::: "memory");
        }
    }
    __syncthreads();
}

constexpr size_t WS_CTL = 3 * MiB, CTL_BYTES = 64 * 1024;
constexpr int MISC_OFF = LDS_BYTES - 128;

static const PD PH_HOST[NENT] = { PH_TABLE };

__global__ void __launch_bounds__(512, 2) mega_fwd(Args a) {
    extern __shared__ __attribute__((aligned(16))) unsigned char lds_raw[];
    cg::grid_group grid = cg::this_grid();
    Ctx C; C.lds = (LAS unsigned char*)lds_raw; C.tid = threadIdx.x; C.lane = C.tid & 63; C.wave = __builtin_amdgcn_readfirstlane(C.tid >> 6);
    C.G = gridDim.x; C.gw = blockIdx.x * 8 + C.wave; C.ngw = C.G * 8; C.gtid = blockIdx.x * 512 + C.tid; C.nthr = C.G * 512;
    unsigned char* ws = a.ws;
    float* H = a.out;
    for (int u = C.tid; u < 128 / 4; u += 512) ((LAS unsigned*)(C.lds + MISC_OFF))[u] = 0u;
    __syncthreads();
    (void)xcd_barrier_post((unsigned*)(ws + WS_CTL), (volatile LAS unsigned*)(C.lds + MISC_OFF) + 8);
    const ArgsP ap0 = (ArgsP)__builtin_amdgcn_kernarg_segment_ptr();
    unsigned char* const ws0 = ws; float* const H0 = H;
    for (int e = a.ph_lo; e < a.ph_hi; ++e) {
        ws = ws0; H = H0; ArgsP ap = ap0; asm volatile("" : "+s"(ap));
        { int t_ = threadIdx.x; asm volatile("" : "+v"(t_)); int g_ = gridDim.x, bx_ = blockIdx.x; asm volatile("" : "+s"(g_), "+s"(bx_));
          C.tid = t_; C.lane = t_ & 63; C.wave = __builtin_amdgcn_readfirstlane(t_ >> 6); C.G = g_; C.gw = bx_ * 8 + C.wave; C.ngw = g_ * 8; C.gtid = bx_ * 512 + t_; C.nthr = g_ * 512; }
        { GAS1 unsigned char* wg = (GAS1 unsigned char*)ws; GAS1 float* hg = (GAS1 float*)H; asm volatile("" : "+s"(wg), "+s"(hg)); ws = (unsigned char*)wg; H = (float*)hg; }
        const int op = PH_DEV[e].op, L = PH_DEV[e].L;
        if (op == OP_GSTORE) {
            const PD& d = PH_DEV[e];
            pg8::Gemm g{(const bf16*)(ws + d.a), (const bf16*)(ws + d.b), d.M, d.N, d.K}; pg8::StaticOrder S; S.init(g.M, g.N, C.G, (int)((blockIdx.x + C.G - d.rot) % C.G));
            pg8::EpiSeg E{(bf16*)(ws + d.p0), (bf16*)(ws + d.p1), (bf16*)(ws + d.p2), d.ld0, d.ld1, d.ld2, d.t1, d.t2, d.gelu0, d.ss >= 0 ? (const float*)(ws + d.ss) : (const float*)nullptr};
            __syncthreads();
            pg8::gemm_phase<pg8::EpiSeg, pg8::StaticOrder, true, true>((PG8_LAS unsigned char*)C.lds, g, S, E, C.tid);
            __syncthreads();
        } else if (op == OP_GCONV) {
            const PD& d = PH_DEV[e];
            pg8::Gemm g{(const bf16*)(ws + d.a), (const bf16*)(ws + d.b), d.M, d.N, d.K, 2, 34, SEQ}; pg8::StaticOrder S; S.init(g.M, g.N, C.G, (int)((blockIdx.x + C.G - d.rot) % C.G));
            pg8::EpiConv E{(bf16*)(ws + d.p0), (const float*)(ws + d.ss), INP(ap, I_FCONV) + (size_t)L * 3 * DFF2, 34, SEQ, DFF};
            __syncthreads();
            pg8::gemm_phase<pg8::EpiConv, pg8::StaticOrder, true, true>((PG8_LAS unsigned char*)C.lds, g, S, E, C.tid);
            __syncthreads();
        } else if (op == OP_GRESID) {
            const PD& d = PH_DEV[e];
            pg8::Gemm g{(const bf16*)(ws + d.a), (const bf16*)(ws + d.b), d.M, d.N, d.K}; pg8::StaticOrder S; S.init(g.M, g.N, C.G, (int)((blockIdx.x + C.G - d.rot) % C.G));
            pg8::EpiResid E{d.basex ? INP(ap, I_X) : (const float*)nullptr, (d.hb & 1) ? (const bf16*)H : (const bf16*)(ws + WS_HB), (d.hb & 2) ? (bf16*)H : (bf16*)(ws + WS_HB), d.ss >= 0 ? (float*)(ws + d.ss) : (float*)nullptr, DM};
            __syncthreads();
            pg8::gemm_phase<pg8::EpiResid, pg8::StaticOrder, true, true>((PG8_LAS unsigned char*)C.lds, g, S, E, C.tid);
            __syncthreads();
        } else if (op == OP_PRO0) {
            convert_weights(C, ap, 0, 0, C.gw, C.ngw);
            rms_all_rows(C, INP(ap, I_X), INP(ap, I_NMIX), (bf16*)(ws + WS_XN), NT, (bf16*)(ws + WS_XNP));
            rms_all_rows(C, INP(ap, I_MEM), INP(ap, I_MEMNORM), (bf16*)(ws + WS_MEMN), 2 * NMEM, (bf16*)(ws + WS_MEMNP));
        } else if (op == OP_KMEAN) {
            kmean_pooled(C, (const bf16*)(ws + WS_PROJ0), (float*)(ws + WS_KMEAN));
            if (C.G > 80) { if ((int)blockIdx.x >= 80) convert_weights(C, ap, 0, 1, C.gw - 80 * 8, C.ngw - 80 * 8); } else convert_weights(C, ap, 0, 1, C.gw, C.ngw);
        }
        else if (op == OP_MOBA) { moba_wg(C, (const bf16*)(ws + WS_PROJ0), (const bf16*)(ws + WS_VT), (const float*)(ws + WS_KMEAN), (bf16*)(ws + WS_MIX));
                                  pool_mfma(C, (const bf16*)(ws + WS_PROJ0), (const bf16*)(ws + WS_PWT), INP(ap, I_POOLS), (bf16*)(ws + WS_MIX)); }
        else if (op == OP_PRO1) { convert_weights(C, ap, 1, 0, C.gw, C.ngw); sgu_w_convert(C, INP(ap, I_SGUW), (bf16*)(ws + WS_WB)); rms_rows_bg(C, ap, (const bf16*)H, (bf16*)(ws + WS_XN), (float*)(ws + WS_BG)); }
        else if (op == OP_L1PREP) { l1_prep(C, ap, (const bf16*)(ws + WS_Z), (const bf16*)(ws + WS_QKV), (bf16*)(ws + WS_VNT), (bf16*)(ws + WS_QN), (bf16*)(ws + WS_KN), (bf16*)(ws + WS_VV)); }
        else if (op == OP_DNPREP) {
            dn_chunk_prep(C, (const bf16*)(ws + WS_QN), (const bf16*)(ws + WS_KN), (const bf16*)(ws + WS_VV), (const float*)(ws + WS_BG), (bf16*)(ws + WS_U), (bf16*)(ws + WS_W), (bf16*)(ws + WS_QD), (bf16*)(ws + WS_KDT), (bf16*)(ws + WS_QKM), (float*)(ws + WS_GL));
        }
        else if (op == OP_DNSCAN) {
            const int nscan = C.G > 64 ? 64 : 0;
            if ((int)blockIdx.x < nscan || nscan == 0) for (int it = blockIdx.x; it < 64; it += C.G) dn_scan(C, (const bf16*)(ws + WS_U), (const bf16*)(ws + WS_W), (const bf16*)(ws + WS_QD), (const bf16*)(ws + WS_KDT), (const bf16*)(ws + WS_QKM), (const float*)(ws + WS_GL), (float*)(ws + WS_O), it);
            if ((int)blockIdx.x >= nscan) { const int gw0 = C.gw - nscan * 8, ngw0 = C.ngw - nscan * 8;
                sgu_mfma(C, (const bf16*)(ws + WS_Z), (const bf16*)(ws + WS_VNT), (const bf16*)(ws + WS_WB), INP(ap, I_SGUBS), (bf16*)(ws + WS_MIX), gw0, ngw0);
                convert_weights(C, ap, 1, 1, gw0, ngw0); }
        }
        else if (op == OP_DNGATE) { dn_out_gate(C, ap, (const float*)(ws + WS_O), (const bf16*)(ws + WS_GATE), (bf16*)(ws + WS_MIX)); }
        else if (op == OP_RMSX) { rms_all_rows(C, H, INP(ap, I_NXATTN) + L * DM, (bf16*)(ws + WS_XN), NT); }
        else if (op == OP_XATTN) { xattn_wg(C, (const bf16*)(ws + WS_QX), (const bf16*)(ws + WS_KVX), (const bf16*)(ws + WS_VXT), (bf16*)(ws + WS_MIX)); }
        else if (op == OP_RMSF) { rms_all_rows(C, H, INP(ap, I_NFFN) + L * DM, (bf16*)(ws + WS_XN), NT); }
        else if (op == OP_ACT) { ffn_act(C, (const bf16*)(ws + WS_HUP), INP(ap, I_FCONV) + (size_t)L * 3 * DFF2, (bf16*)(ws + WS_ACT), PH_DEV[e].hb); }
        else if (op == OP_FINAL) { final_norm(C, (const bf16*)(ws + WS_HB), H, INP(ap, I_FNORM)); }
        if (PH_DEV[e].sync && e + 1 < a.ph_hi) { if (e < 0) grid.sync();   else { XcdBarrier bar; bar.bar = (unsigned*)(ws + WS_CTL); bar.x = xb_xcc_id(); bar.st = (volatile LAS unsigned*)(C.lds + MISC_OFF) + 8; xcd_barrier(bar); } }
    }
}

extern "C" void kernel_launch(void* const* d_in, const int* in_sizes, int n_in, void* d_out, int out_size, void* d_ws, size_t ws_size, hipStream_t stream) {
    static int grid = 0;
    if (grid == 0) {
        if (n_in != 27 || out_size != NT * DM || ws_size < WS_END) { fprintf(stderr, "kernel_launch: unexpected sizes n_in %d out %d ws %zu\n", n_in, out_size, ws_size); grid = -1; return; }
        int dev = 0, cus = 0, per_cu = 0;
        (void)hipGetDevice(&dev); (void)hipDeviceGetAttribute(&cus, hipDeviceAttributeMultiprocessorCount, dev);
        if (hipFuncSetAttribute((const void*)mega_fwd, hipFuncAttributeMaxDynamicSharedMemorySize, LDS_BYTES) != hipSuccess) { fprintf(stderr, "kernel_launch: hipFuncSetAttribute failed\n"); }
        if (hipOccupancyMaxActiveBlocksPerMultiprocessor(&per_cu, (const void*)mega_fwd, 512, LDS_BYTES) != hipSuccess || per_cu < 1) { fprintf(stderr, "kernel_launch: occupancy query says %d\n", per_cu); per_cu = 1; }
        (void)hipGetLastError();
        grid = cus * 1;
        if (grid <= 0) grid = 256;
    }
    if (grid < 0) return;
    if (hipMemsetAsync((char*)d_ws + WS_CTL, 0, CTL_BYTES, stream) != hipSuccess) { fprintf(stderr, "kernel_launch: hipMemsetAsync failed\n"); return; }
    Args a{};
    for (int i = 0; i < 27; ++i) a.in[i] = (const float*)d_in[i];
    a.out = (float*)d_out; a.ws = (unsigned char*)d_ws;
#if MK_MULTI
    for (int e0 = 0; e0 < NENT;) { int e1 = e0; while (e1 < NENT - 1 && !PH_HOST[e1].sync) ++e1; ++e1;
        a.ph_lo = e0; a.ph_hi = e1; void* args[] = {&a};
        hipError_t er = hipLaunchCooperativeKernel((const void*)mega_fwd, dim3(grid), dim3(512), args, LDS_BYTES, stream);
        if (er != hipSuccess) { fprintf(stderr, "launch %d failed: %s\n", e0, hipGetErrorString(er)); break; }
        e0 = e1; }
#else
    a.ph_lo = 0; a.ph_hi = NENT; void* args[] = {&a};
    hipError_t er = hipLaunchCooperativeKernel((const void*)mega_fwd, dim3(grid), dim3(512), args, LDS_BYTES, stream);
    if (er != hipSuccess) fprintf(stderr, "cooperative launch failed: %s (grid %d)\n", hipGetErrorString(er), grid);
#endif
}
```

```cpp
#include <hip/hip_runtime.h>
#include <hip/hip_cooperative_groups.h>
#include <cstdio>
#include <cstdint>
namespace cg = cooperative_groups;
namespace pg8 {
#define PG8_LAS __attribute__((address_space(3)))
typedef unsigned short bf16_t;
typedef short bf16x8 __attribute__((ext_vector_type(8)));
typedef float f32x4 __attribute__((ext_vector_type(4)));
typedef unsigned u32x4 __attribute__((ext_vector_type(4)));
constexpr int BM = 256, BK = 64, HALF = 128, HTB = HALF * BK * 2  , STAGE_BYTES = 8 * HTB, NXCD = 8, WGM = 8;

__host__ __device__ __forceinline__ int lds_byte(int r, int c) { const int st = (r >> 4) * 2 + (c >> 5), rr = r & 15, cc = c & 31, ob = rr * 64 + cc * 2; return st * 1024 + (ob ^ (((ob >> 9) & 1) << 5)); }
__host__ __device__ __forceinline__ void stage_rc(int b, int& R, int& C) { const int st = b / 1024, sb = b % 1024, swz = sb ^ (((sb >> 9) & 1) << 5); R = (st >> 1) * 16 + swz / 64; C = (st & 1) * 32 + (swz % 64) / 2; }
__host__ __device__ __forceinline__ int perm32(int rho) { const int n = rho >> 4, i = rho & 15; return 8 * (i >> 2) + 4 * n + (i & 3); }

struct Unit { int pm, pn; };
struct Gemm { const bf16_t* A; const bf16_t* Bt; int M, N, K; int ov, tpb, seq; };

struct StaticOrder {
    int nM, nN, nwg, G, c;
    __host__ __device__ void init(int M, int N, int G_, int c_) { nM = M / BM; nN = N / BM; nwg = nM * nN; G = G_; c = c_; }
    __host__ __device__ bool next(int i, Unit& u) const {
        const long L = (long)i * G + c; if (L >= nwg) return false;
        int wgid = (int)L; { const int q = nwg / NXCD, r = nwg % NXCD, xcd = wgid % NXCD, off = wgid / NXCD; wgid = (xcd < r ? xcd * (q + 1) : r * (q + 1) + (xcd - r) * q) + off; }
        const int nig = WGM * nN, gid = wgid / nig, fm = gid * WGM, gsz = (nM - fm) < WGM ? (nM - fm) : WGM;
        u.pm = fm + ((wgid % nig) % gsz); u.pn = (wgid % nig) / gsz; return true;
    }
    __device__ __forceinline__ void a_ready(const Unit&) const {}
    __device__ __forceinline__ void done(const Unit&) const {}
};

__device__ __forceinline__ unsigned cvt_pk_bf16(float lo, float hi) { unsigned r; asm volatile("v_cvt_pk_bf16_f32 %0, %1, %2" : "=v"(r) : "v"(lo), "v"(hi)); return r; }
__device__ __forceinline__ float gelu_tanh(float x) { const float u2 = 1.5957691216057308f * (x + 0.044715f * x * x * x); return x * __builtin_amdgcn_rcpf(1.0f + __expf(-u2)); }

struct EpiSeg {
    static constexpr bool PERM = true, AFTER_DRAIN = false;
    bf16_t* p0; bf16_t* p1; bf16_t* p2; int ld0, ld1, ld2, t1, t2, gelu0; const float* ss;
    __device__ __forceinline__ void operator()(const f32x4 (&acc)[2][2][4][2], const Unit& u, int wr, int wc, int fr, int fq) const {
        bf16_t* base; int ld, colt; bool act = false;
        if (u.pn < t1) { base = p0; ld = ld0; colt = u.pn * BM; act = gelu0 != 0; }
        else if (u.pn < t2) { base = p1; ld = ld1; colt = (u.pn - t1) * BM; }
        else { base = p2; ld = ld2; colt = (u.pn - t2) * BM; }
        const int row0 = u.pm * BM + wr * 64 + fr, col0 = colt + wc * 32 + 8 * fq;
#pragma unroll
        for (int ai = 0; ai < 2; ++ai)
#pragma unroll
            for (int m = 0; m < 4; ++m) { bf16_t* rowp = base + (size_t)(row0 + ai * HALF + m * 16) * ld + col0;
                float rs = 1.0f;
                if (ss) { const f32x4* sp = (const f32x4*)(ss + (size_t)(row0 + ai * HALF + m * 16) * 16); const f32x4 s0 = sp[0], s1 = sp[1], s2 = sp[2], s3 = sp[3];
                    const float tot = ((s0[0] + s0[1]) + (s0[2] + s0[3])) + ((s1[0] + s1[1]) + (s1[2] + s1[3])) + ((s2[0] + s2[1]) + (s2[2] + s2[3])) + ((s3[0] + s3[1]) + (s3[2] + s3[3]));
                    rs = 1.0f / sqrtf(tot * (1.0f / 1024.0f) + 1e-6f); }
#pragma unroll
                for (int bj = 0; bj < 2; ++bj) { f32x4 v0 = acc[ai][bj][m][0] * rs, v1 = acc[ai][bj][m][1] * rs;
                    if (act) { v0 = (f32x4){gelu_tanh(v0[0]), gelu_tanh(v0[1]), gelu_tanh(v0[2]), gelu_tanh(v0[3])}; v1 = (f32x4){gelu_tanh(v1[0]), gelu_tanh(v1[1]), gelu_tanh(v1[2]), gelu_tanh(v1[3])}; }
                    u32x4 w; w.x = cvt_pk_bf16(v0[0], v0[1]); w.y = cvt_pk_bf16(v0[2], v0[3]); w.z = cvt_pk_bf16(v1[0], v1[1]); w.w = cvt_pk_bf16(v1[2], v1[3]);
                    *(u32x4*)(rowp + bj * HALF) = w; } }
    }
};
struct EpiResid {
    static constexpr bool PERM = true, AFTER_DRAIN = false;
    const float* basef; const bf16_t* baseh; bf16_t* hb; float* ss; int ld;
    __device__ __forceinline__ void operator()(const f32x4 (&acc)[2][2][4][2], const Unit& u, int wr, int wc, int fr, int fq) const {
        const int col0 = u.pn * BM + wc * 32 + 8 * fq;
#pragma unroll
        for (int ai = 0; ai < 2; ++ai)
#pragma unroll
            for (int m = 0; m < 4; ++m) { const size_t off = (size_t)(u.pm * BM + ai * HALF + wr * 64 + m * 16 + fr) * ld + col0; float sq = 0.f;
#pragma unroll
                for (int bj = 0; bj < 2; ++bj) { f32x4 b0, b1;
                    if (basef) { b0 = *(const f32x4*)(basef + off + bj * HALF); b1 = *(const f32x4*)(basef + off + bj * HALF + 4); }
                    else { const u32x4 w = *(const u32x4*)(baseh + off + bj * HALF);
                        b0[0] = __uint_as_float(w.x << 16); b0[1] = __uint_as_float(w.x & 0xffff0000u); b0[2] = __uint_as_float(w.y << 16); b0[3] = __uint_as_float(w.y & 0xffff0000u);
                        b1[0] = __uint_as_float(w.z << 16); b1[1] = __uint_as_float(w.z & 0xffff0000u); b1[2] = __uint_as_float(w.w << 16); b1[3] = __uint_as_float(w.w & 0xffff0000u); }
                    const f32x4 o0 = b0 + acc[ai][bj][m][0], o1 = b1 + acc[ai][bj][m][1];
                    sq += ((o0[0] * o0[0] + o0[1] * o0[1]) + (o0[2] * o0[2] + o0[3] * o0[3])) + ((o1[0] * o1[0] + o1[1] * o1[1]) + (o1[2] * o1[2] + o1[3] * o1[3]));
                    u32x4 w2; w2.x = cvt_pk_bf16(o0[0], o0[1]); w2.y = cvt_pk_bf16(o0[2], o0[3]); w2.z = cvt_pk_bf16(o1[0], o1[1]); w2.w = cvt_pk_bf16(o1[2], o1[3]); *(u32x4*)(hb + off + bj * HALF) = w2; }
                if (ss) { sq += __shfl_xor(sq, 16); sq += __shfl_xor(sq, 32); if (fq == 0) ss[(size_t)(u.pm * BM + ai * HALF + wr * 64 + m * 16 + fr) * 16 + u.pn * 4 + wc] = sq; } }
    }
};
struct EpiConv {
    static constexpr bool PERM = true, AFTER_DRAIN = false;
    static __device__ __forceinline__ float shr16(float oldv, float v, int d) { const int o = __builtin_bit_cast(int, oldv), x = __builtin_bit_cast(int, v); const int y = d == 1 ? __builtin_amdgcn_update_dpp(o, x, 0x111, 0xf, 0xf, false) : __builtin_amdgcn_update_dpp(o, x, 0x112, 0xf, 0xf, false); return __builtin_bit_cast(float, y); }
    static __device__ __forceinline__ float ror16(float v, int d) { const int x = __builtin_bit_cast(int, v); const int y = d == 1 ? __builtin_amdgcn_mov_dpp(x, 0x121, 0xf, 0xf, false) : __builtin_amdgcn_mov_dpp(x, 0x122, 0xf, 0xf, false); return __builtin_bit_cast(float, y); }
    bf16_t* O; const float* ss; const float* cw; int tpb, seq, dff;
    __device__ __forceinline__ void operator()(const f32x4 (&acc)[2][2][4][2], const Unit& u, int wr, int wc, int fr, int fq) const {
        const int lane = fq * 16 + fr, b = u.pm / tpb, pmm = u.pm % tpb, ch0 = u.pn * 128 + wc * 32 + 8 * fq;
#pragma unroll
        for (int ai = 0; ai < 2; ++ai) {
            const int tl0 = pmm * 248 + (2 * ai + wr) * 62 - 2;
            float rs[4];
#pragma unroll
            for (int m = 0; m < 4; ++m) { const int tl = tl0 + 16 * m + fr; float r_ = 0.f;
                if (tl >= 0 && tl < seq) { const f32x4* sp = (const f32x4*)(ss + ((size_t)b * seq + tl) * 16); const f32x4 s0 = sp[0], s1 = sp[1], s2 = sp[2], s3 = sp[3];
                    const float tot = ((s0[0] + s0[1]) + (s0[2] + s0[3])) + ((s1[0] + s1[1]) + (s1[2] + s1[3])) + ((s2[0] + s2[1]) + (s2[2] + s2[3])) + ((s3[0] + s3[1]) + (s3[2] + s3[3]));
                    r_ = 1.0f / sqrtf(tot * (1.0f / 1024.0f) + 1e-6f); }
                rs[m] = r_; }
#pragma unroll
            for (int n = 0; n < 2; ++n) {
                f32x4 wg[3], wu[3];
#pragma unroll
                for (int k = 0; k < 3; ++k) { wg[k] = *(const f32x4*)(cw + (size_t)k * 2 * dff + ch0 + 4 * n); wu[k] = *(const f32x4*)(cw + (size_t)k * 2 * dff + dff + ch0 + 4 * n); }
                float pv[2][4];
#pragma unroll
                for (int bj = 0; bj < 2; ++bj)
#pragma unroll
                    for (int i = 0; i < 4; ++i) pv[bj][i] = 0.f;
#pragma unroll
                for (int m = 0; m < 4; ++m) {
                    const int tl = tl0 + 16 * m + fr; const bool ok = (16 * m + fr >= 2) && tl < seq;
                    float o[4];
#pragma unroll
                    for (int i = 0; i < 4; ++i) { float cv[2];
#pragma unroll
                        for (int bj = 0; bj < 2; ++bj) {
                            const float cur = rs[m] > 0.f ? acc[ai][bj][m][n][i] * rs[m] : 0.f;
                            const float p1 = shr16(ror16(pv[bj][i], 1), cur, 1), p2 = shr16(ror16(pv[bj][i], 2), cur, 2);
                            pv[bj][i] = cur;
                            cv[bj] = bj == 0 ? (wg[0][i] * p2 + wg[1][i] * p1 + wg[2][i] * cur) : (wu[0][i] * p2 + wu[1][i] * p1 + wu[2][i] * cur); }
                        o[i] = cv[0] * __builtin_amdgcn_rcpf(1.0f + __expf(-cv[0])) * cv[1]; }
                    if (ok) { typedef unsigned u32x2e __attribute__((ext_vector_type(2))); u32x2e w; w.x = cvt_pk_bf16(o[0], o[1]); w.y = cvt_pk_bf16(o[2], o[3]);
                        *(u32x2e*)(O + ((size_t)b * seq + tl) * dff + ch0 + 4 * n) = w; }
                }
            }
        }
    }
};
template <class Epi, class Sched, bool ALIGN_EPI = false, bool SP2 = false>
__device__ __forceinline__ void gemm_phase(PG8_LAS unsigned char* lds, const Gemm g, const Sched& S, const Epi& E, const int tid_in) {
    const int tid = tid_in, wid = __builtin_amdgcn_readfirstlane(tid >> 6), lane = tid & 63, wr = wid >> 2, wc = wid & 3, fr = lane & 15, fq = lane >> 4;
    const int K = g.K, nt = K / BK;
    unsigned voffA[2], voffB[2];
#pragma unroll
    for (int i = 0; i < 2; ++i) { int R, C; stage_rc(tid * 16 + i * 8192, R, C); const int Rb = Epi::PERM ? ((R & ~31) + perm32(R & 31)) : R;
        voffA[i] = (unsigned)((R - (R >> 6) * g.ov) * K + C) * 2u; voffB[i] = (unsigned)(Rb * K + C) * 2u; }
    const size_t kstep = (size_t)(BK * 2);
    const size_t hstep = (size_t)HALF * K * 2;
    const size_t tstep = 2 * hstep;
    const size_t hstepA = (size_t)(HALF - 2 * g.ov) * K * 2;
#define PG8_ABASE(pm_) ((const char*)g.A + (g.ov ? ((size_t)((pm_) / g.tpb) * g.seq + (size_t)((pm_) % g.tpb) * (BM - 4 * g.ov)) * K * 2 - (size_t)g.ov * K * 2 : (size_t)(pm_) * tstep))
    const unsigned ldsw = (unsigned)wid * 1024u;
    const int aoff = lds_byte(wr * 64 + fr, fq * 8), boff = lds_byte(wc * 32 + fr, fq * 8);
#define PG8_SA(b, h) (((b) * 2 + (h)) * HTB)
#define PG8_SB(b, h) ((4 + (b) * 2 + (h)) * HTB)
#define PG8_STAGE(bufoff, gbase, voff) do { _Pragma("unroll") for (int _i = 0; _i < 2; ++_i) \
        __builtin_amdgcn_global_load_lds((const unsigned*)((const char*)(gbase) + (voff)[_i]), (PG8_LAS unsigned*)(lds + (bufoff) + ldsw + _i * 8192), 16, 0, 0); } while (0)
#define PG8_LDA(dst, b, h) do { _Pragma("unroll") for (int m = 0; m < 4; ++m) _Pragma("unroll") for (int k = 0; k < 2; ++k) dst[m][k] = *(const PG8_LAS bf16x8*)(lds + PG8_SA(b, h) + aoff + m * 2048 + k * 1024); } while (0)
#define PG8_LDB(dst, b, h) do { _Pragma("unroll") for (int n = 0; n < 2; ++n) _Pragma("unroll") for (int k = 0; k < 2; ++k) dst[n][k] = *(const PG8_LAS bf16x8*)(lds + PG8_SB(b, h) + boff + n * 2048 + k * 1024); } while (0)
#define PG8_MMA(ai, bj, At, Bt) do { __builtin_amdgcn_s_setprio(1); _Pragma("unroll") for (int m = 0; m < 4; ++m) _Pragma("unroll") for (int n = 0; n < 2; ++n) _Pragma("unroll") for (int k = 0; k < 2; ++k) \
        acc[ai][bj][m][n] = __builtin_amdgcn_mfma_f32_16x16x32_bf16(Bt[n][k], At[m][k], acc[ai][bj][m][n], 0, 0, 0); __builtin_amdgcn_s_setprio(0); } while (0)
#define PG8_WAIT_V(n) asm volatile("s_waitcnt vmcnt(" #n ")" ::: "memory")
#define PG8_WAIT_L(n) asm volatile("s_waitcnt lgkmcnt(" #n ")" ::: "memory")
#define PG8_BAR __builtin_amdgcn_s_barrier()
#define PG8_SCHED __builtin_amdgcn_sched_barrier(0)
    Unit cur, nxt; int ui = 0;
    if (!S.next(0, cur)) return;
    f32x4 acc[2][2][4][2];
#pragma unroll
    for (int a = 0; a < 2; ++a)
#pragma unroll
        for (int b = 0; b < 2; ++b)
#pragma unroll
            for (int m = 0; m < 4; ++m)
#pragma unroll
                for (int n = 0; n < 2; ++n) acc[a][b][m][n] = (f32x4){0.f, 0.f, 0.f, 0.f};
    bf16x8 At[4][2], B0[2][2], B1[2][2];
    const char* cA = PG8_ABASE(cur.pm); const char* cB = (const char*)g.Bt + (size_t)cur.pn * tstep;
    S.a_ready(cur);
    if constexpr (SP2) {
        PG8_STAGE(PG8_SB(0, 0), cB, voffB); PG8_STAGE(PG8_SB(0, 1), cB + hstep, voffB); PG8_STAGE(PG8_SA(0, 0), cA, voffA); PG8_STAGE(PG8_SA(0, 1), cA + hstepA, voffA);
        if (wr == 1) PG8_BAR;
        PG8_WAIT_V(2); PG8_BAR;
        PG8_STAGE(PG8_SB(1, 0), cB + kstep, voffB); PG8_STAGE(PG8_SA(1, 0), cA + kstep, voffA); PG8_STAGE(PG8_SB(1, 1), cB + hstep + kstep, voffB);
        PG8_WAIT_V(6); PG8_BAR;
    } else {
        PG8_STAGE(PG8_SB(0, 0), cB, voffB); PG8_STAGE(PG8_SA(0, 0), cA, voffA); PG8_STAGE(PG8_SB(0, 1), cB + hstep, voffB); PG8_STAGE(PG8_SA(0, 1), cA + hstepA, voffA);
        if (wr == 1) PG8_BAR;
        PG8_WAIT_V(4); PG8_BAR;
        PG8_STAGE(PG8_SB(1, 0), cB + kstep, voffB); PG8_STAGE(PG8_SA(1, 0), cA + kstep, voffA); PG8_STAGE(PG8_SB(1, 1), cB + hstep + kstep, voffB);
        PG8_WAIT_V(6); PG8_BAR;
    }
    for (;;) {
        const bool has_next = S.next(ui + 1, nxt);
        const char* nA = has_next ? PG8_ABASE(nxt.pm) : cA; const char* nB = has_next ? (const char*)g.Bt + (size_t)nxt.pn * tstep : cB;
        for (int t = 0; t < nt; t += 2) {
            const bool last = (t == nt - 2);
            const char* a1 = cA + (size_t)(t + 1) * kstep;
            const char* a2 = last ? nA : cA + (size_t)(t + 2) * kstep; const char* b2 = last ? nB : cB + (size_t)(t + 2) * kstep;
            const char* a3 = a2 + kstep; const char* b3 = b2 + kstep;
            if (last && has_next) S.a_ready(nxt);
            if constexpr (SP2) {
            PG8_LDB(B0, 0, 0); PG8_LDB(B1, 0, 1); PG8_SCHED; PG8_LDA(At, 0, 0); PG8_STAGE(PG8_SA(1, 1), a1 + hstepA, voffA);
            PG8_WAIT_V(8); PG8_WAIT_L(0); PG8_BAR; PG8_MMA(0, 0, At, B0); PG8_MMA(0, 1, At, B1); PG8_BAR; PG8_SCHED;
            PG8_LDA(At, 0, 1); PG8_STAGE(PG8_SB(0, 0), b2, voffB); PG8_STAGE(PG8_SB(0, 1), b2 + hstep, voffB); PG8_STAGE(PG8_SA(0, 0), a2, voffA);
            PG8_WAIT_V(8); PG8_WAIT_L(0); PG8_BAR; PG8_MMA(1, 0, At, B0); PG8_MMA(1, 1, At, B1); PG8_BAR; PG8_SCHED;
            PG8_LDB(B0, 1, 0); PG8_LDB(B1, 1, 1); PG8_SCHED; PG8_LDA(At, 1, 0); PG8_STAGE(PG8_SA(0, 1), a2 + hstepA, voffA);
            PG8_WAIT_V(8); PG8_WAIT_L(0); PG8_BAR; PG8_MMA(0, 0, At, B0); PG8_MMA(0, 1, At, B1); PG8_BAR; PG8_SCHED;
            PG8_LDA(At, 1, 1); PG8_STAGE(PG8_SB(1, 0), b3, voffB); PG8_STAGE(PG8_SB(1, 1), b3 + hstep, voffB); PG8_STAGE(PG8_SA(1, 0), a3, voffA);
            PG8_WAIT_V(8); PG8_WAIT_L(0); PG8_BAR; PG8_MMA(1, 0, At, B0); PG8_MMA(1, 1, At, B1); PG8_BAR; PG8_SCHED;
            } else {
            PG8_LDB(B0, 0, 0); PG8_SCHED; PG8_LDA(At, 0, 0); PG8_STAGE(PG8_SA(1, 1), a1 + hstepA, voffA);
            PG8_WAIT_L(8); PG8_BAR; PG8_WAIT_L(0); PG8_MMA(0, 0, At, B0); PG8_BAR; PG8_SCHED;
            PG8_LDB(B1, 0, 1); PG8_STAGE(PG8_SB(0, 0), b2, voffB);
            PG8_BAR; PG8_WAIT_L(0); PG8_MMA(0, 1, At, B1); PG8_BAR;
            PG8_LDA(At, 0, 1); PG8_STAGE(PG8_SA(0, 0), a2, voffA);
            PG8_BAR; PG8_WAIT_L(0); PG8_MMA(1, 0, At, B0); PG8_BAR; PG8_SCHED;
            PG8_STAGE(PG8_SB(0, 1), b2 + hstep, voffB);
            PG8_WAIT_V(6); PG8_BAR; PG8_MMA(1, 1, At, B1); PG8_BAR;
            PG8_LDB(B0, 1, 0); PG8_SCHED; PG8_LDA(At, 1, 0); PG8_STAGE(PG8_SA(0, 1), a2 + hstepA, voffA);
            PG8_WAIT_L(8); PG8_BAR; PG8_WAIT_L(0); PG8_MMA(0, 0, At, B0); PG8_BAR; PG8_SCHED;
            PG8_LDB(B1, 1, 1); PG8_STAGE(PG8_SB(1, 0), b3, voffB);
            PG8_BAR; PG8_WAIT_L(0); PG8_MMA(0, 1, At, B1); PG8_BAR;
            PG8_LDA(At, 1, 1); PG8_STAGE(PG8_SA(1, 0), a3, voffA);
            PG8_BAR; PG8_WAIT_L(0); PG8_MMA(1, 0, At, B0); PG8_BAR; PG8_SCHED;
            PG8_STAGE(PG8_SB(1, 1), b3 + hstep, voffB);
            PG8_WAIT_V(6); PG8_BAR; PG8_MMA(1, 1, At, B1); PG8_BAR;
            }
        }
        if constexpr (ALIGN_EPI) { if (wr == 0) PG8_BAR; }
        if constexpr (!Epi::AFTER_DRAIN) { E(acc, cur, wr, wc, fr, fq); S.done(cur); }
        if (!has_next) break;
#pragma unroll
        for (int a = 0; a < 2; ++a)
#pragma unroll
            for (int b = 0; b < 2; ++b)
#pragma unroll
                for (int m = 0; m < 4; ++m)
#pragma unroll
                    for (int n = 0; n < 2; ++n) acc[a][b][m][n] = (f32x4){0.f, 0.f, 0.f, 0.f};
        cur = nxt; cA = nA; cB = nB; ++ui;
        if constexpr (ALIGN_EPI) { if (wr == 1) PG8_BAR; }
    }
    PG8_WAIT_V(0);
    if constexpr (!ALIGN_EPI) { if (wr == 0) PG8_BAR; }
    PG8_BAR;
    if constexpr (Epi::AFTER_DRAIN) { E.fused(acc, cur, wr, wc, fr, fq, lds, wid, lane); S.done(cur); }
#undef PG8_ABASE
#undef PG8_SA
#undef PG8_SB
#undef PG8_STAGE
#undef PG8_LDA
#undef PG8_LDB
#undef PG8_MMA
#undef PG8_WAIT_V
#undef PG8_WAIT_L
#undef PG8_BAR
#undef PG8_SCHED
}
}

constexpr int NT = 16384, SEQ = 8192, DM = 1024, NMEM = 256, DFF = 2816, DFF2 = 5632;
constexpr float EPS = 1e-6f;
#define LAS __attribute__((address_space(3)))
typedef unsigned short bf16;
typedef float f32x4 __attribute__((ext_vector_type(4)));
typedef unsigned u32x4 __attribute__((ext_vector_type(4)));
typedef unsigned u32x2 __attribute__((ext_vector_type(2)));
constexpr size_t MiB = 1u << 20;
constexpr size_t WS_MEMN = 0, WS_BG = 1 * MiB, WS_KMEAN = 1 * MiB + 512 * 1024;
constexpr size_t WS_WTS = 4 * MiB;
constexpr size_t W_IN = WS_WTS, W_OUT = WS_WTS + 6 * MiB, W_Q = WS_WTS + 8 * MiB, W_KV = WS_WTS + 10 * MiB, W_O = WS_WTS + 14 * MiB, W_UP = WS_WTS + 16 * MiB, W_DN = WS_WTS + 27 * MiB;
constexpr size_t WS_XN = 37 * MiB, WS_KVX = 69 * MiB, WS_MIX = 71 * MiB, WS_QX = 103 * MiB, WS_F = 135 * MiB;
constexpr size_t WS_PROJ0 = WS_F, WS_Z = WS_F, WS_QKV = WS_F + 32 * MiB, WS_GATE = WS_F + 80 * MiB, WS_O = WS_QX;
constexpr size_t WS_U = WS_F + 32 * MiB, WS_W = WS_F + 48 * MiB, WS_KDT = WS_F + 64 * MiB, WS_QD = WS_F + 96 * MiB, WS_QKM = WS_F + 112 * MiB, WS_GL = 1 * MiB + 768 * 1024;
constexpr size_t WS_VT = WS_F + 48 * MiB, WS_XNP = WS_F + 64 * MiB, WS_MEMNP = 2 * MiB, WS_VXT = WS_KVX + 1 * MiB;
constexpr size_t WS_PWT = 3 * MiB + 64 * 1024, WS_WB = 3 * MiB + 256 * 1024;
constexpr size_t WS_VNT = WS_XN, WS_HB = WS_XN, WS_SS = 248 * MiB;
constexpr size_t WS_POOLED = WS_QX, WS_VN = WS_XN, WS_VV = WS_XN + 16 * MiB, WS_QN = WS_QX, WS_KN = WS_QX + 16 * MiB;
constexpr size_t WS_ACT = WS_MIX, WS_HUP = WS_MIX + 88 * MiB, WS_END = 256 * MiB;
static_assert(WS_HUP + 88 * MiB <= WS_END && WS_GATE + 16 * MiB <= WS_QD && WS_QKM + 8 * MiB <= WS_END, "ws map");
constexpr int LDS_BYTES = 147456;

__device__ __forceinline__ float bf2f(unsigned v) { return __uint_as_float(v << 16); }
__device__ __forceinline__ unsigned f2bf(float f) { unsigned u = __float_as_uint(f); return (u + 0x7fffu + ((u >> 16) & 1u)) >> 16; }
__device__ __forceinline__ unsigned pk2(float lo, float hi) { return f2bf(lo) | (f2bf(hi) << 16); }
__device__ __forceinline__ float lo16(unsigned w) { return __uint_as_float(w << 16); }
__device__ __forceinline__ float hi16(unsigned w) { return __uint_as_float(w & 0xffff0000u); }
__device__ __forceinline__ float wave_sum(float v) {
#pragma unroll
    for (int o = 1; o < 64; o <<= 1) v += __shfl_xor(v, o);
    return v;
}
__device__ __forceinline__ float wave_max(float v) {
#pragma unroll
    for (int o = 1; o < 64; o <<= 1) v = fmaxf(v, __shfl_xor(v, o));
    return v;
}
__device__ __forceinline__ float silu_f(float x) { return x * __builtin_amdgcn_rcpf(1.0f + __expf(-x)); }
#define LDS_WAIT() asm volatile("s_waitcnt lgkmcnt(0)" ::: "memory")

struct Args { const float* in[27]; float* out; unsigned char* ws; int ph_lo, ph_hi; };
typedef const __attribute__((address_space(4))) Args* ArgsP;
#define GAS1 __attribute__((address_space(1)))
__device__ __forceinline__ const float* inp_ptr(ArgsP ap, int i) { GAS1 const float* g = (GAS1 const float*)ap->in[i]; asm volatile("" : "+s"(g)); return (const float*)g; }
__device__ __forceinline__ unsigned char* ws_ptr(ArgsP ap) { GAS1 unsigned char* g = (GAS1 unsigned char*)ap->ws; asm volatile("" : "+s"(g)); return (unsigned char*)g; }
#define INP(ap, i) inp_ptr((ap), (i))
enum { I_X = 0, I_MEM, I_MEMNORM, I_NMIX, I_NXATTN, I_NFFN, I_EVIN, I_POOLW, I_POOLS, I_EVOUT, I_ODIN, I_SGUG, I_SGUB, I_SGUW, I_SGUBS, I_DNCONV, I_DNALOG, I_DNDT, I_DNNG, I_ODOUT,
       I_WQ, I_WKV, I_WO, I_FUP, I_FCONV, I_FDN, I_FNORM };

struct Ctx { LAS unsigned char* lds; int tid, lane, wave, G, gw, ngw, gtid, nthr; };

__device__ __forceinline__ void transpose_item(const float* W, int ldw, int K, int ncols, bf16* WT, LAS float* scr, int item, int lane, const float* gain = nullptr, int guperm = 0) {
    const int nblk = ncols / 32, kb = item / nblk, nb = item % nblk, k0 = 64 * kb, n0 = 32 * nb;
#pragma unroll
    for (int i = 0; i < 8; ++i) { const int kk = 8 * i + (lane >> 3), c4 = lane & 7;
        const f32x4 v = *(const f32x4*)(W + (size_t)(k0 + kk) * ldw + n0 + 4 * c4); const float gk = gain ? gain[k0 + kk] : 1.0f;
        LAS float* d = scr + kk * 33 + 4 * c4; d[0] = v.x * gk; d[1] = v.y * gk; d[2] = v.z * gk; d[3] = v.w * gk; }
    LDS_WAIT();
    const int c = lane & 7;
    int drow = n0; if (guperm) { const int isu = n0 >= guperm ? 1 : 0, nn = n0 - isu * guperm; drow = 256 * (nn >> 7) + 128 * isu + (nn & 127); }
#pragma unroll
    for (int j = 0; j < 4; ++j) { const int n = (lane >> 3) + 8 * j; const LAS float* s = scr + (8 * c) * 33 + n;
        u32x4 o; o.x = pk2(s[0 * 33], s[1 * 33]); o.y = pk2(s[2 * 33], s[3 * 33]); o.z = pk2(s[4 * 33], s[5 * 33]); o.w = pk2(s[6 * 33], s[7 * 33]);
        *(u32x4*)(WT + (size_t)(drow + n) * K + k0 + 8 * c) = o; }
    LDS_WAIT();
}
__device__ __forceinline__ void convert_weights(const Ctx& C, ArgsP a, int L, int part, int gw0, int ngw0) {
    LAS float* scr = (LAS float*)(C.lds + C.wave * 16384);
    unsigned char* ws = ws_ptr(a);
    const float* w_in = L == 0 ? INP(a, I_EVIN) : INP(a, I_ODIN); const int n_in = L == 0 ? 2048 : 3072, ld_in = L == 0 ? 2048 : 3080;
    const float* w_out = L == 0 ? INP(a, I_EVOUT) : INP(a, I_ODOUT);
    const float* wq = INP(a, I_WQ) + (size_t)L * DM * DM; const float* wkv = INP(a, I_WKV) + (size_t)L * DM * 2 * DM; const float* wo = INP(a, I_WO) + (size_t)L * DM * DM;
    const float* wup = INP(a, I_FUP) + (size_t)L * DM * DFF2; const float* wdn = INP(a, I_FDN) + (size_t)L * DFF * DM;
    const int i0 = (DM / 64) * (n_in / 32), i1 = (DM / 64) * (DM / 32), i2 = i1, i3 = (DM / 64) * (2 * DM / 32), i4 = i1, i5 = (DM / 64) * (DFF2 / 32), i6 = (DFF / 64) * (DM / 32);
    const int total = i0 + i1 + i2 + i3 + i4 + i5 + i6;
    for (int it = gw0; it < total; it += ngw0) {
        int r = it;
        { const bool first = (r < i0 + i1) || (r >= i0 + i1 + i2 && r < i0 + i1 + i2 + i3); if ((part == 0 && !first) || (part == 1 && first)) continue; }
        if (r < i0) {
            if (L == 0) {
                const int ia = (DM / 64) * (1024 / 32), ib = (DM / 64) * (512 / 32);
                if (r < ia) transpose_item(w_in, ld_in, DM, 1024, (bf16*)(ws + W_IN), scr, r, C.lane);
                else if (r < ia + ib) transpose_item(w_in + 1536, ld_in, DM, 512, (bf16*)(ws + W_IN) + (size_t)1024 * DM, scr, r - ia, C.lane);
                else transpose_item(w_in + 1024, ld_in, DM, 512, (bf16*)(ws + W_IN) + (size_t)1536 * DM, scr, r - ia - ib, C.lane);
            } else transpose_item(w_in, ld_in, DM, n_in, (bf16*)(ws + W_IN), scr, r, C.lane);
            continue; } r -= i0;
        if (r < i1) { transpose_item(w_out, DM, DM, DM, (bf16*)(ws + W_OUT), scr, r, C.lane); continue; } r -= i1;
        if (r < i2) { transpose_item(wq, DM, DM, DM, (bf16*)(ws + W_Q), scr, r, C.lane, INP(a, I_NXATTN) + L * DM); continue; } r -= i2;
        if (r < i3) { transpose_item(wkv, 2 * DM, DM, 2 * DM, (bf16*)(ws + W_KV), scr, r, C.lane); continue; } r -= i3;
        if (r < i4) { transpose_item(wo, DM, DM, DM, (bf16*)(ws + W_O), scr, r, C.lane); continue; } r -= i4;
        if (r < i5) { transpose_item(wup, DFF2, DM, DFF2, (bf16*)(ws + W_UP), scr, r, C.lane, INP(a, I_NFFN) + L * DM, DFF); continue; } r -= i5;
        transpose_item(wdn, DM, DFF, DM, (bf16*)(ws + W_DN), scr, r, C.lane);
    }
    if (L == 0 && part != 1) { const float* pw_ = INP(a, I_POOLW); bf16* pf_ = (bf16*)(ws + WS_PWT);
        for (int idx = gw0 * 64 + C.lane; idx < 4 * 128 * 128; idx += ngw0 * 64) { const int j = idx & 7, ln = (idx >> 3) & 63, ks = (idx >> 9) & 3, dt = (idx >> 11) & 7, g = idx >> 14;
            pf_[idx] = (bf16)f2bf(pw_[(size_t)(g * 128 + 32 * ks + 8 * (ln >> 4) + j) * 128 + 16 * dt + (ln & 15)]); } }
}
__device__ __forceinline__ void rms_row_bf16(const float* xrow, const float* gain, bf16* orow, int lane, bf16* orow2 = nullptr) {
    const f32x4* xr = (const f32x4*)xrow + lane; const f32x4* gr = (const f32x4*)gain + lane;
    f32x4 v[4]; float s = 0.f;
#pragma unroll
    for (int j = 0; j < 4; ++j) { v[j] = xr[64 * j]; s += (v[j].x * v[j].x + v[j].y * v[j].y) + (v[j].z * v[j].z + v[j].w * v[j].w); }
    const float r = 1.0f / sqrtf(wave_sum(s) * (1.0f / DM) + EPS);
    u32x2* o8 = (u32x2*)orow + lane;
#pragma unroll
    for (int j = 0; j < 4; ++j) { const f32x4 g = gr[64 * j]; u32x2 w; w.x = pk2(v[j].x * r * g.x, v[j].y * r * g.y); w.y = pk2(v[j].z * r * g.z, v[j].w * r * g.w); o8[64 * j] = w; if (orow2) ((u32x2*)orow2 + lane)[64 * j] = w; }
}
__device__ __forceinline__ int perm32k_pos(int s) { return (s < 16) ? (8 * (s >> 2) + (s & 3)) : (8 * ((s - 16) >> 2) + 4 + (s & 3)); }
__device__ __forceinline__ void rms_all_rows(const Ctx& C, const float* src, const float* gain, bf16* dst, int nrows, bf16* dstp = nullptr) {
    for (int m = C.gw; m < nrows; m += C.ngw) rms_row_bf16(src + (size_t)m * DM, gain, dst + (size_t)m * DM, C.lane, dstp ? dstp + (size_t)((m & ~31) + perm32k_pos(m & 31)) * DM : nullptr);
}
__device__ __forceinline__ void rms_rows_bg(const Ctx& C, ArgsP a, const bf16* HBin, bf16* XN, float* BG) {
    const float* gain = INP(a, I_NMIX) + DM; const float* W = INP(a, I_ODIN);
    const int lane = C.lane;
    for (int m = C.gw; m < NT; m += C.ngw) {
        const u32x2* xr = (const u32x2*)(HBin + (size_t)m * DM) + lane; const f32x4* gr = (const f32x4*)gain + lane;
        f32x4 v[4]; float s = 0.f;
#pragma unroll
        for (int j = 0; j < 4; ++j) { const u32x2 w_ = xr[64 * j]; v[j].x = lo16(w_.x); v[j].y = hi16(w_.x); v[j].z = lo16(w_.y); v[j].w = hi16(w_.y); s += (v[j].x * v[j].x + v[j].y * v[j].y) + (v[j].z * v[j].z + v[j].w * v[j].w); }
        const float r = 1.0f / sqrtf(wave_sum(s) * (1.0f / DM) + EPS);
        u32x2* o8 = (u32x2*)(XN + (size_t)m * DM) + lane;
        float d[8];
#pragma unroll
        for (int c = 0; c < 8; ++c) d[c] = 0.f;
#pragma unroll
        for (int j = 0; j < 4; ++j) { const f32x4 g = gr[64 * j]; f32x4 y; y.x = v[j].x * r * g.x; y.y = v[j].y * r * g.y; y.z = v[j].z * r * g.z; y.w = v[j].w * r * g.w;
            u32x2 w; w.x = pk2(y.x, y.y); w.y = pk2(y.z, y.w); o8[64 * j] = w;
#pragma unroll
            for (int e = 0; e < 4; ++e) { const int k = 4 * lane + 256 * j + e; const f32x4 w0 = *(const f32x4*)(W + (size_t)k * 3080 + 3072), w1 = *(const f32x4*)(W + (size_t)k * 3080 + 3076);
                const float ye = y[e]; d[0] += ye * w0.x; d[1] += ye * w0.y; d[2] += ye * w0.z; d[3] += ye * w0.w; d[4] += ye * w1.x; d[5] += ye * w1.y; d[6] += ye * w1.z; d[7] += ye * w1.w; } }
#pragma unroll
        for (int c = 0; c < 8; ++c) d[c] = wave_sum(d[c]);
        if (lane < 4) {
            const float braw = lane == 0 ? d[0] : lane == 1 ? d[1] : lane == 2 ? d[2] : d[3];
            const float araw = lane == 0 ? d[4] : lane == 1 ? d[5] : lane == 2 ? d[6] : d[7];
            const float beta = 1.0f / (1.0f + expf(-braw));
            const float xx = araw + INP(a, I_DNDT)[lane];
            const float sp = xx > 20.f ? xx : log1pf(expf(xx));
            BG[(size_t)m * 8 + lane] = beta; BG[(size_t)m * 8 + 4 + lane] = -expf(INP(a, I_DNALOG)[lane]) * sp;
        }
    }
}
__device__ __forceinline__ void final_norm(const Ctx& C, const bf16* HBin, float* out, const float* gain) {
    for (int m = C.gw; m < NT; m += C.ngw) {
        const u32x2* xr = (const u32x2*)(HBin + (size_t)m * DM) + C.lane; const f32x4* gr = (const f32x4*)gain + C.lane; f32x4* orow = (f32x4*)(out + (size_t)m * DM) + C.lane;
        f32x4 v[4]; float s = 0.f;
#pragma unroll
        for (int j = 0; j < 4; ++j) { const u32x2 w_ = xr[64 * j]; v[j].x = lo16(w_.x); v[j].y = hi16(w_.x); v[j].z = lo16(w_.y); v[j].w = hi16(w_.y); s += (v[j].x * v[j].x + v[j].y * v[j].y) + (v[j].z * v[j].z + v[j].w * v[j].w); }
        const float r = 1.0f / sqrtf(wave_sum(s) * (1.0f / DM) + EPS);
#pragma unroll
        for (int j = 0; j < 4; ++j) { const f32x4 g = gr[64 * j]; f32x4 y; y.x = v[j].x * r * g.x; y.y = v[j].y * r * g.y; y.z = v[j].z * r * g.z; y.w = v[j].w * r * g.w; orow[64 * j] = y; }
    }
}
__device__ __forceinline__ void kmean_pooled(const Ctx& C, const bf16* PROJ, float* KMEAN) {
    const int lane = C.lane, d4 = lane & 15, rq = lane >> 4;
    for (int it = C.gw; it < 2 * 8 * 32; it += C.ngw) {
        const int blk = it & 31, h = (it >> 5) & 7, b = it >> 8;
        const bf16* p = PROJ + (size_t)(b * SEQ + blk * 256 + rq * 64) * 1536 + 512 + h * 64 + 4 * d4; float s0 = 0.f, s1 = 0.f, s2 = 0.f, s3 = 0.f;
#pragma unroll 8
        for (int r = 0; r < 64; ++r) { const u32x2 w = *(const u32x2*)(p + (size_t)r * 1536); s0 += lo16(w.x); s1 += hi16(w.x); s2 += lo16(w.y); s3 += hi16(w.y); }
        s0 += __shfl_xor(s0, 16); s1 += __shfl_xor(s1, 16); s2 += __shfl_xor(s2, 16); s3 += __shfl_xor(s3, 16);
        s0 += __shfl_xor(s0, 32); s1 += __shfl_xor(s1, 32); s2 += __shfl_xor(s2, 32); s3 += __shfl_xor(s3, 32);
        if (rq == 0) { f32x4 o; o.x = s0 * (1.0f / 256.0f); o.y = s1 * (1.0f / 256.0f); o.z = s2 * (1.0f / 256.0f); o.w = s3 * (1.0f / 256.0f); *(f32x4*)(KMEAN + (size_t)it * 64 + 4 * d4) = o; }
    }
}
__device__ __forceinline__ void unpack8(const u32x4 w, float* f) { f[0] = lo16(w.x); f[1] = hi16(w.x); f[2] = lo16(w.y); f[3] = hi16(w.y); f[4] = lo16(w.z); f[5] = hi16(w.z); f[6] = lo16(w.w); f[7] = hi16(w.w); }
__device__ __forceinline__ void moba_naive(const Ctx& C, const bf16* PROJ, const float* KMEAN, bf16* MIX) {
    for (int idx = C.gtid; idx < 2 * 8 * SEQ; idx += C.nthr) {
        const int t = idx & (SEQ - 1), bh = idx >> 13, h = bh & 7, b = bh >> 3, row = b * SEQ + t, qb = t >> 8;
        float q[64];
        { const u32x4* qp = (const u32x4*)(PROJ + (size_t)row * 2048 + h * 64);
#pragma unroll
          for (int i = 0; i < 8; ++i) unpack8(qp[i], q + 8 * i); }
        float b0 = -INFINITY, b1 = -INFINITY, b2 = -INFINITY; int i0 = -1, i1 = -1, i2 = -1;
        const float* km = KMEAN + (size_t)bh * 32 * 64;
        for (int j = 0; j < qb; ++j) { float s = 0.f;
#pragma unroll
            for (int d = 0; d < 64; ++d) s += q[d] * km[j * 64 + d];
            if (s > b0) { b2 = b1; i2 = i1; b1 = b0; i1 = i0; b0 = s; i0 = j; } else if (s > b1) { b2 = b1; i2 = i1; b1 = s; i1 = j; } else if (s > b2) { b2 = s; i2 = j; } }
        float m = -INFINITY, l = 0.f, o[64];
#pragma unroll
        for (int d = 0; d < 64; ++d) o[d] = 0.f;
        for (int si = 0; si < 4; ++si) {
            const int blk = si == 0 ? i0 : si == 1 ? i1 : si == 2 ? i2 : qb;
            if (blk < 0) continue;
            const int nk = (si == 3) ? (t - qb * 256 + 1) : 256;
            const bf16* kp = PROJ + (size_t)(b * SEQ + blk * 256) * 2048 + 512 + h * 64;
            for (int kk = 0; kk < nk; ++kk) {
                const u32x4* kr = (const u32x4*)(kp + (size_t)kk * 2048); const u32x4* vr = (const u32x4*)(kp + (size_t)kk * 2048 + 512);
                float s = 0.f;
#pragma unroll
                for (int i = 0; i < 8; ++i) { float f[8]; unpack8(kr[i], f);
#pragma unroll
                    for (int e = 0; e < 8; ++e) s += q[8 * i + e] * f[e]; }
                s *= 0.125f;
                const float mn = fmaxf(m, s), corr = __expf(m - mn), p = __expf(s - mn);
                l = l * corr + p; m = mn;
#pragma unroll
                for (int i = 0; i < 8; ++i) { float f[8]; unpack8(vr[i], f);
#pragma unroll
                    for (int e = 0; e < 8; ++e) o[8 * i + e] = o[8 * i + e] * corr + p * f[e]; }
            }
        }
        const float il = 1.0f / l; u32x4* op = (u32x4*)(MIX + (size_t)row * 1024 + h * 64);
#pragma unroll
        for (int i = 0; i < 8; ++i) { u32x4 w; w.x = pk2(o[8 * i] * il, o[8 * i + 1] * il); w.y = pk2(o[8 * i + 2] * il, o[8 * i + 3] * il); w.z = pk2(o[8 * i + 4] * il, o[8 * i + 5] * il); w.w = pk2(o[8 * i + 6] * il, o[8 * i + 7] * il); op[i] = w; }
    }
}
__device__ __forceinline__ void pool_linear_naive(const Ctx& C, const bf16* POOLED, const float* pool_w, const float* pool_scale, bf16* MIX) {
    for (size_t idx = C.gtid; idx < (size_t)NT * 512; idx += C.nthr) {
        const int co = (int)(idx & 511), row = (int)(idx >> 9), g = co >> 7, d = co & 127;
        const bf16* pp = POOLED + (size_t)row * 512 + g * 128; const float* w = pool_w + (size_t)g * 128 * 128 + d; float s = 0.f;
        for (int c = 0; c < 128; ++c) s += bf2f(pp[c]) * w[(size_t)c * 128];
        MIX[(size_t)row * 1024 + 512 + co] = (bf16)f2bf(s * pool_scale[co]);
    }
}
__device__ __forceinline__ void xattn_naive(const Ctx& C, const bf16* QX, const bf16* KVX, bf16* OX) {
    LAS float* qs = (LAS float*)(C.lds + C.wave * 2048); LAS float* ps = qs + 256; const int lane = C.lane;
    for (int it = C.gw; it < NT * 4; it += C.ngw) {
        const int row = it >> 2, hd = it & 3, b = row >> 13;
        { const u32x2 w = *((const u32x2*)(QX + (size_t)row * 1024 + hd * 256) + lane); qs[4 * lane] = lo16(w.x); qs[4 * lane + 1] = hi16(w.x); qs[4 * lane + 2] = lo16(w.y); qs[4 * lane + 3] = hi16(w.y); }
        LDS_WAIT();
        float s[4];
#pragma unroll
        for (int i = 0; i < 4; ++i) { const int j = lane + 64 * i; const u32x4* kr = (const u32x4*)(KVX + (size_t)(b * NMEM + j) * 2048 + hd * 256); float acc = 0.f;
            for (int d8 = 0; d8 < 32; ++d8) { float f[8]; unpack8(kr[d8], f); const f32x4 qa = *(const LAS f32x4*)(qs + 8 * d8), qb = *(const LAS f32x4*)(qs + 8 * d8 + 4);
                acc += f[0] * qa.x + f[1] * qa.y + f[2] * qa.z + f[3] * qa.w + f[4] * qb.x + f[5] * qb.y + f[6] * qb.z + f[7] * qb.w; }
            s[i] = acc * 0.0625f; }
        const float mx = wave_max(fmaxf(fmaxf(s[0], s[1]), fmaxf(s[2], s[3])));
        float p[4], sum = 0.f;
#pragma unroll
        for (int i = 0; i < 4; ++i) { p[i] = __expf(s[i] - mx); sum += p[i]; }
        sum = wave_sum(sum); const float inv = 1.0f / sum;
#pragma unroll
        for (int i = 0; i < 4; ++i) ps[lane + 64 * i] = p[i] * inv;
        LDS_WAIT();
        float o0 = 0.f, o1 = 0.f, o2 = 0.f, o3 = 0.f; const bf16* vb = KVX + (size_t)(b * NMEM) * 2048 + 1024 + hd * 256 + 4 * lane;
        for (int j = 0; j < 256; ++j) { const float pj = ps[j]; const u32x2 w = *(const u32x2*)(vb + (size_t)j * 2048); o0 += pj * lo16(w.x); o1 += pj * hi16(w.x); o2 += pj * lo16(w.y); o3 += pj * hi16(w.y); }
        u32x2 w; w.x = pk2(o0, o1); w.y = pk2(o2, o3); *((u32x2*)(OX + (size_t)row * 1024 + hd * 256) + lane) = w;
        LDS_WAIT();
    }
}
__device__ __forceinline__ void ffn_act(const Ctx& C, const bf16* HUP, const float* cw, bf16* ACT, int hb) {
    for (int idx = C.gtid; idx < (SEQ / 8) * 352; idx += C.nthr) {
        const int c8 = idx % 352, rb = idx / 352, c = c8 * 8, t0 = rb * 8;
        float wg[3][8], wu[3][8];
#pragma unroll
        for (int k = 0; k < 3; ++k) { const f32x4 a0 = *(const f32x4*)(cw + (size_t)k * DFF2 + c), a1 = *(const f32x4*)(cw + (size_t)k * DFF2 + c + 4), b0 = *(const f32x4*)(cw + (size_t)k * DFF2 + DFF + c), b1 = *(const f32x4*)(cw + (size_t)k * DFF2 + DFF + c + 4);
            wg[k][0] = a0.x; wg[k][1] = a0.y; wg[k][2] = a0.z; wg[k][3] = a0.w; wg[k][4] = a1.x; wg[k][5] = a1.y; wg[k][6] = a1.z; wg[k][7] = a1.w;
            wu[k][0] = b0.x; wu[k][1] = b0.y; wu[k][2] = b0.z; wu[k][3] = b0.w; wu[k][4] = b1.x; wu[k][5] = b1.y; wu[k][6] = b1.z; wu[k][7] = b1.w; }
        float g0[8], g1[8], u0[8], u1[8];
        if (t0 >= 2) { unpack8(*(const u32x4*)(HUP + (size_t)(t0 - 2) * DFF2 + c), g0); unpack8(*(const u32x4*)(HUP + (size_t)(t0 - 2) * DFF2 + DFF + c), u0);
                       unpack8(*(const u32x4*)(HUP + (size_t)(t0 - 1) * DFF2 + c), g1); unpack8(*(const u32x4*)(HUP + (size_t)(t0 - 1) * DFF2 + DFF + c), u1); }
        else {
#pragma unroll
            for (int e = 0; e < 8; ++e) { g0[e] = 0.f; g1[e] = 0.f; u0[e] = 0.f; u1[e] = 0.f; } }
#pragma unroll
        for (int r = 0; r < 8; ++r) {
            float g2[8], u2[8]; unpack8(*(const u32x4*)(HUP + (size_t)(t0 + r) * DFF2 + c), g2); unpack8(*(const u32x4*)(HUP + (size_t)(t0 + r) * DFF2 + DFF + c), u2);
            float o[8];
#pragma unroll
            for (int e = 0; e < 8; ++e) { const float gv = wg[0][e] * g0[e] + wg[1][e] * g1[e] + wg[2][e] * g2[e], uv = wu[0][e] * u0[e] + wu[1][e] * u1[e] + wu[2][e] * u2[e]; o[e] = silu_f(gv) * uv; }
            u32x4 w; w.x = pk2(o[0], o[1]); w.y = pk2(o[2], o[3]); w.z = pk2(o[4], o[5]); w.w = pk2(o[6], o[7]);
            *(u32x4*)(ACT + (size_t)(hb * SEQ + t0 + r) * DFF + c) = w;
#pragma unroll
            for (int e = 0; e < 8; ++e) { g0[e] = g1[e]; g1[e] = g2[e]; u0[e] = u1[e]; u1[e] = u2[e]; }
        }
    }
}
__device__ __forceinline__ void l1_prep_naive(const Ctx& C, ArgsP a, const bf16* Z, const bf16* QKV, bf16* VN, bf16* QN, bf16* KN, bf16* VV) {
    const int lane = C.lane;
    const float* lng = INP(a, I_SGUG); const float* lnb = INP(a, I_SGUB); const float* cw = INP(a, I_DNCONV);
    for (int row = C.gw; row < NT; row += C.ngw) {
        float f[8]; unpack8(*((const u32x4*)(Z + (size_t)row * 1024 + 512) + lane), f);
        float s = 0.f;
#pragma unroll
        for (int e = 0; e < 8; ++e) s += f[e];
        const float mu = wave_sum(s) * (1.0f / 512.0f); float q = 0.f;
#pragma unroll
        for (int e = 0; e < 8; ++e) { f[e] -= mu; q += f[e] * f[e]; }
        const float rstd = 1.0f / sqrtf(wave_sum(q) * (1.0f / 512.0f) + EPS);
        const f32x4 g0 = *((const f32x4*)lng + 2 * lane), g1 = *((const f32x4*)lng + 2 * lane + 1), c0 = *((const f32x4*)lnb + 2 * lane), c1 = *((const f32x4*)lnb + 2 * lane + 1);
        u32x4 w; w.x = pk2(f[0] * rstd * g0.x + c0.x, f[1] * rstd * g0.y + c0.y); w.y = pk2(f[2] * rstd * g0.z + c0.z, f[3] * rstd * g0.w + c0.w);
        w.z = pk2(f[4] * rstd * g1.x + c1.x, f[5] * rstd * g1.y + c1.y); w.w = pk2(f[6] * rstd * g1.z + c1.z, f[7] * rstd * g1.w + c1.w);
        { bf16* vt = VN + ((size_t)(row >> 7) * 512 + 8 * lane) * 128 + (row & 127);
          vt[0] = (bf16)(w.x & 0xffffu); vt[128] = (bf16)(w.x >> 16); vt[256] = (bf16)(w.y & 0xffffu); vt[384] = (bf16)(w.y >> 16);
          vt[512] = (bf16)(w.z & 0xffffu); vt[640] = (bf16)(w.z >> 16); vt[768] = (bf16)(w.w & 0xffffu); vt[896] = (bf16)(w.w >> 16); }
    }
    for (int it = C.gw; it < NT * 4; it += C.ngw) {
        const int row = it >> 2, hh = it & 3, tl = row & (SEQ - 1), c = hh * 128 + 2 * lane;
        float y[3][2];
#pragma unroll
        for (int s3 = 0; s3 < 3; ++s3) { const int cs = s3 * 512 + c; float a0 = 0.f, a1 = 0.f;
#pragma unroll
            for (int j = 0; j < 4; ++j) { const int ts = tl - 3 + j; if (ts < 0) continue;
                const unsigned w = *(const unsigned*)(QKV + (size_t)(row - 3 + j) * 1536 + cs); a0 += cw[j * 1536 + cs] * lo16(w); a1 += cw[j * 1536 + cs + 1] * hi16(w); }
            y[s3][0] = silu_f(a0); y[s3][1] = silu_f(a1); }
        const float rq = 1.0f / sqrtf(wave_sum(y[0][0] * y[0][0] + y[0][1] * y[0][1]) + EPS) * 0.08838834764831845f;
        const float rk = 1.0f / sqrtf(wave_sum(y[1][0] * y[1][0] + y[1][1] * y[1][1]) + EPS);
        *(unsigned*)(QN + (size_t)row * 512 + c) = pk2(y[0][0] * rq, y[0][1] * rq);
        *(unsigned*)(KN + (size_t)row * 512 + c) = pk2(y[1][0] * rk, y[1][1] * rk);
        *(unsigned*)(VV + (size_t)row * 512 + c) = pk2(y[2][0], y[2][1]);
    }
}
__device__ __forceinline__ void sgu_naive(const Ctx& C, ArgsP a, const bf16* Z, const bf16* VN, bf16* MIX, int blk0, int nblk) {
    const float* sw = INP(a, I_SGUW); const float* sb = INP(a, I_SGUBS);
    const size_t start = (size_t)(blockIdx.x - blk0) * 512 + C.tid, stride = (size_t)nblk * 512;
    for (size_t idx = start; idx < (size_t)NT * 512; idx += stride) {
        const int ch = (int)(idx & 511), row = (int)(idx >> 9), g = ch >> 7, tl = row & 127, r0 = row & ~127;
        const float* w = sw + (size_t)(g * 128 + tl) * 128; const bf16* vp = VN + (size_t)r0 * 512 + ch; float s = 0.f;
        for (int k = 0; k <= tl; ++k) s += w[k] * bf2f(vp[(size_t)k * 512]);
        s += sb[g * 128 + tl];
        MIX[(size_t)row * 1024 + ch] = (bf16)f2bf(bf2f(Z[(size_t)row * 1024 + ch]) * s);
    }
}
__device__ __forceinline__ void dn_recurrent(const Ctx& C, const bf16* QN, const bf16* KN, const bf16* VV, const float* BG, float* O, int bh) {
    const int b = bh >> 2, hh = bh & 3, dv = C.tid & 127, g4 = C.tid >> 7;
    LAS float* red1 = (LAS float*)C.lds; LAS float* red2 = red1 + 512;
    float S[32];
#pragma unroll
    for (int i = 0; i < 32; ++i) S[i] = 0.f;
    for (int t = 0; t < SEQ; ++t) {
        const size_t row = (size_t)b * SEQ + t;
        const u32x4* kp = (const u32x4*)(KN + row * 512 + hh * 128 + 32 * g4); const u32x4* qp = (const u32x4*)(QN + row * 512 + hh * 128 + 32 * g4);
        float kk[32], qq[32];
#pragma unroll
        for (int i = 0; i < 4; ++i) { unpack8(kp[i], kk + 8 * i); unpack8(qp[i], qq + 8 * i); }
        const float vv = bf2f(VV[row * 512 + hh * 128 + dv]), beta = BG[row * 8 + hh], av = __expf(BG[row * 8 + 4 + hh]);
        float part = 0.f;
#pragma unroll
        for (int i = 0; i < 32; ++i) part += kk[i] * S[i];
        red1[g4 * 128 + dv] = part; __syncthreads();
        const float kS = (red1[dv] + red1[128 + dv]) + (red1[256 + dv] + red1[384 + dv]);
        const float vnew = beta * (vv - av * kS);
        float op = 0.f;
#pragma unroll
        for (int i = 0; i < 32; ++i) { S[i] = av * S[i] + kk[i] * vnew; op += qq[i] * S[i]; }
        red2[g4 * 128 + dv] = op; __syncthreads();
        if (g4 == 0) O[row * 512 + hh * 128 + dv] = (red2[dv] + red2[128 + dv]) + (red2[256 + dv] + red2[384 + dv]);
    }
    __syncthreads();
}
__device__ __forceinline__ void dn_out_gate(const Ctx& C, ArgsP a, const float* O, const bf16* GATE, bf16* MIX) {
    const float* ng = INP(a, I_DNNG); const int lane = C.lane;
    const f32x4 n0 = *(const f32x4*)(ng + ((8 * lane) & 127)), n1 = *(const f32x4*)(ng + ((8 * lane) & 127) + 4);
    for (int row = C.gw; row < NT; row += C.ngw) {
        const f32x4 o0 = *((const f32x4*)(O + (size_t)row * 512) + 2 * lane), o1 = *((const f32x4*)(O + (size_t)row * 512) + 2 * lane + 1);
        float ss = ((o0.x * o0.x + o0.y * o0.y) + (o0.z * o0.z + o0.w * o0.w)) + ((o1.x * o1.x + o1.y * o1.y) + (o1.z * o1.z + o1.w * o1.w));
        ss += __shfl_xor(ss, 1); ss += __shfl_xor(ss, 2); ss += __shfl_xor(ss, 4); ss += __shfl_xor(ss, 8);
        const float r = 1.0f / sqrtf(ss * (1.0f / 128.0f) + EPS);
        float g[8]; unpack8(*((const u32x4*)(GATE + (size_t)row * 512) + lane), g);
        u32x4 w; w.x = pk2(o0.x * r * n0.x * silu_f(g[0]), o0.y * r * n0.y * silu_f(g[1])); w.y = pk2(o0.z * r * n0.z * silu_f(g[2]), o0.w * r * n0.w * silu_f(g[3]));
        w.z = pk2(o1.x * r * n1.x * silu_f(g[4]), o1.y * r * n1.y * silu_f(g[5])); w.w = pk2(o1.z * r * n1.z * silu_f(g[6]), o1.w * r * n1.w * silu_f(g[7]));
        *((u32x4*)(MIX + (size_t)row * 1024 + 512) + lane) = w;
    }
}
typedef short bf16x8 __attribute__((ext_vector_type(8)));
#define MFMA16(a, b, c) __builtin_amdgcn_mfma_f32_16x16x32_bf16((a), (b), (c), 0, 0, 0)
__device__ __forceinline__ float rdlane(float v, int i) { return __uint_as_float(__builtin_amdgcn_readlane(__float_as_uint(v), i)); }
#define WG_BAR() do { asm volatile("s_waitcnt vmcnt(0) lgkmcnt(0)" ::: "memory"); __builtin_amdgcn_s_barrier(); asm volatile("" ::: "memory"); } while (0)
#define LDS_BAR() do { asm volatile("s_waitcnt lgkmcnt(0)" ::: "memory"); __builtin_amdgcn_s_barrier(); asm volatile("" ::: "memory"); } while (0)

#define FRAG_W(i, k)  (((((i) >> 4) * 4 + ((k) >> 5)) * 64 + (((k) >> 3) & 3) * 16 + ((i) & 15)) * 8 + ((k) & 7))
#define FRAG_QK(i, j) (((((i) >> 4) * 2 + ((j) >> 5)) * 64 + (((j) >> 3) & 3) * 16 + ((i) & 15)) * 8 + ((j) & 7))
#define FRAG_KD(d, t) ((((((d) >> 5) * 2 + (((d) >> 4) & 1)) * 2 + ((t) >> 5)) * 64 + (((t) >> 3) & 3) * 16 + ((d) & 15)) * 8 + ((t) & 7))
#define FRAG_U(i, v)  (((((v) >> 4) * 4 + ((i) >> 4)) * 64 + (((i) >> 2) & 3) * 16 + ((v) & 15)) * 4 + ((i) & 3))
__device__ __forceinline__ void dn_chunk_prep(const Ctx& C, const bf16* QN, const bf16* KN, const bf16* VV, const float* BG, bf16* U, bf16* Wm, bf16* QD, bf16* KDT, bf16* QKm, float* GL) {
    LAS float* Am = (LAS float*)(C.lds + C.wave * 16384);
    const int lane = C.lane, fr = lane & 15, fq = lane >> 4;
    for (int it4 = C.gw; it4 < 4096; it4 += C.ngw) {
        const int it = it4 >> 2, ps = it4 & 3;
        const int n = it & 127, hh = (it >> 7) & 3, b = it >> 9;
        const size_t row0 = (size_t)b * SEQ + (size_t)n * 64;
        const float beta = BG[(row0 + lane) * 8 + hh], gg = BG[(row0 + lane) * 8 + 4 + hh];
        float gc = gg;
#pragma unroll
        for (int o = 1; o < 64; o <<= 1) { const float t = __shfl_up(gc, o); if (lane >= o) gc += t; }
        const float gcl = rdlane(gc, 63);
        const bf16* Kb = KN + row0 * 512 + hh * 128; const bf16* Qb = QN + row0 * 512 + hh * 128; const bf16* Vb = VV + row0 * 512 + hh * 128;
        bf16* qkm = QKm + (size_t)it * 4096;
#pragma unroll 1
        for (int mt = 0; mt < 4; ++mt) {
            bf16x8 ak[4], aq[4];
#pragma unroll
            for (int ks = 0; ks < 4; ++ks) { ak[ks] = *(const bf16x8*)(Kb + (size_t)(16 * mt + fr) * 512 + 32 * ks + 8 * fq); aq[ks] = *(const bf16x8*)(Qb + (size_t)(16 * mt + fr) * 512 + 32 * ks + 8 * fq); }
#pragma unroll 1
            for (int nt = 0; nt < 4; ++nt) {
                const int j = 16 * nt + fr;
                if (nt > mt) {
                    if (ps == 0) {
#pragma unroll
                        for (int r = 0; r < 4; ++r) qkm[FRAG_QK(16 * mt + 4 * fq + r, j)] = 0; }
                    continue;
                }
                f32x4 ckk = {0.f, 0.f, 0.f, 0.f}, cqk = {0.f, 0.f, 0.f, 0.f};
#pragma unroll
                for (int ks = 0; ks < 4; ++ks) { const bf16x8 bk = *(const bf16x8*)(Kb + (size_t)(16 * nt + fr) * 512 + 32 * ks + 8 * fq); ckk = MFMA16(ak[ks], bk, ckk); cqk = MFMA16(aq[ks], bk, cqk); }
                const float gj = __shfl(gc, j);
#pragma unroll
                for (int r = 0; r < 4; ++r) { const int i = 16 * mt + 4 * fq + r; const float gi = __shfl(gc, i), bi = __shfl(beta, i);
                    const float dec = (i >= j) ? __expf(gi - gj) : 0.f;
                    Am[i * 64 + j] = (i > j) ? bi * ckk[r] * dec : 0.f;
                    if (ps == 0) qkm[FRAG_QK(i, j)] = (bf16)f2bf((i >= j) ? cqk[r] * dec : 0.f); }
            }
        }
        LDS_WAIT();
        { const int p = ps;
            const int c = lane + 64 * (p & 1); const bf16* src = (p < 2 ? Vb : Kb) + c; bf16* dstb = (p < 2 ? U : Wm) + (size_t)it * 8192;
            float x[64];
#pragma unroll
            for (int i = 0; i < 64; ++i) { const float bi = rdlane(beta, i), gi = rdlane(gc, i); x[i] = bf2f(src[(size_t)i * 512]) * (p < 2 ? bi : bi * __expf(gi)); if ((i & 7) == 7) __builtin_amdgcn_sched_barrier(0); }
            float Ar[64];
#pragma unroll
            for (int i = 1; i < 64; ++i) Ar[i] = Am[i * 64 + lane];
            LDS_WAIT();
#pragma unroll
            for (int i = 1; i < 64; ++i) {
                float acc = x[i];
#pragma unroll
                for (int j = 0; j < i; ++j) acc -= rdlane(Ar[i], j) * x[j];
                x[i] = acc;
            }
#pragma unroll
            for (int i = 0; i < 64; ++i) dstb[p < 2 ? FRAG_U(i, c) : FRAG_W(i, c)] = (bf16)f2bf(x[i]);
        }
        bf16* qd = QD + (size_t)it * 8192;
        if (ps == 1)
#pragma unroll 4
        for (int i = 0; i < 64; ++i) { const float e = __expf(__shfl(gc, i)); const unsigned w = *(const unsigned*)(Qb + (size_t)i * 512 + 2 * lane); *(unsigned*)(qd + FRAG_W(i, 2 * lane)) = pk2(lo16(w) * e, hi16(w) * e); }
        bf16* kdt = KDT + (size_t)it * 8192; const float ek = __expf(gcl - gc);
        if (ps == 2)
#pragma unroll 2
        for (int d8 = 0; d8 < 16; ++d8) { float f[8]; unpack8(*(const u32x4*)(Kb + (size_t)lane * 512 + 8 * d8), f);
#pragma unroll
            for (int e = 0; e < 8; ++e) kdt[FRAG_KD(8 * d8 + e, lane)] = (bf16)f2bf(f[e] * ek); }
        if (ps == 3 && lane == 0) GL[it] = __expf(gcl);
        LDS_WAIT();
    }
}
constexpr int SB_LD = 136, VN_LD = 72;
__device__ __forceinline__ void dn_scan(const Ctx& C, const bf16* U, const bf16* Wm, const bf16* QD, const bf16* KDT, const bf16* QKm, const float* GL, float* O, int it) {
    const int bh = it & 7, sl = it >> 3, hh = bh & 3, b = bh >> 2, dv0 = sl * 16;
    LAS bf16* SbT = (LAS bf16*)C.lds;
    LAS bf16* VnT = (LAS bf16*)(C.lds + 16384);
    LAS float* glb = (LAS float*)(C.lds + 24576);
    for (int i = C.tid; i < 2 * 16 * SB_LD / 2; i += 512) ((LAS unsigned*)SbT)[i] = 0u;
    if (C.tid < 128) glb[C.tid] = GL[(size_t)(it & 7) * 128 + C.tid];
    __syncthreads();
    const int w = C.wave, lane = C.lane, fr = lane & 15, fq = lane >> 4;
    f32x4 S0 = {0.f, 0.f, 0.f, 0.f}, S1 = S0;
    const size_t item0 = (size_t)bh * 128;
    if (w < 4) {
        bf16x8 cw[4][4], ck[4][4]; float cu[4][4];
#define DN_LOAD_A(set, st) do { const size_t it_ = item0 + (st); \
            const bf16* wp_ = Wm + it_ * 8192 + (size_t)(w * 4 * 64 + lane) * 8; const bf16* up_ = U + it_ * 8192 + (size_t)((sl * 4 + w) * 64 + lane) * 4; const bf16* kp_ = KDT + it_ * 8192 + (size_t)(w * 4 * 64 + lane) * 8; \
            _Pragma("unroll") for (int ks = 0; ks < 4; ++ks) cw[set][ks] = *(const bf16x8*)(wp_ + 512 * ks); \
            { const u32x2 uw_ = *(const u32x2*)up_; cu[set][0] = lo16(uw_.x); cu[set][1] = hi16(uw_.x); cu[set][2] = lo16(uw_.y); cu[set][3] = hi16(uw_.y); } \
            ck[set][0] = *(const bf16x8*)(kp_); ck[set][1] = *(const bf16x8*)(kp_ + 512); ck[set][2] = *(const bf16x8*)(kp_ + 1024); ck[set][3] = *(const bf16x8*)(kp_ + 1536); } while (0)
        DN_LOAD_A(0, 0); DN_LOAD_A(1, 1); DN_LOAD_A(2, 2);
        for (int n0 = 0; n0 < 128; n0 += 4) {
#pragma unroll
            for (int k = 0; k < 4; ++k) {
                const int n = n0 + k, ns = (n + 3 < 128) ? n + 3 : 127;
                DN_LOAD_A((k + 3) & 3, ns);
                LAS bf16* Sc = SbT + (k & 1) * 16 * SB_LD; LAS bf16* Sn = SbT + ((k & 1) ^ 1) * 16 * SB_LD;
                f32x4 t1 = {0.f, 0.f, 0.f, 0.f};
                { bf16x8 sb[4];
#pragma unroll
                  for (int ks = 0; ks < 4; ++ks) sb[ks] = *(const LAS bf16x8*)(Sc + fr * SB_LD + 32 * ks + 8 * fq);
                  __builtin_amdgcn_sched_barrier(0);
#pragma unroll
                  for (int ks = 0; ks < 4; ++ks) t1 = MFMA16(cw[k][ks], sb[ks], t1); }
                u32x2 pw; pw.x = pk2(cu[k][0] - t1[0], cu[k][1] - t1[1]); pw.y = pk2(cu[k][2] - t1[2], cu[k][3] - t1[3]);
                *(LAS u32x2*)(VnT + fr * VN_LD + 16 * w + 4 * fq) = pw;
                LDS_BAR();
                bf16x8 vb[2];
                { const float gl = glb[n]; S0 = S0 * gl; S1 = S1 * gl; }
#pragma unroll
                for (int ks = 0; ks < 2; ++ks) vb[ks] = *(const LAS bf16x8*)(VnT + fr * VN_LD + 32 * ks + 8 * fq);
                __builtin_amdgcn_sched_barrier(0);
#pragma unroll
                for (int ks = 0; ks < 2; ++ks) { S0 = MFMA16(ck[k][ks], vb[ks], S0); S1 = MFMA16(ck[k][2 + ks], vb[ks], S1); }
                u32x2 s0; s0.x = pk2(S0[0], S0[1]); s0.y = pk2(S0[2], S0[3]); u32x2 s1; s1.x = pk2(S1[0], S1[1]); s1.y = pk2(S1[2], S1[3]);
                *(LAS u32x2*)(Sn + fr * SB_LD + 32 * w + 4 * fq) = s0; *(LAS u32x2*)(Sn + fr * SB_LD + 32 * w + 16 + 4 * fq) = s1;
                LDS_BAR();
            }
        }
#undef DN_LOAD_A
    } else {
        const int w2 = w - 4;
        bf16x8 cq[4][4], cm[4][2];
#define DN_LOAD_B(set, st) do { const size_t it_ = item0 + (st); const bf16* qp_ = QD + it_ * 8192 + (size_t)(w2 * 4 * 64 + lane) * 8; const bf16* mp_ = QKm + it_ * 4096 + (size_t)(w2 * 2 * 64 + lane) * 8; \
            _Pragma("unroll") for (int ks = 0; ks < 4; ++ks) cq[set][ks] = *(const bf16x8*)(qp_ + 512 * ks); \
            cm[set][0] = *(const bf16x8*)(mp_); cm[set][1] = *(const bf16x8*)(mp_ + 512); } while (0)
        DN_LOAD_B(0, 0); DN_LOAD_B(1, 1); DN_LOAD_B(2, 2);
        for (int n0 = 0; n0 < 128; n0 += 4) {
#pragma unroll
            for (int k = 0; k < 4; ++k) {
                const int n = n0 + k, ns = (n + 3 < 128) ? n + 3 : 127;
                DN_LOAD_B((k + 3) & 3, ns);
                LAS bf16* Sc = SbT + (k & 1) * 16 * SB_LD;
                f32x4 o = {0.f, 0.f, 0.f, 0.f};
                { bf16x8 sb[4];
#pragma unroll
                  for (int ks = 0; ks < 4; ++ks) sb[ks] = *(const LAS bf16x8*)(Sc + fr * SB_LD + 32 * ks + 8 * fq);
                  __builtin_amdgcn_sched_barrier(0);
#pragma unroll
                  for (int ks = 0; ks < 4; ++ks) o = MFMA16(cq[k][ks], sb[ks], o); }
                LDS_BAR();
                o = MFMA16(cm[k][0], *(const LAS bf16x8*)(VnT + fr * VN_LD + 8 * fq), o);
                o = MFMA16(cm[k][1], *(const LAS bf16x8*)(VnT + fr * VN_LD + 32 + 8 * fq), o);
                float* op = O + ((size_t)b * SEQ + (size_t)n * 64 + 16 * w2 + 4 * fq) * 512 + hh * 128 + dv0 + fr;
                op[0] = o[0]; op[512] = o[1]; op[1024] = o[2]; op[1536] = o[3];
                LDS_BAR();
            }
        }
#undef DN_LOAD_B
    }
    __syncthreads();
}
__device__ __forceinline__ int perm32k_inv(int s) { return (s < 16) ? (8 * (s >> 2) + (s & 3)) : (8 * ((s - 16) >> 2) + 4 + (s & 3)); }
__device__ __forceinline__ bf16x8 pack_p(const f32x4 a, const f32x4 b) { u32x4 w; w.x = pk2(a[0], a[1]); w.y = pk2(a[2], a[3]); w.z = pk2(b[0], b[1]); w.w = pk2(b[2], b[3]); return __builtin_bit_cast(bf16x8, w); }

__device__ __forceinline__ void xattn_mfma(const Ctx& C, const bf16* QX, const bf16* KX, const bf16* VXT, bf16* OX) {
    const int lane = C.lane, fr = lane & 15, fq = lane >> 4;
    for (int it = C.gw; it < (NT / 16) * 4; it += C.ngw) {
        const int hd = it & 3, qt = it >> 2, row0 = qt * 16, b = row0 >> 13;
        bf16x8 qf[8];
        const bf16* qp = QX + (size_t)(row0 + fr) * 1024 + hd * 256 + 8 * fq;
#pragma unroll
        for (int ks = 0; ks < 8; ++ks) qf[ks] = *(const bf16x8*)(qp + 32 * ks);
        f32x4 st[16];
        const bf16* kp = KX + (size_t)(b * NMEM + fr) * 1024 + hd * 256 + 8 * fq;
#pragma unroll
        for (int kt = 0; kt < 16; ++kt) { f32x4 acc = {0.f, 0.f, 0.f, 0.f};
#pragma unroll
            for (int ks = 0; ks < 8; ++ks) acc = MFMA16(*(const bf16x8*)(kp + (size_t)kt * 16 * 1024 + 32 * ks), qf[ks], acc);
            st[kt] = acc; }
        float mx = -INFINITY;
#pragma unroll
        for (int kt = 0; kt < 16; ++kt) mx = fmaxf(mx, fmaxf(fmaxf(st[kt][0], st[kt][1]), fmaxf(st[kt][2], st[kt][3])));
        mx = fmaxf(mx, __shfl_xor(mx, 16)); mx = fmaxf(mx, __shfl_xor(mx, 32));
        float sum = 0.f; const float mxs = mx * 0.0625f;
#pragma unroll
        for (int kt = 0; kt < 16; ++kt) {
#pragma unroll
            for (int r = 0; r < 4; ++r) { const float p = __expf(st[kt][r] * 0.0625f - mxs); st[kt][r] = p; sum += p; } }
        sum += __shfl_xor(sum, 16); sum += __shfl_xor(sum, 32);
        const float inv = 1.0f / sum;
        bf16x8 pf[8];
#pragma unroll
        for (int kk = 0; kk < 8; ++kk) pf[kk] = pack_p(st[2 * kk], st[2 * kk + 1]);
        const bf16* vp = VXT + (size_t)(hd * 256 + fr) * 512 + b * NMEM + 8 * fq;
        bf16* op = OX + (size_t)(row0 + fr) * 1024 + hd * 256 + 4 * fq;
#pragma unroll 4
        for (int dt = 0; dt < 16; ++dt) { f32x4 acc = {0.f, 0.f, 0.f, 0.f};
#pragma unroll
            for (int kk = 0; kk < 8; ++kk) acc = MFMA16(*(const bf16x8*)(vp + (size_t)dt * 16 * 512 + 32 * kk), pf[kk], acc);
            u32x2 w; w.x = pk2(acc[0] * inv, acc[1] * inv); w.y = pk2(acc[2] * inv, acc[3] * inv);
            *(u32x2*)(op + 16 * dt) = w; }
    }
}

__device__ __forceinline__ void moba_item(const bf16* PQ, const bf16* VT, const float* KMEAN, bf16* MIX, int bh, int tile, int lane) {
    const int fr = lane & 15, fq = lane >> 4, h = bh & 7, b = bh >> 3, qb = tile >> 3;
    const int row0 = b * SEQ + tile * 32;
    unsigned mask = 0u;
    if (qb > 0) {
        float q[64];
        { const u32x4* qp = (const u32x4*)(PQ + (size_t)(row0 + (lane & 31)) * 1536 + h * 64);
#pragma unroll
          for (int i = 0; i < 8; ++i) unpack8(qp[i], q + 8 * i); }
        float b0 = -INFINITY, b1 = -INFINITY, b2 = -INFINITY; int i0 = -1, i1 = -1, i2 = -1;
        const float* km = KMEAN + (size_t)bh * 32 * 64;
        for (int j = 0; j < qb; ++j) { float s = 0.f;
#pragma unroll
            for (int d = 0; d < 64; ++d) s += q[d] * km[j * 64 + d];
            if (s > b0) { b2 = b1; i2 = i1; b1 = b0; i1 = i0; b0 = s; i0 = j; } else if (s > b1) { b2 = b1; i2 = i1; b1 = s; i1 = j; } else if (s > b2) { b2 = s; i2 = j; } }
        if (i0 >= 0) mask |= 1u << i0; if (i1 >= 0) mask |= 1u << i1; if (i2 >= 0) mask |= 1u << i2;
    }
    const unsigned m0 = (unsigned)__shfl((int)mask, fr), m1 = (unsigned)__shfl((int)mask, 16 + fr);
    bf16x8 qf[2][2];
#pragma unroll
    for (int qt = 0; qt < 2; ++qt)
#pragma unroll
        for (int ks = 0; ks < 2; ++ks) qf[qt][ks] = *(const bf16x8*)(PQ + (size_t)(row0 + 16 * qt + fr) * 1536 + h * 64 + 32 * ks + 8 * fq);
    f32x4 oacc[2][4];
#pragma unroll
    for (int qt = 0; qt < 2; ++qt)
#pragma unroll
        for (int dt = 0; dt < 4; ++dt) oacc[qt][dt] = (f32x4){0.f, 0.f, 0.f, 0.f};
    float mrow[2] = {-INFINITY, -INFINITY}, lrow[2] = {0.f, 0.f};
    const int qoff0 = (tile & 7) * 32;
    for (int bi = 0; bi <= qb; ++bi) {
        const int blk = (bi == 0) ? qb : bi - 1; const bool own = (bi == 0);
        if (!own && !__any((int)(((m0 | m1) >> blk) & 1u))) continue;
        const bool s0 = own || ((m0 >> blk) & 1u), s1 = own || ((m1 >> blk) & 1u);
        for (int hf = 0; hf < 2; ++hf) {
            if (own && hf * 128 > qoff0 + 31) continue;
            const int key0 = b * SEQ + blk * 256 + hf * 128;
            f32x4 st[2][8];
            const bf16* kp = PQ + (size_t)(key0 + fr) * 1536 + 512 + h * 64 + 8 * fq;
#pragma unroll
            for (int kt = 0; kt < 8; ++kt) { const bf16x8 k0 = *(const bf16x8*)(kp + (size_t)kt * 16 * 1536), k1 = *(const bf16x8*)(kp + (size_t)kt * 16 * 1536 + 32);
#pragma unroll
                for (int qt = 0; qt < 2; ++qt) { f32x4 acc = {0.f, 0.f, 0.f, 0.f}; acc = MFMA16(k0, qf[qt][0], acc); acc = MFMA16(k1, qf[qt][1], acc); st[qt][kt] = acc; } }
            bf16x8 pf[2][4];
#pragma unroll
            for (int qt = 0; qt < 2; ++qt) {
                const bool sel = qt == 0 ? s0 : s1; const int qoff = qoff0 + 16 * qt + fr;
                float mx = -INFINITY;
#pragma unroll
                for (int kt = 0; kt < 8; ++kt)
#pragma unroll
                    for (int r = 0; r < 4; ++r) { float s = st[qt][kt][r] * 0.125f; const int kin = hf * 128 + 16 * kt + 4 * fq + r;
                        if (!sel || (own && kin > qoff)) s = -INFINITY; st[qt][kt][r] = s; mx = fmaxf(mx, s); }
                mx = fmaxf(mx, __shfl_xor(mx, 16)); mx = fmaxf(mx, __shfl_xor(mx, 32));
                const float mn = fmaxf(mrow[qt], mx);
                const float corr = __expf(mrow[qt] - mn); mrow[qt] = mn;
                float ps = 0.f;
#pragma unroll
                for (int kt = 0; kt < 8; ++kt)
#pragma unroll
                    for (int r = 0; r < 4; ++r) { const float p = __expf(st[qt][kt][r] - mn); st[qt][kt][r] = p; ps += p; }
                lrow[qt] = lrow[qt] * corr + ps;
#pragma unroll
                for (int dt = 0; dt < 4; ++dt) oacc[qt][dt] = oacc[qt][dt] * corr;
#pragma unroll
                for (int kk = 0; kk < 4; ++kk) pf[qt][kk] = pack_p(st[qt][2 * kk], st[qt][2 * kk + 1]);
            }
            const bf16* vp = VT + (size_t)(h * 64 + fr) * NT + key0 + 8 * fq;
#pragma unroll
            for (int dt = 0; dt < 4; ++dt)
#pragma unroll
                for (int kk = 0; kk < 4; ++kk) { const bf16x8 vf = *(const bf16x8*)(vp + (size_t)dt * 16 * NT + 32 * kk);
                    oacc[0][dt] = MFMA16(vf, pf[0][kk], oacc[0][dt]); oacc[1][dt] = MFMA16(vf, pf[1][kk], oacc[1][dt]); }
        }
    }
#pragma unroll
    for (int qt = 0; qt < 2; ++qt) {
        float l = lrow[qt]; l += __shfl_xor(l, 16); l += __shfl_xor(l, 32); const float inv = 1.0f / l;
        bf16* op = MIX + (size_t)(row0 + 16 * qt + fr) * 1024 + h * 64 + 4 * fq;
#pragma unroll
        for (int dt = 0; dt < 4; ++dt) { u32x2 w; w.x = pk2(oacc[qt][dt][0] * inv, oacc[qt][dt][1] * inv); w.y = pk2(oacc[qt][dt][2] * inv, oacc[qt][dt][3] * inv); *(u32x2*)(op + 16 * dt) = w; }
    }
}
__device__ __forceinline__ void moba_mfma(const Ctx& C, const bf16* PQ, const bf16* VT, const float* KMEAN, bf16* MIX) {
    for (int pi = C.gw; pi < 2048; pi += C.ngw) {
        const int bh = pi >> 7, pp = pi & 127;
        moba_item(PQ, VT, KMEAN, MIX, bh, pp, C.lane);
        moba_item(PQ, VT, KMEAN, MIX, bh, 255 - pp, C.lane);
    }
}
__device__ __forceinline__ void pool_mfma(const Ctx& C, const bf16* PQ, const bf16* PWT, const float* pool_scale, bf16* MIX) {
    const int lane = C.lane, fr = lane & 15, fq = lane >> 4;
    for (int it = C.gw; it < (NT / 16) * 4; it += C.ngw) {
        const int g = it & 3, tt = it >> 2, row = tt * 16 + fr, tl = row & (SEQ - 1), w = 2 << g;
        const int cnt = (tl + 1 < w) ? tl + 1 : w; const float icnt = 1.0f / (float)cnt;
        bf16x8 bfr[4];
#pragma unroll
        for (int ks = 0; ks < 4; ++ks) {
            const bf16* p = PQ + (size_t)row * 1536 + 1024 + g * 128 + 32 * ks + 8 * fq;
            float cur[8], s[8]; unpack8(*(const u32x4*)p, cur);
#pragma unroll
            for (int e = 0; e < 8; ++e) s[e] = cur[e];
            for (int i = 1; i < cnt; ++i) { float f[8]; unpack8(*(const u32x4*)(p - (size_t)i * 1536), f);
#pragma unroll
                for (int e = 0; e < 8; ++e) s[e] += f[e]; }
            u32x4 wv; wv.x = pk2(s[0] * icnt - cur[0], s[1] * icnt - cur[1]); wv.y = pk2(s[2] * icnt - cur[2], s[3] * icnt - cur[3]);
            wv.z = pk2(s[4] * icnt - cur[4], s[5] * icnt - cur[5]); wv.w = pk2(s[6] * icnt - cur[6], s[7] * icnt - cur[7]);
            bfr[ks] = __builtin_bit_cast(bf16x8, wv);
        }
        const bf16* ap = PWT + (size_t)g * 128 * 128 + (size_t)lane * 8;
        bf16* op = MIX + (size_t)row * 1024 + 512 + g * 128 + 4 * fq; const float* sp = pool_scale + g * 128 + 4 * fq;
#pragma unroll 2
        for (int dt = 0; dt < 8; ++dt) { f32x4 acc = {0.f, 0.f, 0.f, 0.f};
#pragma unroll
            for (int ks = 0; ks < 4; ++ks) acc = MFMA16(*(const bf16x8*)(ap + (size_t)(dt * 4 + ks) * 512), bfr[ks], acc);
            const f32x4 sc = *(const f32x4*)(sp + 16 * dt);
            u32x2 wv; wv.x = pk2(acc[0] * sc.x, acc[1] * sc.y); wv.y = pk2(acc[2] * sc.z, acc[3] * sc.w); *(u32x2*)(op + 16 * dt) = wv; }
    }
}
__device__ __forceinline__ void sgu_mfma(const Ctx& C, const bf16* Z, const bf16* VNT, const bf16* Wb, const float* sgu_b, bf16* MIX, int gw0, int ngw0) {
    const int lane = C.lane, fr = lane & 15, fq = lane >> 4;
    for (int it = gw0; it < 128 * 4 * 8; it += ngw0) {
        const int tt = it & 7, g = (it >> 3) & 3, n = it >> 5, nks = (tt >> 1) + 1;
        const int row = n * 128 + tt * 16 + fr;
        bf16x8 bfr[4];
#pragma unroll
        for (int ks = 0; ks < 4; ++ks) bfr[ks] = (ks < nks) ? *(const bf16x8*)(Wb + (size_t)(g * 128 + tt * 16 + fr) * 128 + 32 * ks + 8 * fq) : (bf16x8){0, 0, 0, 0, 0, 0, 0, 0};
        const float bias = sgu_b[g * 128 + tt * 16 + fr];
        const bf16* ap = VNT + ((size_t)n * 512 + g * 128 + fr) * 128 + 8 * fq;
        const bf16* up = Z + (size_t)row * 1024 + g * 128 + 4 * fq; bf16* op = MIX + (size_t)row * 1024 + g * 128 + 4 * fq;
#pragma unroll 2
        for (int ct = 0; ct < 8; ++ct) { f32x4 acc = {0.f, 0.f, 0.f, 0.f};
#pragma unroll
            for (int ks = 0; ks < 4; ++ks) if (ks < nks) acc = MFMA16(*(const bf16x8*)(ap + (size_t)ct * 16 * 128 + 32 * ks), bfr[ks], acc);
            const u32x2 uw = *(const u32x2*)(up + 16 * ct);
            u32x2 wv; wv.x = pk2(lo16(uw.x) * (acc[0] + bias), hi16(uw.x) * (acc[1] + bias)); wv.y = pk2(lo16(uw.y) * (acc[2] + bias), hi16(uw.y) * (acc[3] + bias)); *(u32x2*)(op + 16 * ct) = wv; }
    }
}
__device__ __forceinline__ void sgu_w_convert(const Ctx& C, const float* sw, bf16* Wb) {
    for (int idx = C.gtid; idx < 4 * 128 * 128; idx += C.nthr) { const int s = idx & 127, t = (idx >> 7) & 127; Wb[idx] = (bf16)((s <= t) ? f2bf(sw[idx]) : 0u); }
}
constexpr int MK_LD = 72, MV_LD = 136;
constexpr int MK_BYTES = 128 * MK_LD * 2, MV_BYTES = 64 * MV_LD * 2;
__device__ __forceinline__ void moba_wg_block(const Ctx& C, const bf16* PQ, const bf16* VT, const float* KMEAN, bf16* MIX, int bh, int qb) {
    const int lane = C.lane, fr = lane & 15, fq = lane >> 4, h = bh & 7, b = bh >> 3, w = C.wave, tid = C.tid;
    const int tile = qb * 8 + w, row0 = b * SEQ + tile * 32;
    LAS bf16* Kb0 = (LAS bf16*)C.lds; LAS bf16* Vb0 = (LAS bf16*)(C.lds + 2 * MK_BYTES);
    unsigned mask = 0u;
    if (qb > 0) {
        float q[64];
        { const u32x4* qp = (const u32x4*)(PQ + (size_t)(row0 + (lane & 31)) * 1536 + h * 64);
#pragma unroll
          for (int i = 0; i < 8; ++i) unpack8(qp[i], q + 8 * i); }
        float b0 = -INFINITY, b1 = -INFINITY, b2 = -INFINITY; int i0 = -1, i1 = -1, i2 = -1;
        const float* km = KMEAN + (size_t)bh * 32 * 64;
        for (int j = 0; j < qb; ++j) { float s = 0.f;
#pragma unroll
            for (int d = 0; d < 64; ++d) s += q[d] * km[j * 64 + d];
            if (s > b0) { b2 = b1; i2 = i1; b1 = b0; i1 = i0; b0 = s; i0 = j; } else if (s > b1) { b2 = b1; i2 = i1; b1 = s; i1 = j; } else if (s > b2) { b2 = s; i2 = j; } }
        if (i0 >= 0) mask |= 1u << i0; if (i1 >= 0) mask |= 1u << i1; if (i2 >= 0) mask |= 1u << i2;
    }
    const unsigned m0 = (unsigned)__shfl((int)mask, fr), m1 = (unsigned)__shfl((int)mask, 16 + fr);
    bf16x8 qf[2][2];
#pragma unroll
    for (int qt = 0; qt < 2; ++qt)
#pragma unroll
        for (int ks = 0; ks < 2; ++ks) qf[qt][ks] = *(const bf16x8*)(PQ + (size_t)(row0 + 16 * qt + fr) * 1536 + h * 64 + 32 * ks + 8 * fq);
    f32x4 oacc[2][4];
#pragma unroll
    for (int qt = 0; qt < 2; ++qt)
#pragma unroll
        for (int dt = 0; dt < 4; ++dt) oacc[qt][dt] = (f32x4){0.f, 0.f, 0.f, 0.f};
    float mrow[2] = {-INFINITY, -INFINITY}, lrow[2] = {0.f, 0.f};
    const int qoff0 = w * 32;
    const int kr = tid >> 3, kc = tid & 7, vr = tid >> 4, vc = tid & 15;
    const int nh = 2 * (qb + 1);
    u32x4 kq0, kq1, vq0, vq1;
#define MOBA_KEY0(i) (b * SEQ + (((i) < 2) ? qb : (((i) - 2) >> 1)) * 256 + ((i) & 1) * 128)
#define MOBA_GLOAD(i) do { const int k0_ = MOBA_KEY0(i); \
        kq0 = *(const u32x4*)(PQ + (size_t)(k0_ + kr) * 1536 + 512 + h * 64 + 8 * kc); kq1 = *(const u32x4*)(PQ + (size_t)(k0_ + kr + 64) * 1536 + 512 + h * 64 + 8 * kc); \
        vq0 = *(const u32x4*)(VT + (size_t)(h * 64 + vr) * NT + k0_ + 8 * vc); vq1 = *(const u32x4*)(VT + (size_t)(h * 64 + vr + 32) * NT + k0_ + 8 * vc); } while (0)
#define MOBA_LSTORE(buf) do { LAS bf16* kb_ = Kb0 + (buf) * (MK_BYTES / 2); LAS bf16* vb_ = Vb0 + (buf) * (MV_BYTES / 2); \
        *(LAS u32x4*)(kb_ + kr * MK_LD + 8 * kc) = kq0; *(LAS u32x4*)(kb_ + (kr + 64) * MK_LD + 8 * kc) = kq1; \
        *(LAS u32x4*)(vb_ + vr * MV_LD + 8 * vc) = vq0; *(LAS u32x4*)(vb_ + (vr + 32) * MV_LD + 8 * vc) = vq1; } while (0)
    MOBA_GLOAD(0); MOBA_LSTORE(0);
    WG_BAR();
    for (int i = 0; i < nh; ++i) {
        if (i + 1 < nh) MOBA_GLOAD(i + 1);
        const bool own = i < 2; const int blk = own ? qb : ((i - 2) >> 1), hf = i & 1;
        const bool s0 = own || ((m0 >> blk) & 1u), s1 = own || ((m1 >> blk) & 1u);
        const bool need = own ? !(hf * 128 > qoff0 + 31) : (__any((int)(((m0 | m1) >> blk) & 1u)) != 0);
        if (need) {
            const LAS bf16* Kb = Kb0 + (i & 1) * (MK_BYTES / 2); const LAS bf16* Vb = Vb0 + (i & 1) * (MV_BYTES / 2);
            f32x4 st[2][8];
            __builtin_amdgcn_s_setprio(1);
#pragma unroll
            for (int kt = 0; kt < 8; ++kt) { const bf16x8 k0 = *(const LAS bf16x8*)(Kb + (16 * kt + fr) * MK_LD + 8 * fq), k1 = *(const LAS bf16x8*)(Kb + (16 * kt + fr) * MK_LD + 32 + 8 * fq);
#pragma unroll
                for (int qt = 0; qt < 2; ++qt) { f32x4 acc = {0.f, 0.f, 0.f, 0.f}; acc = MFMA16(k0, qf[qt][0], acc); acc = MFMA16(k1, qf[qt][1], acc); st[qt][kt] = acc; } }
            __builtin_amdgcn_s_setprio(0);
            bf16x8 pf[2][4];
            constexpr float SC2 = 0.125f * 1.4426950408889634f;
#pragma unroll
            for (int qt = 0; qt < 2; ++qt) {
                const bool sel = qt == 0 ? s0 : s1; const int qoff = qoff0 + 16 * qt + fr;
                float mx = -INFINITY;
                if (own) {
#pragma unroll
                    for (int kt = 0; kt < 8; ++kt)
#pragma unroll
                        for (int r = 0; r < 4; ++r) { const int kin = hf * 128 + 16 * kt + 4 * fq + r; if (kin > qoff) st[qt][kt][r] = -INFINITY; }
                }
#pragma unroll
                for (int kt = 0; kt < 8; ++kt) mx = fmaxf(mx, fmaxf(fmaxf(st[qt][kt][0], st[qt][kt][1]), fmaxf(st[qt][kt][2], st[qt][kt][3])));
                mx *= SC2;
                if (!sel) mx = -INFINITY;
                mx = fmaxf(mx, __shfl_xor(mx, 16)); mx = fmaxf(mx, __shfl_xor(mx, 32));
                const float mn = fmaxf(mrow[qt], mx);
                const float corr = __builtin_amdgcn_exp2f(mrow[qt] - mn); mrow[qt] = mn;
                float ps = 0.f;
#pragma unroll
                for (int kt = 0; kt < 8; ++kt)
#pragma unroll
                    for (int r = 0; r < 4; ++r) { const float p = __builtin_amdgcn_exp2f(__builtin_fmaf(st[qt][kt][r], SC2, -mn)); st[qt][kt][r] = p; ps += p; }
                if (!sel) ps = 0.f;
                lrow[qt] = lrow[qt] * corr + ps;
#pragma unroll
                for (int dt = 0; dt < 4; ++dt) oacc[qt][dt] = oacc[qt][dt] * corr;
#pragma unroll
                for (int kk = 0; kk < 4; ++kk) { bf16x8 pv = pack_p(st[qt][2 * kk], st[qt][2 * kk + 1]); if (!sel) pv = (bf16x8){0, 0, 0, 0, 0, 0, 0, 0}; pf[qt][kk] = pv; }
            }
            __builtin_amdgcn_s_setprio(1);
#pragma unroll
            for (int dt = 0; dt < 4; ++dt)
#pragma unroll
                for (int kk = 0; kk < 4; ++kk) { const bf16x8 vf = *(const LAS bf16x8*)(Vb + (16 * dt + fr) * MV_LD + 32 * kk + 8 * fq);
                    oacc[0][dt] = MFMA16(vf, pf[0][kk], oacc[0][dt]); oacc[1][dt] = MFMA16(vf, pf[1][kk], oacc[1][dt]); }
            __builtin_amdgcn_s_setprio(0);
        }
        if (i + 1 < nh) MOBA_LSTORE((i + 1) & 1);
        WG_BAR();
    }
#undef MOBA_KEY0
#undef MOBA_GLOAD
#undef MOBA_LSTORE
#pragma unroll
    for (int qt = 0; qt < 2; ++qt) {
        float l = lrow[qt]; l += __shfl_xor(l, 16); l += __shfl_xor(l, 32); const float inv = 1.0f / l;
        bf16* op = MIX + (size_t)(row0 + 16 * qt + fr) * 1024 + h * 64 + 4 * fq;
#pragma unroll
        for (int dt = 0; dt < 4; ++dt) { u32x2 wv; wv.x = pk2(oacc[qt][dt][0] * inv, oacc[qt][dt][1] * inv); wv.y = pk2(oacc[qt][dt][2] * inv, oacc[qt][dt][3] * inv); *(u32x2*)(op + 16 * dt) = wv; }
    }
}
__device__ __forceinline__ void moba_wg(const Ctx& C, const bf16* PQ, const bf16* VT, const float* KMEAN, bf16* MIX) {
    for (int it = blockIdx.x; it < 256; it += C.G) {
        const int bh = it & 15, pp = it >> 4;
        moba_wg_block(C, PQ, VT, KMEAN, MIX, bh, 31 - pp);
        moba_wg_block(C, PQ, VT, KMEAN, MIX, bh, pp);
    }
}
constexpr int XK_LD = 264, XV_LD = 136;
constexpr int XK_BYTES = 128 * XK_LD * 2, XV_BYTES = 256 * XV_LD * 2;
static_assert(XK_BYTES + XV_BYTES <= LDS_BYTES - 256, "xattn LDS");
__device__ __forceinline__ void xattn_wg(const Ctx& C, const bf16* QX, const bf16* KX, const bf16* VXT, bf16* OX) {
    const int lane = C.lane, fr = lane & 15, fq = lane >> 4, w = C.wave, tid = C.tid;
    LAS bf16* Kb = (LAS bf16*)C.lds; LAS bf16* Vb = (LAS bf16*)(C.lds + XK_BYTES);
    constexpr float SC2 = 0.0625f * 1.4426950408889634f;
    for (int it = blockIdx.x; it < 512; it += C.G) {
        const int hd = it & 3, bq = it >> 2, row0 = bq * 128 + w * 16, b = bq >> 6;
        bf16x8 qf[8];
        { const bf16* qp = QX + (size_t)(row0 + fr) * 1024 + hd * 256 + 8 * fq;
#pragma unroll
          for (int ks = 0; ks < 8; ++ks) qf[ks] = *(const bf16x8*)(qp + 32 * ks); }
        f32x4 oacc[16];
#pragma unroll
        for (int dt = 0; dt < 16; ++dt) oacc[dt] = (f32x4){0.f, 0.f, 0.f, 0.f};
        float mrow = -INFINITY, lrow = 0.f;
        for (int hf = 0; hf < 2; ++hf) {
            WG_BAR();
#pragma unroll
            for (int i = 0; i < 8; ++i) { const int id = tid + 512 * i;
                { const int r = id >> 5, c = id & 31; *(LAS u32x4*)(Kb + r * XK_LD + 8 * c) = *(const u32x4*)(KX + (size_t)(b * NMEM + 128 * hf + r) * 1024 + hd * 256 + 8 * c); }
                { const int r = id >> 4, c = id & 15; *(LAS u32x4*)(Vb + r * XV_LD + 8 * c) = *(const u32x4*)(VXT + (size_t)(hd * 256 + r) * 512 + b * NMEM + 128 * hf + 8 * c); } }
            WG_BAR();
            f32x4 st[8];
            __builtin_amdgcn_s_setprio(1);
#pragma unroll
            for (int kt = 0; kt < 8; ++kt) { f32x4 acc = {0.f, 0.f, 0.f, 0.f};
#pragma unroll
                for (int ks = 0; ks < 8; ++ks) acc = MFMA16(*(const LAS bf16x8*)(Kb + (16 * kt + fr) * XK_LD + 32 * ks + 8 * fq), qf[ks], acc);
                st[kt] = acc; }
            __builtin_amdgcn_s_setprio(0);
            float mx = -INFINITY;
#pragma unroll
            for (int kt = 0; kt < 8; ++kt)
#pragma unroll
                for (int r = 0; r < 4; ++r) { const float sv = st[kt][r] * SC2; st[kt][r] = sv; mx = fmaxf(mx, sv); }
            mx = fmaxf(mx, __shfl_xor(mx, 16)); mx = fmaxf(mx, __shfl_xor(mx, 32));
            const float mn = fmaxf(mrow, mx), corr = __builtin_amdgcn_exp2f(mrow - mn); mrow = mn;
            float ps = 0.f;
#pragma unroll
            for (int kt = 0; kt < 8; ++kt)
#pragma unroll
                for (int r = 0; r < 4; ++r) { const float p = __builtin_amdgcn_exp2f(st[kt][r] - mn); st[kt][r] = p; ps += p; }
            lrow = lrow * corr + ps;
            bf16x8 pf[4];
#pragma unroll
            for (int kk = 0; kk < 4; ++kk) pf[kk] = pack_p(st[2 * kk], st[2 * kk + 1]);
            __builtin_amdgcn_s_setprio(1);
#pragma unroll
            for (int dt = 0; dt < 16; ++dt) { f32x4 acc = oacc[dt] * corr;
#pragma unroll
                for (int kk = 0; kk < 4; ++kk) acc = MFMA16(*(const LAS bf16x8*)(Vb + (16 * dt + fr) * XV_LD + 32 * kk + 8 * fq), pf[kk], acc);
                oacc[dt] = acc; }
            __builtin_amdgcn_s_setprio(0);
        }
        lrow += __shfl_xor(lrow, 16); lrow += __shfl_xor(lrow, 32);
        const float inv = 1.0f / lrow;
        bf16* op = OX + (size_t)(row0 + fr) * 1024 + hd * 256 + 4 * fq;
#pragma unroll
        for (int dt = 0; dt < 16; ++dt) { u32x2 wv; wv.x = pk2(oacc[dt][0] * inv, oacc[dt][1] * inv); wv.y = pk2(oacc[dt][2] * inv, oacc[dt][3] * inv); *(u32x2*)(op + 16 * dt) = wv; }
    }
    WG_BAR();
}
__device__ __forceinline__ void l1_prep(const Ctx& C, ArgsP a, const bf16* Z, const bf16* QKV, bf16* VNT, bf16* QN, bf16* KN, bf16* VV) {
    const int lane = C.lane;
    const float* lng = INP(a, I_SGUG); const float* lnb = INP(a, I_SGUB); const float* cw = INP(a, I_DNCONV);
    for (int blk = C.gw; blk < NT / 8; blk += C.ngw) {
        const int row0 = blk * 8;
        {
            const f32x4 g0 = *((const f32x4*)lng + 2 * lane), g1 = *((const f32x4*)lng + 2 * lane + 1), c0 = *((const f32x4*)lnb + 2 * lane), c1 = *((const f32x4*)lnb + 2 * lane + 1);
            unsigned vt[8][4];
#pragma unroll
            for (int e = 0; e < 8; ++e)
#pragma unroll
                for (int q = 0; q < 4; ++q) vt[e][q] = 0u;
#pragma unroll
            for (int r = 0; r < 8; ++r) {
                float f[8]; unpack8(*((const u32x4*)(Z + (size_t)(row0 + r) * 1024 + 512) + lane), f);
                float s = 0.f;
#pragma unroll
                for (int e = 0; e < 8; ++e) s += f[e];
                const float mu = wave_sum(s) * (1.0f / 512.0f); float q = 0.f;
#pragma unroll
                for (int e = 0; e < 8; ++e) { f[e] -= mu; q += f[e] * f[e]; }
                const float rstd = 1.0f / sqrtf(wave_sum(q) * (1.0f / 512.0f) + EPS);
                const float y[8] = {f[0] * rstd * g0.x + c0.x, f[1] * rstd * g0.y + c0.y, f[2] * rstd * g0.z + c0.z, f[3] * rstd * g0.w + c0.w,
                                    f[4] * rstd * g1.x + c1.x, f[5] * rstd * g1.y + c1.y, f[6] * rstd * g1.z + c1.z, f[7] * rstd * g1.w + c1.w};
#pragma unroll
                for (int e = 0; e < 8; ++e) vt[e][r >> 1] |= f2bf(y[e]) << (16 * (r & 1));
            }
            bf16* vp = VNT + ((size_t)(row0 >> 7) * 512 + 8 * lane) * 128 + (row0 & 127);
#pragma unroll
            for (int e = 0; e < 8; ++e) { u32x4 w; w.x = vt[e][0]; w.y = vt[e][1]; w.z = vt[e][2]; w.w = vt[e][3]; *(u32x4*)(vp + (size_t)e * 128) = w; }
        }
        const bool hist = (row0 & (SEQ - 1)) != 0;
#pragma unroll 1
        for (int s3 = 0; s3 < 3; ++s3) {
            const int cs = s3 * 512 + 8 * lane;
            float w[4][8];
#pragma unroll
            for (int j = 0; j < 4; ++j) { const f32x4 a0 = *(const f32x4*)(cw + j * 1536 + cs), a1 = *(const f32x4*)(cw + j * 1536 + cs + 4);
                w[j][0] = a0.x; w[j][1] = a0.y; w[j][2] = a0.z; w[j][3] = a0.w; w[j][4] = a1.x; w[j][5] = a1.y; w[j][6] = a1.z; w[j][7] = a1.w; }
            float x0[8], x1[8], x2[8];
            if (hist) { unpack8(*(const u32x4*)(QKV + (size_t)(row0 - 3) * 1536 + cs), x0); unpack8(*(const u32x4*)(QKV + (size_t)(row0 - 2) * 1536 + cs), x1); unpack8(*(const u32x4*)(QKV + (size_t)(row0 - 1) * 1536 + cs), x2); }
            else {
#pragma unroll
                for (int e = 0; e < 8; ++e) { x0[e] = 0.f; x1[e] = 0.f; x2[e] = 0.f; } }
            bf16* dst = (s3 == 0 ? QN : s3 == 1 ? KN : VV) + (size_t)row0 * 512 + 8 * lane;
#pragma unroll
            for (int r = 0; r < 8; ++r) {
                float x3[8]; unpack8(*(const u32x4*)(QKV + (size_t)(row0 + r) * 1536 + cs), x3);
                float y[8], ss = 0.f;
#pragma unroll
                for (int e = 0; e < 8; ++e) { y[e] = silu_f(w[0][e] * x0[e] + w[1][e] * x1[e] + w[2][e] * x2[e] + w[3][e] * x3[e]); ss += y[e] * y[e]; }
                float sc = 1.0f;
                if (s3 < 2) { ss += __shfl_xor(ss, 1); ss += __shfl_xor(ss, 2); ss += __shfl_xor(ss, 4); ss += __shfl_xor(ss, 8);
                    sc = 1.0f / sqrtf(ss + EPS); if (s3 == 0) sc *= 0.08838834764831845f; }
                u32x4 o; o.x = pk2(y[0] * sc, y[1] * sc); o.y = pk2(y[2] * sc, y[3] * sc); o.z = pk2(y[4] * sc, y[5] * sc); o.w = pk2(y[6] * sc, y[7] * sc);
                *(u32x4*)(dst + (size_t)r * 512) = o;
#pragma unroll
                for (int e = 0; e < 8; ++e) { x0[e] = x1[e]; x1[e] = x2[e]; x2[e] = x3[e]; }
            }
        }
    }
}

#ifndef MK_MULTI
#define MK_MULTI 0
#endif
enum { OP_PRO0 = 0, OP_KMEAN, OP_MOBA, OP_RMSX, OP_XATTN, OP_RMSF, OP_ACT, OP_PRO1, OP_L1PREP, OP_DNPREP, OP_DNSCAN, OP_DNGATE, OP_FINAL, OP_GSTORE, OP_GRESID, OP_GCONV };
struct PD { int op, sync, L, hb, M, N, K; unsigned long long a, b, p0, p1, p2; int ld0, ld1, ld2, t1, t2, gelu0, basex, rot; long long ss; };
#define PH_TABLE \
  {OP_PRO0, 1, 0, 0, 0, 0, 0, 0ull, 0ull, 0ull, 0ull, 0ull, 0, 0, 0, 0, 0, 0, 0, 0, -1ll}, \
  {OP_GSTORE, 0, 0, 0, 16384, 1536, 1024, 38797312ull, 4194304ull, 141557760ull, 0ull, 0ull, 1536, 0, 0, 1000, 1000, 0, 0, 0, -1ll}, \
  {OP_GSTORE, 1, 0, 0, 512, 16384, 1024, 7340032ull, 208666624ull, 191889408ull, 0ull, 0ull, 16384, 0, 0, 1000, 1000, 0, 0, 128, -1ll}, \
  {OP_KMEAN, 0, 0, 0, 0, 0, 0, 0ull, 0ull, 0ull, 0ull, 0ull, 0, 0, 0, 0, 0, 0, 0, 0, -1ll}, \
  {OP_GSTORE, 0, 0, 0, 512, 1024, 1024, 0ull, 14680064ull, 72351744ull, 0ull, 0ull, 1024, 0, 0, 1000, 1000, 0, 0, 64, -1ll}, \
  {OP_GSTORE, 1, 0, 0, 1024, 512, 1024, 16777216ull, 2097152ull, 73400320ull, 0ull, 0ull, 512, 0, 0, 1000, 1000, 0, 0, 72, -1ll}, \
  {OP_MOBA, 1, 0, 0, 0, 0, 0, 0ull, 0ull, 0ull, 0ull, 0ull, 0, 0, 0, 0, 0, 0, 0, 0, -1ll}, \
  {OP_GRESID, 1, 0, 0, 16384, 1024, 1024, 74448896ull, 10485760ull, 0ull, 0ull, 0ull, 0, 0, 0, 0, 0, 0, 1, 0, 260046848ll}, \
  {OP_GSTORE, 1, 0, 0, 16384, 1024, 1024, 38797312ull, 12582912ull, 108003328ull, 0ull, 0ull, 1024, 0, 0, 1000, 1000, 0, 0, 0, 260046848ll}, \
  {OP_XATTN, 1, 0, 0, 0, 0, 0, 0ull, 0ull, 0ull, 0ull, 0ull, 0, 0, 0, 0, 0, 0, 0, 0, -1ll}, \
  {OP_GRESID, 1, 0, 0, 16384, 1024, 1024, 74448896ull, 18874368ull, 0ull, 0ull, 0ull, 0, 0, 0, 0, 0, 0, 0, 0, 260046848ll}, \
  {OP_GCONV, 1, 0, 0, 17408, 5632, 1024, 38797312ull, 20971520ull, 74448896ull, 0ull, 0ull, 0, 0, 0, 0, 0, 0, 0, 0, 260046848ll}, \
  {OP_GRESID, 1, 0, 2, 16384, 1024, 2816, 74448896ull, 32505856ull, 0ull, 0ull, 0ull, 0, 0, 0, 0, 0, 0, 0, 0, -1ll}, \
  {OP_PRO1, 1, 0, 0, 0, 0, 0, 0ull, 0ull, 0ull, 0ull, 0ull, 0, 0, 0, 0, 0, 0, 0, 0, -1ll}, \
  {OP_GSTORE, 1, 0, 0, 16384, 3072, 1024, 38797312ull, 4194304ull, 141557760ull, 175112192ull, 225443840ull, 1024, 1536, 512, 4, 10, 1, 0, 0, -1ll}, \
  {OP_L1PREP, 1, 0, 0, 0, 0, 0, 0ull, 0ull, 0ull, 0ull, 0ull, 0, 0, 0, 0, 0, 0, 0, 0, -1ll}, \
  {OP_DNPREP, 0, 0, 0, 0, 0, 0, 0ull, 0ull, 0ull, 0ull, 0ull, 0, 0, 0, 0, 0, 0, 0, 0, -1ll}, \
  {OP_GSTORE, 0, 0, 0, 512, 1024, 1024, 0ull, 14680064ull, 72351744ull, 0ull, 0ull, 1024, 0, 0, 1000, 1000, 0, 0, 128, -1ll}, \
  {OP_GSTORE, 1, 0, 0, 1024, 512, 1024, 16777216ull, 2097152ull, 73400320ull, 0ull, 0ull, 512, 0, 0, 1000, 1000, 0, 0, 136, -1ll}, \
  {OP_DNSCAN, 1, 0, 0, 0, 0, 0, 0ull, 0ull, 0ull, 0ull, 0ull, 0, 0, 0, 0, 0, 0, 0, 0, -1ll}, \
  {OP_DNGATE, 1, 0, 0, 0, 0, 0, 0ull, 0ull, 0ull, 0ull, 0ull, 0, 0, 0, 0, 0, 0, 0, 0, -1ll}, \
  {OP_GRESID, 1, 0, 1, 16384, 1024, 1024, 74448896ull, 10485760ull, 0ull, 0ull, 0ull, 0, 0, 0, 0, 0, 0, 0, 0, 260046848ll}, \
  {OP_GSTORE, 1, 0, 0, 16384, 1024, 1024, 38797312ull, 12582912ull, 108003328ull, 0ull, 0ull, 1024, 0, 0, 1000, 1000, 0, 0, 0, 260046848ll}, \
  {OP_XATTN, 1, 1, 0, 0, 0, 0, 0ull, 0ull, 0ull, 0ull, 0ull, 0, 0, 0, 0, 0, 0, 0, 0, -1ll}, \
  {OP_GRESID, 1, 0, 0, 16384, 1024, 1024, 74448896ull, 18874368ull, 0ull, 0ull, 0ull, 0, 0, 0, 0, 0, 0, 0, 0, 260046848ll}, \
  {OP_GCONV, 1, 1, 0, 17408, 5632, 1024, 38797312ull, 20971520ull, 74448896ull, 0ull, 0ull, 0, 0, 0, 0, 0, 0, 0, 0, 260046848ll}, \
  {OP_GRESID, 1, 0, 0, 16384, 1024, 2816, 74448896ull, 32505856ull, 0ull, 0ull, 0ull, 0, 0, 0, 0, 0, 0, 0, 0, -1ll}, \
  {OP_FINAL, 0, 0, 0, 0, 0, 0, 0ull, 0ull, 0ull, 0ull, 0ull, 0, 0, 0, 0, 0, 0, 0, 0, -1ll},
constexpr int NENT = 28;
__constant__ PD PH_DEV[NENT] = { PH_TABLE };
#define XB_TMO      128
#define XB_XCNT(j)  (256  + 64 * (j))
#define XB_XSUB(j)  (1280 + 64 * (j))
#define XB_XGEN(j)  (2304 + 64 * (j))
#define XB_TOP      3328
#define XB_TOPGEN   3392
#define XCD_BAR_WORDS 3456
#define XB_SPIN_CAP (1u << 18)

__device__ __forceinline__ unsigned xb_ld(unsigned* p)              { return __hip_atomic_load(p, __ATOMIC_RELAXED, __HIP_MEMORY_SCOPE_AGENT); }
__device__ __forceinline__ unsigned xb_add(unsigned* p, unsigned v) { return __hip_atomic_fetch_add(p, v, __ATOMIC_RELAXED, __HIP_MEMORY_SCOPE_AGENT); }
__device__ __forceinline__ unsigned xb_xcc_id() { return (unsigned)__builtin_amdgcn_s_getreg((3 << 11) | 20) & 0xFu; }
#define XB_SPIN(cond, bar) do { unsigned _sp = 0; while (cond) { __builtin_amdgcn_s_sleep(1); \
    if ((++_sp & 255u) == 0u) { if (xb_ld(&(bar)[XB_TMO])) break; if (_sp > XB_SPIN_CAP) { atomicAdd(&(bar)[XB_TMO], 1u); break; } } } } while (0)

struct XcdBarrier {
    unsigned* bar; unsigned x;
    volatile LAS unsigned* st;
};

__device__ __forceinline__ XcdBarrier xcd_barrier_post(unsigned* bar, volatile LAS unsigned* st) {
    XcdBarrier b; b.bar = bar; b.x = xb_xcc_id(); b.st = st;
    if (threadIdx.x == 0) (void)xb_add(&bar[XB_XCNT(b.x)], 1u);
    return b;
}
__device__ __forceinline__ void xcd_barrier_complete(unsigned* bar, unsigned x, unsigned& nloc, unsigned& nx) {
    const unsigned G = gridDim.x * gridDim.y * gridDim.z;
    unsigned sum, cnt, mine, sp = 0u;
    for (;;) {
        sum = 0u; cnt = 0u; mine = 0u;
#pragma unroll
        for (unsigned j = 0; j < 16; ++j) { const unsigned c = xb_ld(&bar[XB_XCNT(j)]); sum += c; cnt += (c > 0u) ? 1u : 0u; mine = (j == x) ? c : mine; }
        if (sum == G) break;
        __builtin_amdgcn_s_sleep(1);
        if ((++sp & 255u) == 0u) { if (xb_ld(&bar[XB_TMO])) break; if (sp > XB_SPIN_CAP) { atomicAdd(&bar[XB_TMO], 1u); break; } }
    }
    nloc = mine > 0u ? mine : 1u; nx = cnt > 0u ? cnt : 1u;
}

__device__ __forceinline__ void xcd_barrier(const XcdBarrier& b) {
    asm volatile("s_waitcnt vmcnt(0)" ::: "memory");
    __syncthreads();
    if (threadIdx.x == 0) {
        unsigned* bar = b.bar;
        __builtin_amdgcn_s_waitcnt(0);
        unsigned nloc = b.st[0], nx = b.st[1];
        if (nloc == 0u) { xcd_barrier_complete(bar, b.x, nloc, nx); b.st[0] = nloc; b.st[1] = nx; }
        const unsigned old = xb_add(&bar[XB_XSUB(b.x)], 1u);
        const unsigned gen = old / nloc;
        if (old + 1u == (gen + 1u) * nloc) {
            __builtin_amdgcn_fence(__ATOMIC_RELEASE, "agent");
            asm volatile("s_waitcnt vmcnt(0)" ::: "memory");
            const unsigned og = xb_add(&bar[XB_TOP], 1u);
            const unsigned tg = og / nx;
            if (og + 1u == (tg + 1u) * nx) xb_add(&bar[XB_TOPGEN], 1u);
            else XB_SPIN(xb_ld(&bar[XB_TOPGEN]) == tg, bar);
            __builtin_amdgcn_fence(__ATOMIC_ACQUIRE, "agent");
            xb_add(&bar[XB_XGEN(b.x)], 1u);
            asm volatile("s_waitcnt vmcnt(0)" ::: "memory");
        } else {
            XB_SPIN(xb_ld(&bar[XB_XGEN(b.x)]) == gen, bar);
            __builtin_amdgcn_fence(__ATOMIC_ACQUIRE, "agent");
            asm volatile("s_waitcnt vmcnt(0)" ::: "memory");
        }
    }
    __syncthreads();
}

constexpr size_t WS_CTL = 3 * MiB, CTL_BYTES = 64 * 1024;
constexpr int MISC_OFF = LDS_BYTES - 128;

static const PD PH_HOST[NENT] = { PH_TABLE };

__global__ void __launch_bounds__(512, 2) mega_fwd(Args a) {
    extern __shared__ __attribute__((aligned(16))) unsigned char lds_raw[];
    cg::grid_group grid = cg::this_grid();
    Ctx C; C.lds = (LAS unsigned char*)lds_raw; C.tid = threadIdx.x; C.lane = C.tid & 63; C.wave = __builtin_amdgcn_readfirstlane(C.tid >> 6);
    C.G = gridDim.x; C.gw = blockIdx.x * 8 + C.wave; C.ngw = C.G * 8; C.gtid = blockIdx.x * 512 + C.tid; C.nthr = C.G * 512;
    unsigned char* ws = a.ws;
    float* H = a.out;
    for (int u = C.tid; u < 128 / 4; u += 512) ((LAS unsigned*)(C.lds + MISC_OFF))[u] = 0u;
    __syncthreads();
    (void)xcd_barrier_post((unsigned*)(ws + WS_CTL), (volatile LAS unsigned*)(C.lds + MISC_OFF) + 8);
    const ArgsP ap0 = (ArgsP)__builtin_amdgcn_kernarg_segment_ptr();
    unsigned char* const ws0 = ws; float* const H0 = H;
    for (int e = a.ph_lo; e < a.ph_hi; ++e) {
        ws = ws0; H = H0; ArgsP ap = ap0; asm volatile("" : "+s"(ap));
        { int t_ = threadIdx.x; asm volatile("" : "+v"(t_)); int g_ = gridDim.x, bx_ = blockIdx.x; asm volatile("" : "+s"(g_), "+s"(bx_));
          C.tid = t_; C.lane = t_ & 63; C.wave = __builtin_amdgcn_readfirstlane(t_ >> 6); C.G = g_; C.gw = bx_ * 8 + C.wave; C.ngw = g_ * 8; C.gtid = bx_ * 512 + t_; C.nthr = g_ * 512; }
        { GAS1 unsigned char* wg = (GAS1 unsigned char*)ws; GAS1 float* hg = (GAS1 float*)H; asm volatile("" : "+s"(wg), "+s"(hg)); ws = (unsigned char*)wg; H = (float*)hg; }
        const int op = PH_DEV[e].op, L = PH_DEV[e].L;
        if (op == OP_GSTORE) {
            const PD& d = PH_DEV[e];
            pg8::Gemm g{(const bf16*)(ws + d.a), (const bf16*)(ws + d.b), d.M, d.N, d.K}; pg8::StaticOrder S; S.init(g.M, g.N, C.G, (int)((blockIdx.x + C.G - d.rot) % C.G));
            pg8::EpiSeg E{(bf16*)(ws + d.p0), (bf16*)(ws + d.p1), (bf16*)(ws + d.p2), d.ld0, d.ld1, d.ld2, d.t1, d.t2, d.gelu0, d.ss >= 0 ? (const float*)(ws + d.ss) : (const float*)nullptr};
            __syncthreads();
            pg8::gemm_phase<pg8::EpiSeg, pg8::StaticOrder, true, true>((PG8_LAS unsigned char*)C.lds, g, S, E, C.tid);
            __syncthreads();
        } else if (op == OP_GCONV) {
            const PD& d = PH_DEV[e];
            pg8::Gemm g{(const bf16*)(ws + d.a), (const bf16*)(ws + d.b), d.M, d.N, d.K, 2, 34, SEQ}; pg8::StaticOrder S; S.init(g.M, g.N, C.G, (int)((blockIdx.x + C.G - d.rot) % C.G));
            pg8::EpiConv E{(bf16*)(ws + d.p0), (const float*)(ws + d.ss), INP(ap, I_FCONV) + (size_t)L * 3 * DFF2, 34, SEQ, DFF};
            __syncthreads();
            pg8::gemm_phase<pg8::EpiConv, pg8::StaticOrder, true, true>((PG8_LAS unsigned char*)C.lds, g, S, E, C.tid);
            __syncthreads();
        } else if (op == OP_GRESID) {
            const PD& d = PH_DEV[e];
            pg8::Gemm g{(const bf16*)(ws + d.a), (const bf16*)(ws + d.b), d.M, d.N, d.K}; pg8::StaticOrder S; S.init(g.M, g.N, C.G, (int)((blockIdx.x + C.G - d.rot) % C.G));
            pg8::EpiResid E{d.basex ? INP(ap, I_X) : (const float*)nullptr, (d.hb & 1) ? (const bf16*)H : (const bf16*)(ws + WS_HB), (d.hb & 2) ? (bf16*)H : (bf16*)(ws + WS_HB), d.ss >= 0 ? (float*)(ws + d.ss) : (float*)nullptr, DM};
            __syncthreads();
            pg8::gemm_phase<pg8::EpiResid, pg8::StaticOrder, true, true>((PG8_LAS unsigned char*)C.lds, g, S, E, C.tid);
            __syncthreads();
        } else if (op == OP_PRO0) {
            convert_weights(C, ap, 0, 0, C.gw, C.ngw);
            rms_all_rows(C, INP(ap, I_X), INP(ap, I_NMIX), (bf16*)(ws + WS_XN), NT, (bf16*)(ws + WS_XNP));
            rms_all_rows(C, INP(ap, I_MEM), INP(ap, I_MEMNORM), (bf16*)(ws + WS_MEMN), 2 * NMEM, (bf16*)(ws + WS_MEMNP));
        } else if (op == OP_KMEAN) {
            kmean_pooled(C, (const bf16*)(ws + WS_PROJ0), (float*)(ws + WS_KMEAN));
            if (C.G > 80) { if ((int)blockIdx.x >= 80) convert_weights(C, ap, 0, 1, C.gw - 80 * 8, C.ngw - 80 * 8); } else convert_weights(C, ap, 0, 1, C.gw, C.ngw);
        }
        else if (op == OP_MOBA) { moba_wg(C, (const bf16*)(ws + WS_PROJ0), (const bf16*)(ws + WS_VT), (const float*)(ws + WS_KMEAN), (bf16*)(ws + WS_MIX));
                                  pool_mfma(C, (const bf16*)(ws + WS_PROJ0), (const bf16*)(ws + WS_PWT), INP(ap, I_POOLS), (bf16*)(ws + WS_MIX)); }
        else if (op == OP_PRO1) { convert_weights(C, ap, 1, 0, C.gw, C.ngw); sgu_w_convert(C, INP(ap, I_SGUW), (bf16*)(ws + WS_WB)); rms_rows_bg(C, ap, (const bf16*)H, (bf16*)(ws + WS_XN), (float*)(ws + WS_BG)); }
        else if (op == OP_L1PREP) { l1_prep(C, ap, (const bf16*)(ws + WS_Z), (const bf16*)(ws + WS_QKV), (bf16*)(ws + WS_VNT), (bf16*)(ws + WS_QN), (bf16*)(ws + WS_KN), (bf16*)(ws + WS_VV)); }
        else if (op == OP_DNPREP) {
            dn_chunk_prep(C, (const bf16*)(ws + WS_QN), (const bf16*)(ws + WS_KN), (const bf16*)(ws + WS_VV), (const float*)(ws + WS_BG), (bf16*)(ws + WS_U), (bf16*)(ws + WS_W), (bf16*)(ws + WS_QD), (bf16*)(ws + WS_KDT), (bf16*)(ws + WS_QKM), (float*)(ws + WS_GL));
        }
        else if (op == OP_DNSCAN) {
            const int nscan = C.G > 64 ? 64 : 0;
            if ((int)blockIdx.x < nscan || nscan == 0) for (int it = blockIdx.x; it < 64; it += C.G) dn_scan(C, (const bf16*)(ws + WS_U), (const bf16*)(ws + WS_W), (const bf16*)(ws + WS_QD), (const bf16*)(ws + WS_KDT), (const bf16*)(ws + WS_QKM), (const float*)(ws + WS_GL), (float*)(ws + WS_O), it);
            if ((int)blockIdx.x >= nscan) { const int gw0 = C.gw - nscan * 8, ngw0 = C.ngw - nscan * 8;
                sgu_mfma(C, (const bf16*)(ws + WS_Z), (const bf16*)(ws + WS_VNT), (const bf16*)(ws + WS_WB), INP(ap, I_SGUBS), (bf16*)(ws + WS_MIX), gw0, ngw0);
                convert_weights(C, ap, 1, 1, gw0, ngw0); }
        }
        else if (op == OP_DNGATE) { dn_out_gate(C, ap, (const float*)(ws + WS_O), (const bf16*)(ws + WS_GATE), (bf16*)(ws + WS_MIX)); }
        else if (op == OP_RMSX) { rms_all_rows(C, H, INP(ap, I_NXATTN) + L * DM, (bf16*)(ws + WS_XN), NT); }
        else if (op == OP_XATTN) { xattn_wg(C, (const bf16*)(ws + WS_QX), (const bf16*)(ws + WS_KVX), (const bf16*)(ws + WS_VXT), (bf16*)(ws + WS_MIX)); }
        else if (op == OP_RMSF) { rms_all_rows(C, H, INP(ap, I_NFFN) + L * DM, (bf16*)(ws + WS_XN), NT); }
        else if (op == OP_ACT) { ffn_act(C, (const bf16*)(ws + WS_HUP), INP(ap, I_FCONV) + (size_t)L * 3 * DFF2, (bf16*)(ws + WS_ACT), PH_DEV[e].hb); }
        else if (op == OP_FINAL) { final_norm(C, (const bf16*)(ws + WS_HB), H, INP(ap, I_FNORM)); }
        if (PH_DEV[e].sync && e + 1 < a.ph_hi) { if (e < 0) grid.sync();   else { XcdBarrier bar; bar.bar = (unsigned*)(ws + WS_CTL); bar.x = xb_xcc_id(); bar.st = (volatile LAS unsigned*)(C.lds + MISC_OFF) + 8; xcd_barrier(bar); } }
    }
}

extern "C" void kernel_launch(void* const* d_in, const int* in_sizes, int n_in, void* d_out, int out_size, void* d_ws, size_t ws_size, hipStream_t stream) {
    static int grid = 0;
    if (grid == 0) {
        if (n_in != 27 || out_size != NT * DM || ws_size < WS_END) { fprintf(stderr, "kernel_launch: unexpected sizes n_in %d out %d ws %zu\n", n_in, out_size, ws_size); grid = -1; return; }
        int dev = 0, cus = 0, per_cu = 0;
        (void)hipGetDevice(&dev); (void)hipDeviceGetAttribute(&cus, hipDeviceAttributeMultiprocessorCount, dev);
        if (hipFuncSetAttribute((const void*)mega_fwd, hipFuncAttributeMaxDynamicSharedMemorySize, LDS_BYTES) != hipSuccess) { fprintf(stderr, "kernel_launch: hipFuncSetAttribute failed\n"); }
        if (hipOccupancyMaxActiveBlocksPerMultiprocessor(&per_cu, (const void*)mega_fwd, 512, LDS_BYTES) != hipSuccess || per_cu < 1) { fprintf(stderr, "kernel_launch: occupancy query says %d\n", per_cu); per_cu = 1; }
        (void)hipGetLastError();
        grid = cus * 1;
        if (grid <= 0) grid = 256;
    }
    if (grid < 0) return;
    if (hipMemsetAsync((char*)d_ws + WS_CTL, 0, CTL_BYTES, stream) != hipSuccess) { fprintf(stderr, "kernel_launch: hipMemsetAsync failed\n"); return; }
    Args a{};
    for (int i = 0; i < 27; ++i) a.in[i] = (const float*)d_in[i];
    a.out = (float*)d_out; a.ws = (unsigned char*)d_ws;
#if MK_MULTI
    for (int e0 = 0; e0 < NENT;) { int e1 = e0; while (e1 < NENT - 1 && !PH_HOST[e1].sync) ++e1; ++e1;
        a.ph_lo = e0; a.ph_hi = e1; void* args[] = {&a};
        hipError_t er = hipLaunchCooperativeKernel((const void*)mega_fwd, dim3(grid), dim3(512), args, LDS_BYTES, stream);
        if (er != hipSuccess) { fprintf(stderr, "launch %d failed: %s\n", e0, hipGetErrorString(er)); break; }
        e0 = e1; }
#else
    a.ph_lo = 0; a.ph_hi = NENT; void* args[] = {&a};
    hipError_t er = hipLaunchCooperativeKernel((const void*)mega_fwd, dim3(grid), dim3(512), args, LDS_BYTES, stream);
    if (er != hipSuccess) fprintf(stderr, "cooperative launch failed: %s (grid %d)\n", hipGetErrorString(er), grid);
#endif
}
```
